# Optimizing an MI355X kernel written in HIP

```python
import math, functools
import jax, jax.numpy as jnp
from jax import lax
import numpy as np

D_MODEL = 1024
BATCH = 2
SEQ = 8192
DEPTH = 1

GRID_W = 64
CTX_LEN = 256
HEAD_DIM = 64
A_HEADS = 8
A_KV_HEADS = 2
A_GROUP = A_HEADS // A_KV_HEADS
A_WIDTH = A_HEADS * HEAD_DIM
B_HEADS = 4
B_V_DIM = 2 * HEAD_DIM
B_WIDTH = B_HEADS * B_V_DIM
N_BRANCH = 2
A_Q_COLS = A_HEADS * HEAD_DIM
A_KV_COLS = A_KV_HEADS * HEAD_DIM
B_QK_COLS = B_HEADS * 2 * HEAD_DIM
IN_SPLIT = [A_Q_COLS, A_KV_COLS, A_KV_COLS, B_QK_COLS, B_QK_COLS, B_WIDTH, D_MODEL, D_MODEL]
IN_COLS = sum(IN_SPLIT)
IN_OFFSETS = [int(v) for v in np.cumsum(IN_SPLIT)[:-1]]
ROPE_THETA = 10000.0
AXIS_PAIRS = HEAD_DIM // 4
Q_BLOCK = 128
N_EXPERTS = 32
TOP_K = 4
D_EXPERT = D_MODEL
SWIGLU_LIMIT = 7.0
SWIGLU_ALPHA = 1.702
MOE_BLOCK = 128
N_MOD = 6
EPS = 1e-6
SUBLN_EPS = 1e-5

kernel_name = "hybrid_gqa_diffattn_moe_dit_block"


def _rmsnorm(x, gain, eps=EPS):
    xf = x.astype(jnp.float32)
    y = xf * lax.rsqrt(jnp.mean(xf * xf, axis=-1, keepdims=True) + eps)
    return (y * gain.astype(jnp.float32)).astype(x.dtype)


def _modulate(h, shift, scale):
    return h * (1 + scale) + shift


def _axial_rope(rows):
    row = jnp.repeat(jnp.arange(rows, dtype=jnp.float32), GRID_W)
    col = jnp.tile(jnp.arange(GRID_W, dtype=jnp.float32), rows)
    inv = 1.0 / (ROPE_THETA ** (jnp.arange(AXIS_PAIRS, dtype=jnp.float32) / AXIS_PAIRS))
    ang = jnp.concatenate([row[:, None] * inv, col[:, None] * inv], axis=-1)
    return jnp.cos(ang), jnp.sin(ang)


def _apply_rope(x, cos, sin):
    extra = x.ndim - 3
    cos = cos.reshape(cos.shape[0], *([1] * extra), cos.shape[1])
    sin = sin.reshape(sin.shape[0], *([1] * extra), sin.shape[1])
    xp = x.reshape(*x.shape[:-1], HEAD_DIM // 2, 2)
    x0, x1 = xp[..., 0], xp[..., 1]
    out = jnp.stack([x0 * cos - x1 * sin, x0 * sin + x1 * cos], axis=-1)
    return out.reshape(x.shape).astype(x.dtype)


def _project(h, w_in, q_norm_a, k_norm_a, q_norm_b, k_norm_b):
    b, n, _ = h.shape
    qa, ka, va, qb, kb, vb, ga, gb = jnp.split(h @ w_in, IN_OFFSETS, axis=-1)
    qa = _rmsnorm(qa.reshape(b, n, A_HEADS, HEAD_DIM), q_norm_a)
    ka = _rmsnorm(ka.reshape(b, n, A_KV_HEADS, HEAD_DIM), k_norm_a)
    va = va.reshape(b, n, A_KV_HEADS, HEAD_DIM)
    qb = _rmsnorm(qb.reshape(b, n, B_HEADS, 2, HEAD_DIM), q_norm_b)
    kb = _rmsnorm(kb.reshape(b, n, B_HEADS, 2, HEAD_DIM), k_norm_b)
    vb = vb.reshape(b, n, B_HEADS, B_V_DIM)
    return qa, ka, va, qb, kb, vb, ga, gb


def _gqa_attend(q, k, v):
    b, n = q.shape[:2]
    qg = q.reshape(b, n, A_KV_HEADS, A_GROUP, HEAD_DIM)
    s = jnp.einsum('bqhgd,bkhd->bhgqk', qg, k).astype(jnp.float32) * (HEAD_DIM ** -0.5)
    p = jax.nn.softmax(s, axis=-1).astype(v.dtype)
    o = jnp.einsum('bhgqk,bkhd->bqhgd', p, v)
    return o.reshape(b, n, A_WIDTH)


def _diff_attend(q, k, v, lam):
    s = jnp.einsum('bqhmd,bkhmd->bhmqk', q, k).astype(jnp.float32) * (HEAD_DIM ** -0.5)
    p = jax.nn.softmax(s, axis=-1)
    a = (p[:, :, 0] - lam * p[:, :, 1]).astype(v.dtype)
    return jnp.einsum('bhqk,bkhe->bqhe', a, v)


def _sweep_query_blocks(attend, q, k, v):
    b, s = q.shape[:2]
    nb = s // Q_BLOCK
    qb = jnp.moveaxis(q.reshape(b, nb, Q_BLOCK, *q.shape[2:]), 1, 0)
    o = lax.map(lambda qq: attend(qq, k, v), qb)
    o = jnp.moveaxis(o, 0, 1)
    return o.reshape(b, s, *o.shape[3:])


def _diff_out(o, subln, lam_init):
    o = _rmsnorm(o, subln, SUBLN_EPS) * (1.0 - lam_init)
    return o.reshape(o.shape[0], o.shape[1], B_WIDTH)


def _merge(ya, yb, ga, gb, w_oa, w_ob, w_out):
    merged = jax.nn.sigmoid(ga) * (ya @ w_oa) + jax.nn.sigmoid(gb) * (yb @ w_ob)
    return merged @ w_out


def _moe(h, router_w, router_b, w_gate, b_gate, w_up, b_up, w_down, b_down):
    t = h.shape[0]
    logits = (h @ router_w + router_b).astype(jnp.float32)
    top_logit, top_e = lax.top_k(logits, TOP_K)
    top_w = jax.nn.softmax(top_logit, axis=-1)
    n_assign = t * TOP_K
    flat_e = top_e.reshape(-1)
    order = jnp.argsort(flat_e)
    sorted_e = flat_e[order]
    sorted_tok = order // TOP_K
    sorted_w = top_w.reshape(-1)[order]
    counts = jnp.bincount(flat_e, length=N_EXPERTS)
    padded = (counts + MOE_BLOCK - 1) // MOE_BLOCK * MOE_BLOCK
    pad_end = jnp.cumsum(padded)
    pad_start = pad_end - padded
    start = jnp.cumsum(counts) - counts
    dest = pad_start[sorted_e] + jnp.arange(n_assign) - start[sorted_e]
    n_blocks = -(-n_assign // MOE_BLOCK) + N_EXPERTS
    buf_tok = jnp.zeros((n_blocks * MOE_BLOCK,), jnp.int32).at[dest].set(sorted_tok.astype(jnp.int32))
    block_e = jnp.minimum(jnp.searchsorted(pad_end, jnp.arange(n_blocks) * MOE_BLOCK, side='right'),
                          N_EXPERTS - 1)
    xb = h[buf_tok].reshape(n_blocks, MOE_BLOCK, h.shape[-1])

    def expert_block(args):
        xe, e = args
        gate = jnp.minimum(xe @ w_gate[e] + b_gate[e], SWIGLU_LIMIT)
        up = jnp.clip(xe @ w_up[e] + b_up[e], -SWIGLU_LIMIT, SWIGLU_LIMIT)
        act = (up + 1) * (gate * jax.nn.sigmoid(SWIGLU_ALPHA * gate))
        return act @ w_down[e] + b_down[e]

    yb = lax.map(expert_block, (xb, block_e)).reshape(-1, h.shape[-1])
    y = yb[dest] * sorted_w[:, None].astype(h.dtype)
    return jax.ops.segment_sum(y, sorted_tok, num_segments=t)


def setup_inputs(seed: int = 0) -> dict:
    key = jax.random.key(seed)
    ks = jax.random.split(key, 32)
    f32 = jnp.float32
    L = DEPTH

    def nrm(k, shape, scale):
        return jax.random.normal(k, shape, f32) * scale

    def gain(k, shape):
        return 1.0 + 0.05 * jax.random.normal(k, shape, f32)

    return {
        "x": nrm(ks[0], (BATCH, SEQ, D_MODEL), 1.0),
        "c": nrm(ks[1], (BATCH, D_MODEL), 1.0),
        "ctx": nrm(ks[2], (BATCH, CTX_LEN, D_MODEL), 1.0),
        "c_ctx": nrm(ks[3], (D_MODEL,), 1.0),
        "w_ada": nrm(ks[4], (L, D_MODEL, N_MOD * D_MODEL), 0.5 * D_MODEL ** -0.5),
        "b_ada": nrm(ks[5], (L, N_MOD * D_MODEL), 0.02),
        "norm_attn": gain(ks[6], (L, D_MODEL)),
        "w_in": nrm(ks[7], (L, D_MODEL, IN_COLS), D_MODEL ** -0.5),
        "q_norm_a": gain(ks[8], (L, HEAD_DIM)),
        "k_norm_a": gain(ks[9], (L, HEAD_DIM)),
        "q_norm_b": gain(ks[10], (L, HEAD_DIM)),
        "k_norm_b": gain(ks[11], (L, HEAD_DIM)),
        "lambda_q1": nrm(ks[12], (L, HEAD_DIM), 0.1),
        "lambda_k1": nrm(ks[13], (L, HEAD_DIM), 0.1),
        "lambda_q2": nrm(ks[14], (L, HEAD_DIM), 0.1),
        "lambda_k2": nrm(ks[15], (L, HEAD_DIM), 0.1),
        "subln_b": gain(ks[16], (L, B_V_DIM)),
        "w_oa": nrm(ks[17], (L, A_WIDTH, D_MODEL), A_WIDTH ** -0.5),
        "w_ob": nrm(ks[18], (L, B_WIDTH, D_MODEL), B_WIDTH ** -0.5),
        "w_out": nrm(ks[19], (L, D_MODEL, D_MODEL), D_MODEL ** -0.5),
        "norm_mlp": gain(ks[20], (L, D_MODEL)),
        "router_w": nrm(ks[21], (L, D_MODEL, N_EXPERTS), D_MODEL ** -0.5),
        "router_b": nrm(ks[22], (L, N_EXPERTS), 0.01),
        "w_gate": nrm(ks[23], (L, N_EXPERTS, D_MODEL, D_EXPERT), D_MODEL ** -0.5),
        "b_gate": nrm(ks[24], (L, N_EXPERTS, D_EXPERT), 0.02),
        "w_up": nrm(ks[25], (L, N_EXPERTS, D_MODEL, D_EXPERT), D_MODEL ** -0.5),
        "b_up": nrm(ks[26], (L, N_EXPERTS, D_EXPERT), 0.02),
        "w_down": nrm(ks[27], (L, N_EXPERTS, D_EXPERT, D_MODEL), D_EXPERT ** -0.5),
        "b_down": nrm(ks[28], (L, N_EXPERTS, D_MODEL), 0.02),
    }


def reference(x, c, ctx, c_ctx, w_ada, b_ada, norm_attn, w_in, q_norm_a, k_norm_a, q_norm_b,
              k_norm_b, lambda_q1, lambda_k1, lambda_q2, lambda_k2, subln_b, w_oa, w_ob, w_out,
              norm_mlp, router_w, router_b, w_gate, b_gate, w_up, b_up, w_down, b_down):
    b, s, d = x.shape
    rows = s // GRID_W
    cos, sin = _axial_rope(rows)
    cx = ctx
    for l in range(DEPTH):
        last = l == DEPTH - 1
        lam_init = 0.8 - 0.6 * math.exp(-0.3 * l)
        lam = (jnp.exp(jnp.sum(lambda_q1[l].astype(jnp.float32) * lambda_k1[l].astype(jnp.float32)))
               - jnp.exp(jnp.sum(lambda_q2[l].astype(jnp.float32) * lambda_k2[l].astype(jnp.float32)))
               + lam_init)
        mod_x = (jax.nn.silu(c) @ w_ada[l] + b_ada[l])[:, None, :]
        mod_c = (jax.nn.silu(c_ctx) @ w_ada[l] + b_ada[l])[None, None, :]
        sh_a, sc_a, g_a, sh_m, sc_m, g_m = jnp.split(mod_x, N_MOD, axis=-1)
        csh_a, csc_a, cg_a, csh_m, csc_m, cg_m = jnp.split(mod_c, N_MOD, axis=-1)
        proj = functools.partial(_project, w_in=w_in[l], q_norm_a=q_norm_a[l], k_norm_a=k_norm_a[l],
                                 q_norm_b=q_norm_b[l], k_norm_b=k_norm_b[l])

        hx = _modulate(_rmsnorm(x, norm_attn[l]), sh_a, sc_a)
        hc = _modulate(_rmsnorm(cx, norm_attn[l]), csh_a, csc_a)
        qa, ka, va, qb, kb, vb, ga, gb = proj(hx)
        cqa, cka, cva, cqb, ckb, cvb, cga, cgb = proj(hc)
        qa, ka = _apply_rope(qa, cos, sin), _apply_rope(ka, cos, sin)
        qb, kb = _apply_rope(qb, cos, sin), _apply_rope(kb, cos, sin)
        ka_all = jnp.concatenate([ka, cka], axis=1)
        va_all = jnp.concatenate([va, cva], axis=1)
        kb_all = jnp.concatenate([kb, ckb], axis=1)
        vb_all = jnp.concatenate([vb, cvb], axis=1)
        ya = _sweep_query_blocks(_gqa_attend, qa, ka_all, va_all)
        yb = _sweep_query_blocks(lambda qq, kk, vv: _diff_attend(qq, kk, vv, lam), qb, kb_all, vb_all)
        yb = _diff_out(yb, subln_b[l], lam_init)
        x = x + g_a * _merge(ya, yb, ga, gb, w_oa[l], w_ob[l], w_out[l])
        if not last:
            cya = _gqa_attend(cqa, cka, cva)
            cyb = _diff_out(_diff_attend(cqb, ckb, cvb, lam), subln_b[l], lam_init)
            cx = cx + cg_a * _merge(cya, cyb, cga, cgb, w_oa[l], w_ob[l], w_out[l])

        moe = functools.partial(_moe, router_w=router_w[l], router_b=router_b[l], w_gate=w_gate[l],
                                b_gate=b_gate[l], w_up=w_up[l], b_up=b_up[l], w_down=w_down[l],
                                b_down=b_down[l])
        hx = _modulate(_rmsnorm(x, norm_mlp[l]), sh_m, sc_m)
        x = x + g_m * moe(hx.reshape(b * s, d)).reshape(b, s, d)
        if not last:
            hc = _modulate(_rmsnorm(cx, norm_mlp[l]), csh_m, csc_m)
            cx = cx + cg_m * moe(hc.reshape(-1, d)).reshape(cx.shape)
    return x
```

```cpp
#include <hip/hip_runtime.h>
#include <cstdio>
#include <cstdint>

constexpr int D = 1024, NB = 2, SEQ = 8192, CL = 256, T = NB * SEQ  , SK = SEQ + CL  , TK = NB * SK  ;
constexpr int INC = 4352, NE = 32, NMOD = 6 * D;
constexpr float C2 = 0.125f * 1.4426950408889634f;
constexpr int ECAP = 16384;
#ifndef MOE_FP8
#define MOE_FP8 1
#endif
#ifndef INPROJ_FP8_ALL
#define INPROJ_FP8_ALL 1
#endif
#ifndef INPROJ_GATE_FP8
#define INPROJ_GATE_FP8 1
#endif
#ifndef Y_FP8
#define Y_FP8 1
#endif
#ifndef ATT_FP8
#define ATT_FP8 1
#endif
#ifndef MOE_XCD_BLOCKS
#define MOE_XCD_BLOCKS 1
#endif
#ifndef INPROJ_XCD_BLOCKS
#define INPROJ_XCD_BLOCKS 1
#endif
#ifndef EPI_PREFETCH
#define EPI_PREFETCH 1
#endif
#ifndef MERGE_FP8
#define MERGE_FP8 1
#endif
constexpr float W8_SCALE = 256.0f, ACT8_SCALE = 4.0f, Y8_SCALE = 16.0f, YA8_SCALE = 64.0f, MG8_SCALE = 16.0f;
__device__ __forceinline__ unsigned pk4_fp8(float a, float b, float c, float d) {
    a = __builtin_amdgcn_fmed3f(a, -448.0f, 448.0f); b = __builtin_amdgcn_fmed3f(b, -448.0f, 448.0f); c = __builtin_amdgcn_fmed3f(c, -448.0f, 448.0f); d = __builtin_amdgcn_fmed3f(d, -448.0f, 448.0f);
    int r = __builtin_amdgcn_cvt_pk_fp8_f32(a, b, 0, false); r = __builtin_amdgcn_cvt_pk_fp8_f32(c, d, r, true); return (unsigned)r;
}

typedef unsigned short bf16;
typedef float f32x4 __attribute__((ext_vector_type(4)));
#define GAS __attribute__((address_space(1)))
#define LAS __attribute__((address_space(3)))

constexpr size_t MiB = 1u << 20;
constexpr size_t WS_CTL = 0, CTL_BYTES = 1 * MiB;
constexpr size_t WS_MOD = 1 * MiB;
constexpr size_t WS_LAM = 1 * MiB + 128 * 1024;
constexpr size_t WS_WP = 1 * MiB + 256 * 1024;
constexpr size_t WS_CST = 1 * MiB + 768 * 1024;
constexpr size_t WS_WIN = 2 * MiB;
constexpr size_t WS_WOA = 11 * MiB, WS_WOB = 12 * MiB, WS_WOUT = 13 * MiB;
constexpr size_t WS_WD = 16 * MiB;
constexpr size_t WS_WGU = 80 * MiB;
constexpr size_t WS_Y = 80 * MiB;
constexpr size_t WS_HX8 = 144 * MiB;
constexpr size_t WS_HX = 208 * MiB;
constexpr size_t WS_MERGED = 208 * MiB;
constexpr size_t WS_QA = 241 * MiB, WS_QB = 257 * MiB, WS_KA = 273 * MiB, WS_VA = 278 * MiB, WS_KB = 283 * MiB, WS_VB = 300 * MiB;
constexpr size_t WS_G = 317 * MiB;
constexpr size_t WS_ACT = 208 * MiB;
constexpr size_t WS_AY = 381 * MiB;
constexpr size_t WS_OB = 413 * MiB, WS_HM = 445 * MiB;
constexpr size_t WS_TMP = 241 * MiB;
constexpr size_t WS_TOK = 477 * MiB, WS_SW = 479 * MiB, WS_SDST = 481 * MiB;
#ifndef ROUTER_OVERLAP
#define ROUTER_OVERLAP 1
#endif
#ifndef G_U8
#define G_U8 1
#endif
#ifndef X1_BF16
#define X1_BF16 1
#endif
constexpr size_t WS_X1 = 168 * MiB;
constexpr size_t WS_TRASH = 484 * MiB;
constexpr size_t WS_END = 485 * MiB;
constexpr int CW_CNT = 1024;

struct P {
    const float *x, *c, *ctx, *c_ctx, *w_ada, *b_ada, *norm_attn, *w_in, *q_norm_a, *k_norm_a, *q_norm_b, *k_norm_b, *lq1, *lk1, *lq2, *lk2, *subln,
        *w_oa, *w_ob, *w_out, *norm_mlp, *router_w, *router_b, *w_gate, *b_gate, *w_up, *b_up, *w_down, *b_down;
    float* out; unsigned char* ws;
};

__device__ __forceinline__ float bf2f(bf16 h) { return __uint_as_float((unsigned)h << 16); }
__device__ __forceinline__ unsigned f2bf(float f) { unsigned u = __float_as_uint(f); return (u + 0x7fffu + ((u >> 16) & 1u)) >> 16; }
__device__ __forceinline__ unsigned pk2(float lo, float hi) { return f2bf(lo) | (f2bf(hi) << 16); }
__device__ __forceinline__ float wave_sum(float v) {
#pragma unroll
    for (int o = 1; o < 64; o <<= 1) v += __shfl_xor(v, o);
    return v;
}
__device__ __forceinline__ float sigmoidf_(float v) { return 1.0f / (1.0f + __expf(-v)); }
__device__ __forceinline__ void rope_cs(float pos, int j, float& c, float& s) {
    const float inv_rev = exp2f(-(float)j * (13.287712379549449f / 16.0f)) * 0.15915494309189535f;
    float rev = pos * inv_rev; rev = rev - floorf(rev);
    c = __builtin_amdgcn_cosf(rev); s = __builtin_amdgcn_sinf(rev);
}

__device__ __forceinline__ void ph_mod(const P& p, int vb, int nvb, float* lds) {
    const int t = threadIdx.x, c4 = t & 7, rg = t >> 3;
    float* MOD = (float*)(p.ws + WS_MOD);
    for (int it = vb; it < NMOD / 32; it += nvb) {
        const int n0 = it * 32 + c4 * 4;
        f32x4 a0 = {0, 0, 0, 0}, a1 = a0, a2 = a0;
        for (int k = rg; k < D; k += 64) {
            const f32x4 w = *(const f32x4*)(p.w_ada + (size_t)k * NMOD + n0);
            const float c0 = p.c[k], c1 = p.c[D + k], cc = p.c_ctx[k];
            a0 += w * (c0 * sigmoidf_(c0)); a1 += w * (c1 * sigmoidf_(c1)); a2 += w * (cc * sigmoidf_(cc));
        }
        __syncthreads();
#pragma unroll
        for (int j = 0; j < 4; ++j) { lds[(rg * 3 + 0) * 32 + c4 * 4 + j] = a0[j]; lds[(rg * 3 + 1) * 32 + c4 * 4 + j] = a1[j]; lds[(rg * 3 + 2) * 32 + c4 * 4 + j] = a2[j]; }
        __syncthreads();
        if (t < 96) { const int v = t >> 5, cI = t & 31; float s = 0.f; for (int r = 0; r < 64; ++r) s += lds[(r * 3 + v) * 32 + cI]; MOD[v * NMOD + it * 32 + cI] = s + p.b_ada[it * 32 + cI]; }
    }
    if (vb == 0 && t < 64) {
        float a = p.lq1[t] * p.lk1[t], b = p.lq2[t] * p.lk2[t];
        a = wave_sum(a); b = wave_sum(b);
        if (t == 0) *(float*)(p.ws + WS_LAM) = expf(a) - expf(b) + 0.2f;
    }
}

__device__ __forceinline__ void ph_norm1_row(const P& p, int r, int lane, const f32x4 (&v)[4], const f32x4 (&gq)[4], const f32x4 (&shq)[4]) {
    bf16* HX = (bf16*)(p.ws + WS_HX);
    float ss = 0.f;
#pragma unroll
    for (int j = 0; j < 4; ++j) ss += (v[j].x * v[j].x + v[j].y * v[j].y) + (v[j].z * v[j].z + v[j].w * v[j].w);
    const float rstd = 1.0f / sqrtf(wave_sum(ss) * (1.0f / D) + 1e-6f);
#pragma unroll
    for (int j = 0; j < 4; ++j) { const int n = 4 * (64 * j + lane);
        const f32x4 h = (v[j] * rstd) * gq[j] + shq[j];
        if (!INPROJ_FP8_ALL) { uint2 o; o.x = pk2(h.x, h.y); o.y = pk2(h.z, h.w); *(uint2*)(HX + (size_t)r * D + n) = o; }
        if (INPROJ_GATE_FP8) *(unsigned*)(p.ws + WS_HX8 + (size_t)r * D + n) = pk4_fp8(h.x, h.y, h.z, h.w); }
}
__device__ __forceinline__ void ph_norm1(const P& p, int vb, int nvb) {
    const int lane = threadIdx.x & 63, gw = vb * 8 + (threadIdx.x >> 6), ngw = nvb * 8;
    const float* MOD = (const float*)(p.ws + WS_MOD);
    const bool blk = INPROJ_XCD_BLOCKS && nvb == 256; const int x = vb >> 5, w = (vb & 31) * 8 + (threadIdx.x >> 6);
    const int rb = (8 * x + (x >= 4 ? 1 : 0)) * 256, cb = ((x & 3) == 3) ? (x == 3 ? 32 : 65) * 256 : -1;
    if (blk) {
        const int b = x >> 2; const float* mv = MOD + b * NMOD; f32x4 gq[4], shq[4];
#pragma unroll
        for (int j = 0; j < 4; ++j) { const int n = 4 * (64 * j + lane); gq[j] = *(const f32x4*)(p.norm_attn + n) * (*(const f32x4*)(mv + D + n) + 1.0f); shq[j] = *(const f32x4*)(mv + n); }
#pragma unroll
        for (int k0 = 0; k0 < 8; k0 += 4) { f32x4 vq[4][4];
#pragma unroll
            for (int k = 0; k < 4; ++k) { const int r = rb + w + 256 * (k0 + k), t = r % SK; const float* src = p.x + ((size_t)b * SEQ + t) * D;
#pragma unroll
                for (int j = 0; j < 4; ++j) vq[k][j] = *(const f32x4*)(src + 4 * (64 * j + lane)); }
#pragma unroll
            for (int k = 0; k < 4; ++k) ph_norm1_row(p, rb + w + 256 * (k0 + k), lane, vq[k], gq, shq); }
        if (cb >= 0) { const int r = cb + w, t = r % SK; const float* src = p.ctx + ((size_t)b * CL + (t - SEQ)) * D; const float* mc = MOD + 2 * NMOD; f32x4 v[4];
#pragma unroll
            for (int j = 0; j < 4; ++j) { const int n = 4 * (64 * j + lane); v[j] = *(const f32x4*)(src + n); gq[j] = *(const f32x4*)(p.norm_attn + n) * (*(const f32x4*)(mc + D + n) + 1.0f); shq[j] = *(const f32x4*)(mc + n); }
            ph_norm1_row(p, r, lane, v, gq, shq); }
        return;
    }
    for (int r = gw; r < TK; r += ngw) {
        const int b = r / SK, t = r % SK; const bool isctx = t >= SEQ;
        const float* src = isctx ? p.ctx + ((size_t)b * CL + (t - SEQ)) * D : p.x + ((size_t)b * SEQ + t) * D;
        const float* mv = MOD + (isctx ? 2 : b) * NMOD;
        f32x4 v[4], gq[4], shq[4];
#pragma unroll
        for (int j = 0; j < 4; ++j) { const int n = 4 * (64 * j + lane); v[j] = *(const f32x4*)(src + n); gq[j] = *(const f32x4*)(p.norm_attn + n) * (*(const f32x4*)(mv + D + n) + 1.0f); shq[j] = *(const f32x4*)(mv + n); }
        ph_norm1_row(p, r, lane, v, gq, shq);
    }
}

__device__ __forceinline__ void diffout_tile(const P& p, size_t qrow0, int hh) {
    const int lane = threadIdx.x & 63, wave = threadIdx.x >> 6;
    const bf16* OB = (const bf16*)(p.ws + WS_OB); bf16* YB = (bf16*)(p.ws + WS_AY) + 512;
    const float lam = *(const float*)(p.ws + WS_LAM);
    const int e0 = (lane & 15) * 8;
    float sg[8];
#pragma unroll
    for (int j = 0; j < 8; ++j) sg[j] = p.subln[e0 + j];
#pragma unroll 2
    for (int it = 0; it < 8; ++it) {
        const size_t r = qrow0 + wave * 32 + it * 4 + (lane >> 4); const size_t off = r * 512 + hh * 128 + e0;
        const uint4 a = *(const uint4*)(OB + off), b = *(const uint4*)(OB + (size_t)T * 512 + off);
        const unsigned aw[4] = {a.x, a.y, a.z, a.w}, bw[4] = {b.x, b.y, b.z, b.w};
        float d[8]; float ss = 0.f;
#pragma unroll
        for (int j = 0; j < 4; ++j) { d[2 * j] = __uint_as_float(aw[j] << 16) - lam * __uint_as_float(bw[j] << 16); d[2 * j + 1] = __uint_as_float(aw[j] & 0xffff0000u) - lam * __uint_as_float(bw[j] & 0xffff0000u);
            ss += d[2 * j] * d[2 * j] + d[2 * j + 1] * d[2 * j + 1]; }
        ss += __shfl_xor(ss, 1); ss += __shfl_xor(ss, 2); ss += __shfl_xor(ss, 4); ss += __shfl_xor(ss, 8);
        const float rstd = 1.0f / sqrtf(ss * (1.0f / 128.0f) + 1e-5f) * 0.8f;
        if (MERGE_FP8) { uint2 w; w.x = pk4_fp8(d[0] * rstd * sg[0], d[1] * rstd * sg[1], d[2] * rstd * sg[2], d[3] * rstd * sg[3]); w.y = pk4_fp8(d[4] * rstd * sg[4], d[5] * rstd * sg[5], d[6] * rstd * sg[6], d[7] * rstd * sg[7]);
            *(uint2*)(p.ws + WS_AY + r * 1024 + 512 + hh * 128 + e0) = w; }
        else { uint4 w; w.x = pk2(d[0] * rstd * sg[0], d[1] * rstd * sg[1]); w.y = pk2(d[2] * rstd * sg[2], d[3] * rstd * sg[3]); w.z = pk2(d[4] * rstd * sg[4], d[5] * rstd * sg[5]); w.w = pk2(d[6] * rstd * sg[6], d[7] * rstd * sg[7]);
        *(uint4*)(YB + r * 1024 + hh * 128 + e0) = w; }
    }
}

__device__ __forceinline__ void ph_router_prep(const P& p, int vb, int nvb) {
    const float* MOD = (const float*)(p.ws + WS_MOD); float* WP = (float*)(p.ws + WS_WP); float* CST = (float*)(p.ws + WS_CST);
    for (int idx = vb * 512 + threadIdx.x; idx < 2 * 8192; idx += nvb * 512) {
        const int b = idx >> 13, q = idx & 8191, j = q & 31, kb = 8 * (q >> 6) + 4 * ((q >> 5) & 1); f32x4 o;
#pragma unroll
        for (int s = 0; s < 4; ++s) { const int k = kb + s; o[s] = p.norm_mlp[k] * (1.0f + MOD[b * NMOD + 4 * D + k]) * p.router_w[k * NE + j]; }
        *(f32x4*)(WP + (size_t)b * 32768 + q * 4) = o;
    }
    if (vb == 0) { const int lane = threadIdx.x & 63, wave = threadIdx.x >> 6;
        for (int q = wave; q < 64; q += 8) { const int b = q >> 5, e = q & 31; float s = 0.f;
            for (int k = lane; k < D; k += 64) s += MOD[b * NMOD + 3 * D + k] * p.router_w[k * NE + e];
            s = wave_sum(s); if (lane == 0) CST[b * 32 + e] = s + p.router_b[e]; } }
}

__device__ __forceinline__ void ph_diffout(const P& p, int vb, int nvb) {
    const int lane = threadIdx.x & 63, gw = vb * 8 + (threadIdx.x >> 6), ngw = nvb * 8;
    const bf16* OB = (const bf16*)(p.ws + WS_OB); bf16* YB = (bf16*)(p.ws + WS_AY) + 512;
    const float lam = *(const float*)(p.ws + WS_LAM);
    for (int r = gw; r < T; r += ngw) {
        const uint4 a = *(const uint4*)(OB + (size_t)r * 512 + lane * 8), b = *(const uint4*)(OB + (size_t)T * 512 + (size_t)r * 512 + lane * 8);
        const unsigned aw[4] = {a.x, a.y, a.z, a.w}, bw[4] = {b.x, b.y, b.z, b.w};
        float d[8]; float ss = 0.f;
#pragma unroll
        for (int j = 0; j < 4; ++j) { d[2 * j] = __uint_as_float(aw[j] << 16) - lam * __uint_as_float(bw[j] << 16); d[2 * j + 1] = __uint_as_float(aw[j] & 0xffff0000u) - lam * __uint_as_float(bw[j] & 0xffff0000u);
            ss += d[2 * j] * d[2 * j] + d[2 * j + 1] * d[2 * j + 1]; }
        ss += __shfl_xor(ss, 1); ss += __shfl_xor(ss, 2); ss += __shfl_xor(ss, 4); ss += __shfl_xor(ss, 8);
        const float rstd = 1.0f / sqrtf(ss * (1.0f / 128.0f) + 1e-5f) * 0.8f;
        const int e0 = (lane & 15) * 8; float o[8];
#pragma unroll
        for (int j = 0; j < 8; ++j) o[j] = d[j] * rstd * p.subln[e0 + j];
        if (MERGE_FP8) { uint2 w; w.x = pk4_fp8(o[0], o[1], o[2], o[3]); w.y = pk4_fp8(o[4], o[5], o[6], o[7]); *(uint2*)(p.ws + WS_AY + (size_t)r * 1024 + 512 + lane * 8) = w; }
        else { uint4 w; w.x = pk2(o[0], o[1]); w.y = pk2(o[2], o[3]); w.z = pk2(o[4], o[5]); w.w = pk2(o[6], o[7]);
        *(uint4*)(YB + (size_t)r * 1024 + lane * 8) = w; }
    }
}

__device__ __forceinline__ f32x4 x1_ld4(const P& p, size_t e) {
    if (X1_BF16) { const uint2 w = *(const uint2*)((const bf16*)(p.ws + WS_X1) + e);
        return (f32x4){__uint_as_float(w.x << 16), __uint_as_float(w.x & 0xffff0000u), __uint_as_float(w.y << 16), __uint_as_float(w.y & 0xffff0000u)}; }
    return *(const f32x4*)(p.out + e);
}
__device__ __forceinline__ void ph_router2(const P& p, int vb, int nvb, unsigned char* ldsb, unsigned char* smb) {
    typedef float f32x16_ __attribute__((ext_vector_type(16)));
    const int t = threadIdx.x, lane = t & 63, wave = t >> 6;
    float* wl = (float*)ldsb;
    float* part = (float*)ldsb;
    float* lgt = (float*)ldsb + 8192;
    float* rstd_s = (float*)smb; int* sel_e = (int*)(smb + 256); float* sel_w = (float*)(smb + 1280); int* hist = (int*)(smb + 2304); int* gbase = hist + 32; int* lpos = hist + 64;
    const float* MOD = (const float*)(p.ws + WS_MOD); bf16* HM = (bf16*)(p.ws + WS_HM);
    unsigned* CNT = (unsigned*)(p.ws + WS_CTL) + CW_CNT;
    int* TOK = (int*)(p.ws + WS_TOK); float* SW = (float*)(p.ws + WS_SW); int* SDST = (int*)(p.ws + WS_SDST);
    for (int it = vb; it < T / 64; it += nvb) {
        const int b = it / (SEQ / 64);
#if ROUTER_OVERLAP && X1_BF16
        __syncthreads();
        const int r32 = lane & 31, hh = lane >> 5, rt = wave & 1, kq = wave >> 1;
        uint2 avp[32], vqp[8][4];
        { const bf16* ar = (const bf16*)(p.ws + WS_X1) + (size_t)(it * 64 + rt * 32 + r32) * D + kq * 256 + 4 * hh;
#pragma unroll
          for (int c = 0; c < 32; ++c) avp[c] = *(const uint2*)(ar + 8 * c); }
#pragma unroll
        for (int rr = 0; rr < 8; ++rr) { const bf16* src = (const bf16*)(p.ws + WS_X1) + (size_t)(it * 64 + wave * 8 + rr) * D;
#pragma unroll
            for (int j = 0; j < 4; ++j) vqp[rr][j] = *(const uint2*)(src + 4 * (64 * j + lane)); }
        { const unsigned char* srcb = (const unsigned char*)((const float*)(p.ws + WS_WP) + (size_t)b * 32768);
#pragma unroll
          for (int i = 0; i < 16; ++i) __builtin_amdgcn_global_load_lds((const unsigned*)(srcb + (size_t)(t + 512 * i) * 16), (LAS unsigned*)(ldsb + (size_t)(wave * 64 + 512 * i) * 16), 16, 0, 0); }
        if (t < 32) hist[t] = 0;
        f32x4 gq[4], shq[4];
        { const float* mv = MOD + b * NMOD;
#pragma unroll
          for (int j = 0; j < 4; ++j) { const int n = 4 * (64 * j + lane); gq[j] = *(const f32x4*)(p.norm_mlp + n) * (*(const f32x4*)(mv + 4 * D + n) + 1.0f); shq[j] = *(const f32x4*)(mv + 3 * D + n); } }
        asm volatile("s_waitcnt vmcnt(0)" ::: "memory");
        __syncthreads();
        { const float* bl = wl + ((size_t)(kq * 32) * 64 + hh * 32 + r32) * 4;
          f32x16_ acc = {0.f, 0.f, 0.f, 0.f, 0.f, 0.f, 0.f, 0.f, 0.f, 0.f, 0.f, 0.f, 0.f, 0.f, 0.f, 0.f};
#define X1UNP(W) ((f32x4){__uint_as_float((W).x << 16), __uint_as_float((W).x & 0xffff0000u), __uint_as_float((W).y << 16), __uint_as_float((W).y & 0xffff0000u)})
#pragma unroll
          for (int c8 = 0; c8 < 32; c8 += 8) {
#pragma unroll
              for (int i = 0; i < 8; ++i) { const f32x4 bv = *(const f32x4*)(bl + (size_t)(c8 + i) * 256); const f32x4 av = X1UNP(avp[c8 + i]);
#pragma unroll
                  for (int s = 0; s < 4; ++s) acc = __builtin_amdgcn_mfma_f32_32x32x2f32(av[s], bv[s], acc, 0, 0, 0); }
#pragma unroll
              for (int rr = c8 / 4; rr < c8 / 4 + 2; ++rr) {
                  const int rl = wave * 8 + rr, r = it * 64 + rl;
                  f32x4 v[4]; float ss = 0.f;
#pragma unroll
                  for (int j = 0; j < 4; ++j) { v[j] = X1UNP(vqp[rr][j]); ss += (v[j].x * v[j].x + v[j].y * v[j].y) + (v[j].z * v[j].z + v[j].w * v[j].w); }
                  const float rstd = 1.0f / sqrtf(wave_sum(ss) * (1.0f / D) + 1e-6f);
#pragma unroll
                  for (int j = 0; j < 4; ++j) { const int n = 4 * (64 * j + lane);
                      const f32x4 h = (v[j] * rstd) * gq[j] + shq[j];
                      if (MOE_FP8) *(unsigned*)((unsigned char*)HM + (size_t)r * D + n) = pk4_fp8(h.x, h.y, h.z, h.w);
                      else { uint2 o; o.x = pk2(h.x, h.y); o.y = pk2(h.z, h.w); *(uint2*)(HM + (size_t)r * D + n) = o; } }
                  if (lane == 0) rstd_s[rl] = rstd;
              }
          }
#undef X1UNP
#else
        __syncthreads();
        { const f32x4* src = (const f32x4*)((const float*)(p.ws + WS_WP) + (size_t)b * 32768);
#pragma unroll
          for (int i = 0; i < 16; ++i) ((f32x4*)wl)[t + 512 * i] = src[t + 512 * i]; }
        if (t < 32) hist[t] = 0;
        f32x4 gq[4], shq[4];
        { const float* mv = MOD + b * NMOD;
#pragma unroll
          for (int j = 0; j < 4; ++j) { const int n = 4 * (64 * j + lane); gq[j] = *(const f32x4*)(p.norm_mlp + n) * (*(const f32x4*)(mv + 4 * D + n) + 1.0f); shq[j] = *(const f32x4*)(mv + 3 * D + n); } }
        f32x4 vq[8][4];
#pragma unroll
        for (int rr = 0; rr < 8; ++rr) { const size_t src = (size_t)(it * 64 + wave * 8 + rr) * D;
#pragma unroll
            for (int j = 0; j < 4; ++j) vq[rr][j] = x1_ld4(p, src + 4 * (64 * j + lane)); }
#pragma unroll
        for (int rr = 0; rr < 8; ++rr) {
            const int rl = wave * 8 + rr, r = it * 64 + rl;
            f32x4 v[4]; float ss = 0.f;
#pragma unroll
            for (int j = 0; j < 4; ++j) { v[j] = vq[rr][j]; ss += (v[j].x * v[j].x + v[j].y * v[j].y) + (v[j].z * v[j].z + v[j].w * v[j].w); }
            const float rstd = 1.0f / sqrtf(wave_sum(ss) * (1.0f / D) + 1e-6f);
#pragma unroll
            for (int j = 0; j < 4; ++j) { const int n = 4 * (64 * j + lane);
                const f32x4 h = (v[j] * rstd) * gq[j] + shq[j];
                if (MOE_FP8) *(unsigned*)((unsigned char*)HM + (size_t)r * D + n) = pk4_fp8(h.x, h.y, h.z, h.w);
                else { uint2 o; o.x = pk2(h.x, h.y); o.y = pk2(h.z, h.w); *(uint2*)(HM + (size_t)r * D + n) = o; } }
            if (lane == 0) rstd_s[rl] = rstd;
        }
        __syncthreads();
        { const int r32 = lane & 31, hh = lane >> 5, rt = wave & 1, kq = wave >> 1;
          const size_t arow = (size_t)(it * 64 + rt * 32 + r32) * D + kq * 256 + 4 * hh;
          const float* bl = wl + ((size_t)(kq * 32) * 64 + hh * 32 + r32) * 4;
          f32x16_ acc = {0.f, 0.f, 0.f, 0.f, 0.f, 0.f, 0.f, 0.f, 0.f, 0.f, 0.f, 0.f, 0.f, 0.f, 0.f, 0.f};
#pragma unroll 1
          for (int c8 = 0; c8 < 32; c8 += 8) {
              f32x4 av[8];
#pragma unroll
              for (int i = 0; i < 8; ++i) av[i] = x1_ld4(p, arow + (c8 + i) * 8);
#pragma unroll
              for (int i = 0; i < 8; ++i) { const f32x4 bv = *(const f32x4*)(bl + (size_t)(c8 + i) * 256);
#pragma unroll
                  for (int s = 0; s < 4; ++s) acc = __builtin_amdgcn_mfma_f32_32x32x2f32(av[i][s], bv[s], acc, 0, 0, 0); }
          }
#endif
          __syncthreads();
#pragma unroll
          for (int r = 0; r < 16; ++r) part[wave * 1024 + ((r & 3) + 8 * (r >> 2) + 4 * hh) * 32 + r32] = acc[r];
        }
        __syncthreads();
        for (int i = t; i < 2048; i += 512) { const int row = i >> 5, e = i & 31, rt = row >> 5, rw = row & 31;
            lgt[row * 33 + e] = (part[(0 + rt) * 1024 + rw * 32 + e] + part[(2 + rt) * 1024 + rw * 32 + e]) + (part[(4 + rt) * 1024 + rw * 32 + e] + part[(6 + rt) * 1024 + rw * 32 + e]); }
        __syncthreads();
        if (t < 64) {
            const float rs = rstd_s[t]; const float* cst = (const float*)(p.ws + WS_CST) + b * 32;
            float lg[32];
#pragma unroll
            for (int e = 0; e < 32; ++e) lg[e] = lgt[t * 33 + e] * rs + cst[e];
            unsigned used = 0u; float tv[4]; int ti[4];
#pragma unroll
            for (int q = 0; q < 4; ++q) { float best = -INFINITY; int bi = 0;
#pragma unroll
                for (int e = 0; e < 32; ++e) { const float c = ((used >> e) & 1u) ? -INFINITY : lg[e]; if (c > best) { best = c; bi = e; } }
                tv[q] = best; ti[q] = bi; used |= 1u << bi; }
            const float e1 = __expf(tv[1] - tv[0]), e2 = __expf(tv[2] - tv[0]), e3 = __expf(tv[3] - tv[0]); const float inv = 1.0f / (1.0f + e1 + e2 + e3);
            sel_e[t * 4 + 0] = ti[0]; sel_e[t * 4 + 1] = ti[1]; sel_e[t * 4 + 2] = ti[2]; sel_e[t * 4 + 3] = ti[3];
            sel_w[t * 4 + 0] = inv; sel_w[t * 4 + 1] = e1 * inv; sel_w[t * 4 + 2] = e2 * inv; sel_w[t * 4 + 3] = e3 * inv;
        }
        __syncthreads();
        if (t < 256) lpos[t] = atomicAdd(&hist[sel_e[t]], 1);
        __syncthreads();
        if (t < 32) gbase[t] = (int)__hip_atomic_fetch_add(CNT + 64 * t, (unsigned)hist[t], __ATOMIC_RELAXED, __HIP_MEMORY_SCOPE_AGENT);
        __syncthreads();
        if (t < 256) { const int e = sel_e[t], pos = gbase[e] + lpos[t], tok = it * 64 + (t >> 2);
            TOK[e * ECAP + pos] = tok; SW[e * ECAP + pos] = sel_w[t]; SDST[e * ECAP + pos] = tok * 4 + (t & 3); }
    }
}

__device__ __forceinline__ void ph_combine(const P& p, int vb, int nvb) {
    const float* MOD = (const float*)(p.ws + WS_MOD); const bf16* Y = (const bf16*)(p.ws + WS_Y);
    const size_t n8 = (size_t)T * D / 8;
    for (size_t i = (size_t)vb * 512 + threadIdx.x; i < n8; i += (size_t)nvb * 512) {
        const size_t tok = i / (D / 8); const int n = (int)(i % (D / 8)) * 8; const int b = (int)(tok / SEQ);
        float s[8] = {0, 0, 0, 0, 0, 0, 0, 0};
#pragma unroll
        for (int k = 0; k < 4; ++k) {
            if (Y_FP8) { typedef float f32x2_ __attribute__((ext_vector_type(2)));
                const uint2 y = *(const uint2*)((const unsigned char*)Y + (tok * 4 + k) * D + n);
                const f32x2_ a0 = __builtin_amdgcn_cvt_pk_f32_fp8((int)y.x, false), a1 = __builtin_amdgcn_cvt_pk_f32_fp8((int)y.x, true), a2 = __builtin_amdgcn_cvt_pk_f32_fp8((int)y.y, false), a3 = __builtin_amdgcn_cvt_pk_f32_fp8((int)y.y, true);
                s[0] += a0.x; s[1] += a0.y; s[2] += a1.x; s[3] += a1.y; s[4] += a2.x; s[5] += a2.y; s[6] += a3.x; s[7] += a3.y;
            } else { const uint4 y = *(const uint4*)(Y + (tok * 4 + k) * D + n); const unsigned w[4] = {y.x, y.y, y.z, y.w};
#pragma unroll
            for (int j = 0; j < 4; ++j) { s[2 * j] += __uint_as_float(w[j] << 16); s[2 * j + 1] += __uint_as_float(w[j] & 0xffff0000u); } } }
        if (Y_FP8) {
#pragma unroll
            for (int j = 0; j < 8; ++j) s[j] *= 1.0f / Y8_SCALE; }
        float* o = p.out + tok * D + n; const float* gm = MOD + b * NMOD + 5 * D + n;
        f32x4 o0, o1;
        if (X1_BF16) { const uint4 w = *(const uint4*)((const bf16*)(p.ws + WS_X1) + tok * D + n);
            o0 = (f32x4){__uint_as_float(w.x << 16), __uint_as_float(w.x & 0xffff0000u), __uint_as_float(w.y << 16), __uint_as_float(w.y & 0xffff0000u)};
            o1 = (f32x4){__uint_as_float(w.z << 16), __uint_as_float(w.z & 0xffff0000u), __uint_as_float(w.w << 16), __uint_as_float(w.w & 0xffff0000u)}; }
        else { o0 = *(f32x4*)o; o1 = *(f32x4*)(o + 4); }
        const f32x4 g0 = *(const f32x4*)gm, g1 = *(const f32x4*)(gm + 4);
        o0 += g0 * (f32x4){s[0], s[1], s[2], s[3]}; o1 += g1 * (f32x4){s[4], s[5], s[6], s[7]};
        *(f32x4*)o = o0; *(f32x4*)(o + 4) = o1;
    }
}

template <class FA, class FB>
__device__ __forceinline__ void ngemm_acc(float (&acc)[4][4], float* sA, float* sB, int K, FA fa, FB fb) {
    const int t = threadIdx.x, tx = t & 15, ty = t >> 4;
    for (int k0 = 0; k0 < K; k0 += 16) {
#pragma unroll
        for (int i = 0; i < 4; ++i) { const int idx = t + 256 * i; sA[(idx & 15) * 68 + (idx >> 4)] = fa(idx >> 4, k0 + (idx & 15)); }
#pragma unroll
        for (int i = 0; i < 4; ++i) { const int idx = t + 256 * i; sB[(idx >> 6) * 68 + (idx & 63)] = fb(k0 + (idx >> 6), idx & 63); }
        __syncthreads();
#pragma unroll
        for (int kk = 0; kk < 16; ++kk) { const f32x4 a = *(const f32x4*)(sA + kk * 68 + ty * 4), b = *(const f32x4*)(sB + kk * 68 + tx * 4);
#pragma unroll
            for (int i = 0; i < 4; ++i)
#pragma unroll
                for (int j = 0; j < 4; ++j) acc[i][j] += a[i] * b[j]; }
        __syncthreads();
    }
}
#define ZERO_ACC(acc) _Pragma("unroll") for (int i_ = 0; i_ < 4; ++i_) _Pragma("unroll") for (int j_ = 0; j_ < 4; ++j_) acc[i_][j_] = 0.f

__global__ void __launch_bounds__(256) nk_inproj(P p) {
    __shared__ __attribute__((aligned(16))) float sA[16 * 68]; __shared__ __attribute__((aligned(16))) float sB[16 * 68]; __shared__ float Cs[64 * 65];
    const int rt = blockIdx.x, cb = blockIdx.y, t = threadIdx.x, tx = t & 15, ty = t >> 4;
    const int row0 = rt * 64, bb = row0 / SK, t0 = row0 % SK; const bool isctx = t0 >= SEQ;
    int type, hc;
    if (cb < 8) { type = 0; hc = cb; } else if (cb < 10) { type = 1; hc = cb - 8; } else if (cb < 12) { type = 2; hc = cb - 10; } else if (cb < 20) { type = 3; hc = cb - 12; }
    else if (cb < 28) { type = 4; hc = cb - 20; } else if (cb < 36) { type = 5; hc = cb - 28; } else if (cb < 52) { type = 6; hc = cb - 36; } else { type = 7; hc = cb - 52; }
    if (isctx && !(type == 1 || type == 2 || type == 4 || type == 5)) return;
    const bf16* HX = (const bf16*)(p.ws + WS_HX);
    float acc[4][4]; ZERO_ACC(acc);
    ngemm_acc(acc, sA, sB, D, [&](int r, int k) { return bf2f(HX[(size_t)(row0 + r) * D + k]); }, [&](int k, int c) { return p.w_in[(size_t)k * INC + cb * 64 + c]; });
#pragma unroll
    for (int i = 0; i < 4; ++i)
#pragma unroll
        for (int j = 0; j < 4; ++j) Cs[(ty * 4 + i) * 65 + tx * 4 + j] = acc[i][j];
    __syncthreads();
    if (t < 64) {
        const int r = t, tt = t0 + r, hr = row0 + r, qrow = bb * SEQ + tt;
        float v[64];
#pragma unroll
        for (int d = 0; d < 64; ++d) v[d] = Cs[r * 65 + d];
        if (type == 0 || type == 1 || type == 3 || type == 4) {
            float ss = 0.f;
#pragma unroll
            for (int d = 0; d < 64; ++d) ss += v[d] * v[d];
            const float rstd = 1.0f / sqrtf(ss * (1.0f / 64.0f) + 1e-6f);
            const float* gn = type == 0 ? p.q_norm_a : type == 1 ? p.k_norm_a : type == 3 ? p.q_norm_b : p.k_norm_b;
#pragma unroll
            for (int d = 0; d < 64; ++d) v[d] = v[d] * rstd * gn[d];
            if (!isctx) {
#pragma unroll
                for (int i = 0; i < 32; ++i) { const float pos = (float)(i < 16 ? (tt >> 6) : (tt & 63)); float c, s; rope_cs(pos, i & 15, c, s);
                    const float x0 = v[2 * i], x1 = v[2 * i + 1]; v[2 * i] = x0 * c - x1 * s; v[2 * i + 1] = x0 * s + x1 * c; }
            }
            if (type == 0 || type == 3) {
#pragma unroll
                for (int d = 0; d < 64; ++d) v[d] *= C2;
            }
        } else if (type >= 6) {
#pragma unroll
            for (int d = 0; d < 64; ++d) v[d] = sigmoidf_(v[d]);
        }
        bf16* dst;
        switch (type) {
            case 0: dst = (bf16*)(p.ws + WS_QA) + (size_t)qrow * 512 + hc * 64; break;
            case 1: dst = (bf16*)(p.ws + WS_KA) + (size_t)hr * 128 + hc * 64; break;
            case 2: dst = (bf16*)(p.ws + WS_VA) + (size_t)hr * 128 + hc * 64; break;
            case 3: dst = (bf16*)(p.ws + WS_QB) + (size_t)qrow * 512 + hc * 64; break;
            case 4: dst = (bf16*)(p.ws + WS_KB) + (size_t)hr * 512 + hc * 64; break;
            case 5: dst = (bf16*)(p.ws + WS_VB) + (size_t)hr * 512 + hc * 64; break;
            case 6: dst = (bf16*)(p.ws + WS_G) + (size_t)qrow * 2048 + hc * 64; break;
            default: dst = (bf16*)(p.ws + WS_G) + (size_t)qrow * 2048 + 1024 + hc * 64; break;
        }
#pragma unroll
        for (int d = 0; d < 64; d += 8) { uint4 w; w.x = pk2(v[d], v[d + 1]); w.y = pk2(v[d + 2], v[d + 3]); w.z = pk2(v[d + 4], v[d + 5]); w.w = pk2(v[d + 6], v[d + 7]); *(uint4*)(dst + d) = w; }
    }
}

template <int MODE>
__global__ void __launch_bounds__(256) nk_attn(P p) {
    constexpr int VD = MODE == 0 ? 64 : 128;
    __shared__ __attribute__((aligned(16))) float Ks[64 * 64]; __shared__ __attribute__((aligned(16))) float Vs[64 * VD];
    const int qb = blockIdx.x, y = blockIdx.y, t = threadIdx.x, b = y >> 3;
    const bf16 *Q, *K, *V; bf16* O; int kp, op;
    if (MODE == 0) { const int h = y & 7; Q = (const bf16*)(p.ws + WS_QA) + h * 64; K = (const bf16*)(p.ws + WS_KA) + (h >> 2) * 64; V = (const bf16*)(p.ws + WS_VA) + (h >> 2) * 64; O = (bf16*)(p.ws + WS_AY) + h * 64; kp = 128; op = 1024; }
    else { const int h = (y & 7) >> 1, m = y & 1; Q = (const bf16*)(p.ws + WS_QB) + h * 128 + m * 64; K = (const bf16*)(p.ws + WS_KB) + h * 128 + m * 64; V = (const bf16*)(p.ws + WS_VB) + h * 128;
        O = (bf16*)(p.ws + WS_OB) + (size_t)m * T * 512 + h * 128; kp = 512; op = 512; }
    const size_t qrow = (size_t)b * SEQ + qb * 256 + t;
    float q[64], o[VD]; float mx = -INFINITY, l = 0.f;
#pragma unroll
    for (int d = 0; d < 64; ++d) q[d] = bf2f(Q[qrow * 512 + d]);
#pragma unroll
    for (int e = 0; e < VD; ++e) o[e] = 0.f;
    for (int kt = 0; kt < SK / 64; ++kt) {
        const size_t kr0 = (size_t)b * SK + kt * 64;
        __syncthreads();
        { const int key = t >> 2, d0 = (t & 3) * 16;
#pragma unroll
          for (int d = 0; d < 16; ++d) Ks[key * 64 + d0 + d] = bf2f(K[(kr0 + key) * kp + d0 + d]);
          constexpr int VC = VD / 4; const int e0 = (t & 3) * VC;
#pragma unroll
          for (int e = 0; e < VC; ++e) Vs[key * VD + e0 + e] = bf2f(V[(kr0 + key) * kp + e0 + e]); }
        __syncthreads();
        for (int kk = 0; kk < 64; ++kk) {
            float s = 0.f;
#pragma unroll
            for (int d = 0; d < 64; d += 4) { const f32x4 k4 = *(const f32x4*)(Ks + kk * 64 + d); s += q[d] * k4.x + q[d + 1] * k4.y + q[d + 2] * k4.z + q[d + 3] * k4.w; }
            if (s > mx) { const float f = exp2f(mx - s); l *= f;
#pragma unroll
                for (int e = 0; e < VD; ++e) o[e] *= f;
                mx = s; }
            const float pr = exp2f(s - mx); l += pr;
#pragma unroll
            for (int e = 0; e < VD; e += 4) { const f32x4 v4 = *(const f32x4*)(Vs + kk * VD + e); o[e] += pr * v4.x; o[e + 1] += pr * v4.y; o[e + 2] += pr * v4.z; o[e + 3] += pr * v4.w; }
        }
    }
    const float il = 1.0f / l;
#pragma unroll
    for (int e = 0; e < VD; e += 8) { uint4 w; w.x = pk2(o[e] * il, o[e + 1] * il); w.y = pk2(o[e + 2] * il, o[e + 3] * il); w.z = pk2(o[e + 4] * il, o[e + 5] * il); w.w = pk2(o[e + 6] * il, o[e + 7] * il);
        *(uint4*)(O + qrow * op + e) = w; }
}

__global__ void __launch_bounds__(256) nk_merge(P p) {
    __shared__ __attribute__((aligned(16))) float sA[16 * 68]; __shared__ __attribute__((aligned(16))) float sB[16 * 68];
    const int row0 = blockIdx.x * 64, col0 = blockIdx.y * 64, t = threadIdx.x, tx = t & 15, ty = t >> 4;
    const bf16 *AY = (const bf16*)(p.ws + WS_AY), *G = (const bf16*)(p.ws + WS_G); bf16* MG = (bf16*)(p.ws + WS_MERGED);
    float a1[4][4], a2[4][4]; ZERO_ACC(a1); ZERO_ACC(a2);
    ngemm_acc(a1, sA, sB, 512, [&](int r, int k) { return bf2f(AY[(size_t)(row0 + r) * 1024 + k]); }, [&](int k, int c) { return p.w_oa[(size_t)k * D + col0 + c]; });
    ngemm_acc(a2, sA, sB, 512, [&](int r, int k) { return bf2f(AY[(size_t)(row0 + r) * 1024 + 512 + k]); }, [&](int k, int c) { return p.w_ob[(size_t)k * D + col0 + c]; });
#pragma unroll
    for (int i = 0; i < 4; ++i)
#pragma unroll
        for (int j = 0; j < 4; ++j) { const size_t r = row0 + ty * 4 + i; const int c = col0 + tx * 4 + j;
            MG[r * D + c] = (bf16)f2bf(bf2f(G[r * 2048 + c]) * a1[i][j] + bf2f(G[r * 2048 + 1024 + c]) * a2[i][j]); }
}

__global__ void __launch_bounds__(256) nk_outproj(P p) {
    __shared__ __attribute__((aligned(16))) float sA[16 * 68]; __shared__ __attribute__((aligned(16))) float sB[16 * 68];
    const int row0 = blockIdx.x * 64, col0 = blockIdx.y * 64, t = threadIdx.x, tx = t & 15, ty = t >> 4;
    const bf16* MG = (const bf16*)(p.ws + WS_MERGED); const float* MOD = (const float*)(p.ws + WS_MOD);
    float a1[4][4]; ZERO_ACC(a1);
    ngemm_acc(a1, sA, sB, D, [&](int r, int k) { return bf2f(MG[(size_t)(row0 + r) * D + k]); }, [&](int k, int c) { return p.w_out[(size_t)k * D + col0 + c]; });
#pragma unroll
    for (int i = 0; i < 4; ++i)
#pragma unroll
        for (int j = 0; j < 4; ++j) { const size_t r = row0 + ty * 4 + i; const int c = col0 + tx * 4 + j; const int b = (int)(r / SEQ);
            p.out[r * D + c] = p.x[r * D + c] + MOD[b * NMOD + 2 * D + c] * a1[i][j]; }
}

__device__ __forceinline__ void expert_prefix(const P& p, int* s_cnt, int* s_base, int* s_tile0) {
    const unsigned* CNT = (const unsigned*)(p.ws + WS_CTL) + CW_CNT;
    if (threadIdx.x == 0) { int base = 0, tl = 0; for (int e = 0; e < NE; ++e) { const int c = (int)CNT[64 * e]; s_cnt[e] = c; s_base[e] = base; s_tile0[e] = tl; base += (c + 255) / 256 * 256; tl += (c + 63) / 64; } s_tile0[NE] = tl; }
    __syncthreads();
}

__global__ void __launch_bounds__(256) nk_moe1(P p) {
    __shared__ __attribute__((aligned(16))) float sA[16 * 68]; __shared__ __attribute__((aligned(16))) float sB[16 * 68];
    __shared__ int s_cnt[NE], s_base[NE], s_tile0[NE + 1], s_tok[64];
    const int t = threadIdx.x, tx = t & 15, ty = t >> 4;
    expert_prefix(p, s_cnt, s_base, s_tile0);
    const bf16* HM = (const bf16*)(p.ws + WS_HM); const int* TOK = (const int*)(p.ws + WS_TOK); bf16* ACT = (bf16*)(p.ws + WS_ACT);
    const int ntiles = s_tile0[NE] * 16;
    for (int i = blockIdx.x; i < ntiles; i += gridDim.x) {
        const int rtile = i >> 4, ct = i & 15; int e = 0; while (s_tile0[e + 1] <= rtile) ++e;
        const int pos0 = (rtile - s_tile0[e]) * 64, cnt = s_cnt[e], col0 = ct * 64;
        __syncthreads();
        if (t < 64) s_tok[t] = (pos0 + t < cnt) ? TOK[e * ECAP + pos0 + t] : -1;
        __syncthreads();
        float ag[4][4], au[4][4]; ZERO_ACC(ag); ZERO_ACC(au);
        auto fa = [&](int r, int k) { const int tk = s_tok[r]; return tk >= 0 ? bf2f(HM[(size_t)tk * D + k]) : 0.f; };
        ngemm_acc(ag, sA, sB, D, fa, [&](int k, int c) { return p.w_gate[((size_t)e * D + k) * D + col0 + c]; });
        ngemm_acc(au, sA, sB, D, fa, [&](int k, int c) { return p.w_up[((size_t)e * D + k) * D + col0 + c]; });
#pragma unroll
        for (int ii = 0; ii < 4; ++ii)
#pragma unroll
            for (int j = 0; j < 4; ++j) { const int pos = pos0 + ty * 4 + ii, c = col0 + tx * 4 + j;
                if (pos < cnt) { const float g = fminf(ag[ii][j] + p.b_gate[e * D + c], 7.0f); const float u = fminf(fmaxf(au[ii][j] + p.b_up[e * D + c], -7.0f), 7.0f);
                    ACT[(size_t)(s_base[e] + pos) * D + c] = (bf16)f2bf((u + 1.0f) * (g * sigmoidf_(1.702f * g))); } }
    }
}

__global__ void __launch_bounds__(256) nk_moe2(P p) {
    __shared__ __attribute__((aligned(16))) float sA[16 * 68]; __shared__ __attribute__((aligned(16))) float sB[16 * 68];
    __shared__ int s_cnt[NE], s_base[NE], s_tile0[NE + 1];
    const int t = threadIdx.x, tx = t & 15, ty = t >> 4;
    expert_prefix(p, s_cnt, s_base, s_tile0);
    const bf16* ACT = (const bf16*)(p.ws + WS_ACT); const float* SW = (const float*)(p.ws + WS_SW); const int* SDST = (const int*)(p.ws + WS_SDST); bf16* Y = (bf16*)(p.ws + WS_Y);
    const int ntiles = s_tile0[NE] * 16;
    for (int i = blockIdx.x; i < ntiles; i += gridDim.x) {
        const int rtile = i >> 4, ct = i & 15; int e = 0; while (s_tile0[e + 1] <= rtile) ++e;
        const int pos0 = (rtile - s_tile0[e]) * 64, cnt = s_cnt[e], col0 = ct * 64, base = s_base[e];
        float a1[4][4]; ZERO_ACC(a1);
        ngemm_acc(a1, sA, sB, D, [&](int r, int k) { return (pos0 + r < cnt) ? bf2f(ACT[(size_t)(base + pos0 + r) * D + k]) : 0.f; }, [&](int k, int c) { return p.w_down[((size_t)e * D + k) * D + col0 + c]; });
#pragma unroll
        for (int ii = 0; ii < 4; ++ii)
#pragma unroll
            for (int j = 0; j < 4; ++j) { const int pos = pos0 + ty * 4 + ii, c = col0 + tx * 4 + j;
                if (pos < cnt) { const float w = SW[e * ECAP + pos]; const size_t dst = (size_t)SDST[e * ECAP + pos];
                    Y[dst * D + c] = (bf16)f2bf(w * (a1[ii][j] + p.b_down[e * D + c])); } }
    }
}

namespace pg8 {
#define PG8_LAS __attribute__((address_space(3)))
typedef unsigned short bf16_t;
typedef short bf16x8 __attribute__((ext_vector_type(8)));
typedef float f32x4 __attribute__((ext_vector_type(4)));
typedef unsigned u32x4 __attribute__((ext_vector_type(4)));
typedef int i32x4 __attribute__((ext_vector_type(4)));
typedef int i32x8 __attribute__((ext_vector_type(8)));
__device__ __forceinline__ i32x8 cat8(bf16x8 lo, bf16x8 hi) { const i32x4 a = (i32x4)lo, b = (i32x4)hi; return __builtin_shufflevector(a, b, 0, 1, 2, 3, 4, 5, 6, 7); }
constexpr int BM = 256, BK = 64, HALF = 128, HTB = HALF * BK * 2  , STAGE_BYTES = 8 * HTB;
constexpr int PF_OFF = 135168 + 6144;

__host__ __device__ __forceinline__ int lds_byte(int r, int c) { const int st = (r >> 4) * 2 + (c >> 5), rr = r & 15, cc = c & 31, ob = rr * 64 + cc * 2; return st * 1024 + (ob ^ (((ob >> 9) & 1) << 5)); }
__host__ __device__ __forceinline__ void stage_rc(int b, int& R, int& C) { const int st = b / 1024, sb = b % 1024, swz = sb ^ (((sb >> 9) & 1) << 5); R = (st >> 1) * 16 + swz / 64; C = (st & 1) * 32 + (swz % 64) / 2; }
__host__ __device__ __forceinline__ int perm32(int rho) { const int n = rho >> 4, i = rho & 15; return 8 * (i >> 2) + 4 * n + (i & 3); }

struct Unit { int pm, pn, pb, acol, e, pos0, cnt, base; };
struct Gemm { const bf16_t* A; const bf16_t* Bt; int lda, K; };

__device__ __forceinline__ unsigned cvt_pk_bf16(float lo, float hi) { unsigned r; asm volatile("v_cvt_pk_bf16_f32 %0, %1, %2" : "=v"(r) : "v"(lo), "v"(hi)); return r; }

template <class Epi, class Sched, bool ALIGN_EPI>
__device__ __forceinline__ void gemm_phase(PG8_LAS unsigned char* lds, const Gemm g, const Sched& S, const Epi& E) {
    const int tid = threadIdx.x, wid = __builtin_amdgcn_readfirstlane(tid >> 6), lane = tid & 63, wr = wid >> 2, wc = wid & 3, fr = lane & 15, fq = lane >> 4;
    constexpr bool F8 = Epi::F8;
    constexpr int EB = F8 ? 1 : 2;
    const int K = g.K, nt = K / (F8 ? 2 * BK : BK);
    int RA[2], CA[2]; unsigned voffB[2];
#pragma unroll
    for (int i = 0; i < 2; ++i) { int R, C; stage_rc(tid * 16 + i * 8192, R, C); const int Rb = Epi::PERM ? ((R & ~31) + perm32(R & 31)) : R;
        const int c16 = C >> 3, cb = F8 ? 16 * (2 * (c16 & 3) + (c16 >> 2)) : 2 * C;
        RA[i] = R; CA[i] = cb; voffB[i] = (unsigned)(Rb * K * EB + cb); }
    const size_t kstep = (size_t)(BK * 2);
    const size_t hstep = (size_t)HALF * K * EB;
    const size_t tstep = 2 * hstep;
    const unsigned ldsw = (unsigned)wid * 1024u;
    const int aoff = lds_byte(wr * 64 + fr, fq * 8), boff = lds_byte(wc * 32 + fr, fq * 8);
    const char* const gA = (const char*)g.A;
#define PG8_SA(b, h) (((b) * 2 + (h)) * HTB)
#define PG8_SB(b, h) ((4 + (b) * 2 + (h)) * HTB)
#define PG8_STAGE(bufoff, gbase, voff) do { _Pragma("unroll") for (int _i = 0; _i < 2; ++_i) \
        __builtin_amdgcn_global_load_lds((const unsigned*)((const char*)(gbase) + (voff)[_i]), (PG8_LAS unsigned*)(lds + (bufoff) + ldsw + _i * 8192), 16, 0, 0); } while (0)
#define PG8_STAGE_A(bufoff, kbyte, v, h) do { _Pragma("unroll") for (int _i = 0; _i < 2; ++_i) \
        __builtin_amdgcn_global_load_lds((const unsigned*)(gA + (kbyte) + (v)[(h) * 2 + _i]), (PG8_LAS unsigned*)(lds + (bufoff) + ldsw + _i * 8192), 16, 0, 0); } while (0)
#define PG8_AOFF(dst, u) do { _Pragma("unroll") for (int _h = 0; _h < 2; ++_h) _Pragma("unroll") for (int _i = 0; _i < 2; ++_i) \
        dst[_h * 2 + _i] = (unsigned)(((size_t)S.arow(u, _h * HALF + RA[_i]) * (size_t)g.lda + (size_t)(u).acol) * (size_t)EB + (size_t)CA[_i]); } while (0)
#define PG8_LDA(dst, b, h) do { _Pragma("unroll") for (int m = 0; m < 4; ++m) { if constexpr (F8) { dst##8[m].lo = *(const PG8_LAS i32x4*)(lds + PG8_SA(b, h) + aoff + m * 2048); dst##8[m].hi = *(const PG8_LAS i32x4*)(lds + PG8_SA(b, h) + aoff + m * 2048 + 1024); } \
        else { _Pragma("unroll") for (int k = 0; k < 2; ++k) dst[m][k] = *(const PG8_LAS bf16x8*)(lds + PG8_SA(b, h) + aoff + m * 2048 + k * 1024); } } } while (0)
#define PG8_LDB(dst, b, h) do { _Pragma("unroll") for (int n = 0; n < 2; ++n) { if constexpr (F8) { dst##8[n].lo = *(const PG8_LAS i32x4*)(lds + PG8_SB(b, h) + boff + n * 2048); dst##8[n].hi = *(const PG8_LAS i32x4*)(lds + PG8_SB(b, h) + boff + n * 2048 + 1024); } \
        else { _Pragma("unroll") for (int k = 0; k < 2; ++k) dst[n][k] = *(const PG8_LAS bf16x8*)(lds + PG8_SB(b, h) + boff + n * 2048 + k * 1024); } } } while (0)
#define PG8_MMA(ai, bj, At, Bt) do { __builtin_amdgcn_s_setprio(1); if constexpr (F8) { _Pragma("unroll") for (int m = 0; m < 4; ++m) _Pragma("unroll") for (int n = 0; n < 2; ++n) \
        asm volatile("v_mfma_f32_16x16x128_f8f6f4 %0, %1, %2, %0" : "+v"(acc[ai][bj][m][n]) : "v"(Bt##8[n]), "v"(At##8[m])); } else { \
        _Pragma("unroll") for (int m = 0; m < 4; ++m) _Pragma("unroll") for (int n = 0; n < 2; ++n) _Pragma("unroll") for (int k = 0; k < 2; ++k) \
        acc[ai][bj][m][n] = __builtin_amdgcn_mfma_f32_16x16x32_bf16(Bt[n][k], At[m][k], acc[ai][bj][m][n], 0, 0, 0); } __builtin_amdgcn_s_setprio(0); } while (0)
#define PG8_WAIT_V(n) asm volatile("s_waitcnt vmcnt(" #n ")" ::: "memory")
#define PG8_WAIT_L(n) asm volatile("s_waitcnt lgkmcnt(" #n ")" ::: "memory")
#define PG8_BAR __builtin_amdgcn_s_barrier()
#define PG8_SCHED __builtin_amdgcn_sched_barrier(0)
    Unit cur, nxt; int ui = 0;
    if (!S.next(0, cur)) return;
    f32x4 acc[2][2][4][2];
#pragma unroll
    for (int a = 0; a < 2; ++a)
#pragma unroll
        for (int b = 0; b < 2; ++b)
#pragma unroll
            for (int m = 0; m < 4; ++m)
#pragma unroll
                for (int n = 0; n < 2; ++n) acc[a][b][m][n] = (f32x4){0.f, 0.f, 0.f, 0.f};
    bf16x8 At[4][2], B0[2][2], B1[2][2]; i32x8 At8[4], B08[2], B18[2];
    unsigned vo[4], vn[4];
    PG8_AOFF(vo, cur);
    const char* cB = (const char*)g.Bt + (size_t)cur.pb * tstep;
    S.a_ready(cur);
    PG8_STAGE(PG8_SB(0, 0), cB, voffB); PG8_STAGE(PG8_SB(0, 1), cB + hstep, voffB); PG8_STAGE_A(PG8_SA(0, 0), 0, vo, 0); PG8_STAGE_A(PG8_SA(0, 1), 0, vo, 1);
    if (wr == 1) PG8_BAR;
    PG8_WAIT_V(2); PG8_BAR;
    PG8_STAGE(PG8_SB(1, 0), cB + kstep, voffB); PG8_STAGE_A(PG8_SA(1, 0), kstep, vo, 0); PG8_STAGE(PG8_SB(1, 1), cB + hstep + kstep, voffB);
    PG8_WAIT_V(6); PG8_BAR;
    for (;;) {
        const bool has_next = S.next(ui + 1, nxt);
        if (has_next) { PG8_AOFF(vn, nxt); } else {
#pragma unroll
            for (int q = 0; q < 4; ++q) vn[q] = vo[q]; }
        const char* nB = has_next ? (const char*)g.Bt + (size_t)nxt.pb * tstep : cB;
#pragma unroll 1
        for (int t = 0; t < nt; t += 2) {
            const bool last = (t == nt - 2);
            const size_t k1 = (size_t)(t + 1) * kstep;
            const size_t k2 = last ? (size_t)0 : (size_t)(t + 2) * kstep, k3 = k2 + kstep;
            const char* b2 = last ? nB : cB + (size_t)(t + 2) * kstep; const char* b3 = b2 + kstep;
            unsigned v2[4];
#pragma unroll
            for (int q = 0; q < 4; ++q) v2[q] = last ? vn[q] : vo[q];
            if (last && has_next) S.a_ready(nxt);
            if constexpr (Epi::PREFETCH) { if (last) E.prefetch(cur, lds + PF_OFF, wid, lane); }
            PG8_LDB(B0, 0, 0); PG8_LDB(B1, 0, 1); PG8_SCHED; PG8_LDA(At, 0, 0); PG8_STAGE_A(PG8_SA(1, 1), k1, vo, 1);
            PG8_WAIT_V(8); PG8_WAIT_L(0); PG8_BAR; PG8_MMA(0, 0, At, B0); PG8_MMA(0, 1, At, B1); PG8_BAR; PG8_SCHED;
            PG8_LDA(At, 0, 1); PG8_STAGE(PG8_SB(0, 0), b2, voffB); PG8_STAGE(PG8_SB(0, 1), b2 + hstep, voffB); PG8_STAGE_A(PG8_SA(0, 0), k2, v2, 0);
            PG8_WAIT_V(8); PG8_WAIT_L(0); PG8_BAR; PG8_MMA(1, 0, At, B0); PG8_MMA(1, 1, At, B1); PG8_BAR; PG8_SCHED;
            PG8_LDB(B0, 1, 0); PG8_LDB(B1, 1, 1); PG8_SCHED; PG8_LDA(At, 1, 0); PG8_STAGE_A(PG8_SA(0, 1), k2, v2, 1);
            PG8_WAIT_V(8); PG8_WAIT_L(0); PG8_BAR; PG8_MMA(0, 0, At, B0); PG8_MMA(0, 1, At, B1); PG8_BAR; PG8_SCHED;
            PG8_LDA(At, 1, 1); PG8_STAGE(PG8_SB(1, 0), b3, voffB); PG8_STAGE(PG8_SB(1, 1), b3 + hstep, voffB); PG8_STAGE_A(PG8_SA(1, 0), k3, v2, 0);
            PG8_WAIT_V(8); PG8_WAIT_L(0); PG8_BAR; PG8_MMA(1, 0, At, B0); PG8_MMA(1, 1, At, B1); PG8_BAR; PG8_SCHED;
        }
        if constexpr (ALIGN_EPI) { if (wr == 0) PG8_BAR; }
        if constexpr (F8) asm volatile("s_nop 15\n\ts_nop 15" ::: "memory");
        E(acc, cur, wr, wc, fr, fq); S.done(cur);
        if (!has_next) break;
        if (!E.keep_acc(cur))
#pragma unroll
        for (int a = 0; a < 2; ++a)
#pragma unroll
            for (int b = 0; b < 2; ++b)
#pragma unroll
                for (int m = 0; m < 4; ++m)
#pragma unroll
                    for (int n = 0; n < 2; ++n) acc[a][b][m][n] = (f32x4){0.f, 0.f, 0.f, 0.f};
        cur = nxt; cB = nB; ++ui;
#pragma unroll
        for (int q = 0; q < 4; ++q) vo[q] = vn[q];
        if constexpr (ALIGN_EPI) { if (wr == 1) PG8_BAR; }
    }
    PG8_WAIT_V(0);
    if constexpr (!ALIGN_EPI) { if (wr == 0) PG8_BAR; }
    PG8_BAR;
#undef PG8_SA
#undef PG8_SB
#undef PG8_STAGE
#undef PG8_STAGE_A
#undef PG8_AOFF
#undef PG8_LDA
#undef PG8_LDB
#undef PG8_MMA
#undef PG8_WAIT_V
#undef PG8_WAIT_L
#undef PG8_BAR
#undef PG8_SCHED
}
}

struct SchedBase {
    __device__ __forceinline__ void a_ready(const pg8::Unit&) const {}
    __device__ __forceinline__ void done(const pg8::Unit&) const {}
};
struct SchedInProj : SchedBase {
    int G, v;
    __device__ __forceinline__ bool next(int i, pg8::Unit& u) const {
        if (INPROJ_XCD_BLOCKS && G == 256) {
            const int x = v >> 5, q_ = i * 32 + (v & 31);
            if (q_ < 136) { const int lt = 8 * x + (q_ & 7); u.pn = q_ >> 3; u.pm = lt + (lt >> 5); }
            else if ((x & 3) == 3 && q_ < 141) { const int r = q_ - 136; u.pm = x == 3 ? 32 : 65; u.pn = r == 0 ? 2 : 4 + r; }
            else return false;
            u.pb = u.pn; u.acol = 0; u.e = 0; u.pos0 = 0; u.cnt = 0; u.base = 0; return true;
        }
        const int L = i * G + v; if (L >= 1098) return false;
        if (L < 1088) { const int gI = L / 136, r = L % 136, lt = 8 * gI + (r & 7); u.pn = r >> 3; u.pm = lt + (lt >> 5); }
        else { const int r = L - 1088, q = r % 5; u.pm = r < 5 ? 32 : 65; u.pn = q == 0 ? 2 : 4 + q; }
        u.pb = u.pn; u.acol = 0; u.e = 0; u.pos0 = 0; u.cnt = 0; u.base = 0; return true;
    }
    __device__ __forceinline__ int arow(const pg8::Unit& u, int rloc) const { return u.pm * 256 + rloc; }
};
struct SchedInProjA : SchedBase {
    int G, v;
    __device__ __forceinline__ bool next(int i, pg8::Unit& u) const {
        const int L = i * G + v; if (L >= 586) return false;
        if (L < 576) { const int gI = L / 72, r = L % 72, lt = 8 * gI + (r & 7); u.pn = r >> 3; u.pm = lt + (lt >> 5); }
        else { const int r = L - 576, q = r % 5; u.pm = r < 5 ? 32 : 65; u.pn = q == 0 ? 2 : 4 + q; }
        u.pb = u.pn; u.acol = 0; u.e = 0; u.pos0 = 0; u.cnt = 0; u.base = 0; return true;
    }
    __device__ __forceinline__ int arow(const pg8::Unit& u, int rloc) const { return u.pm * 256 + rloc; }
};
struct SchedInProjG : SchedBase {
    int G, v;
    __device__ __forceinline__ bool next(int i, pg8::Unit& u) const {
        int L;
        if (G != 256) { L = i * G + v; if (L >= 512) return false; }
        else if (i == 0) L = v; else if (i == 1 && v >= 74) L = 256 + v - 74; else if (i == 2 && v >= 74 && v < 148) L = 438 + v - 74; else return false;
        const int gI = L / 64, r = L % 64, lt = 8 * gI + (r & 7); u.pn = 9 + (r >> 3); u.pm = lt + (lt >> 5);
        u.pb = u.pn - 9; u.acol = 0; u.e = 0; u.pos0 = 0; u.cnt = 0; u.base = 0; return true;
    }
    __device__ __forceinline__ int arow(const pg8::Unit& u, int rloc) const { return u.pm * 256 + rloc; }
};
template <int NPART>
struct SchedTile : SchedBase {
    int G, v;
    __device__ __forceinline__ bool next(int i, pg8::Unit& u) const {
        if (i >= NPART || v >= 256) return false;
        u.pm = 8 * (v >> 5) + (v & 7); u.pn = (v & 31) >> 3; u.pb = i * 4 + u.pn; u.acol = i * 512; u.e = i; u.pos0 = 0; u.cnt = 0; u.base = 0; return true;
    }
    __device__ __forceinline__ int arow(const pg8::Unit& u, int rloc) const { return u.pm * 256 + rloc; }
};
template <int NN, bool GATHER>
struct SchedMoe : SchedBase {
    int G, v; const LAS int* tb; const int* tok;
    __device__ __forceinline__ bool next(int i, pg8::Unit& u) const {
        const int ntile = tb[64 + NE]; int rt;
        if (MOE_XCD_BLOCKS && G == 256) {
            const int RB = (ntile + 7) >> 3, q_ = i * 32 + (v & 31);
            if (q_ >= RB * NN) return false;
            rt = (v >> 5) * RB + q_ / NN; if (rt >= ntile) return false; u.pn = q_ % NN;
        } else { const int L = i * G + v; if (L >= ntile * NN) return false; rt = L / NN; u.pn = L % NN; }
        typedef int i32x4 __attribute__((ext_vector_type(4))); const i32x4 q = *(const LAS i32x4*)(tb + 128 + 4 * rt);
        u.e = q.x; u.pos0 = q.y; u.cnt = q.z; u.base = q.w; u.pm = (u.base + u.pos0) >> 8; u.pb = u.e * NN + u.pn; u.acol = 0; return true;
    }
    __device__ __forceinline__ int arow(const pg8::Unit& u, int rloc) const {
        if (GATHER) { const int pos = u.pos0 + rloc; return tok[u.e * ECAP + (pos < u.cnt ? pos : u.cnt - 1)]; }
        return u.pm * 256 + rloc;
    }
};

__device__ __forceinline__ float fast_sigmoid(float v) { return __builtin_amdgcn_rcpf(1.0f + __builtin_amdgcn_exp2f(-1.4426950408889634f * v)); }
__device__ __forceinline__ unsigned pk4_u8(float x0, float x1, float x2, float x3) {
    const unsigned a = __float_as_uint(fmaf(x0, 255.0f, 8388608.0f)), b = __float_as_uint(fmaf(x1, 255.0f, 8388608.0f)), c_ = __float_as_uint(fmaf(x2, 255.0f, 8388608.0f)), d = __float_as_uint(fmaf(x3, 255.0f, 8388608.0f));
    const unsigned lo = __builtin_amdgcn_perm(b, a, 0x0c0c0400u), hi = __builtin_amdgcn_perm(d, c_, 0x0c0c0400u);
    return __builtin_amdgcn_perm(hi, lo, 0x05040100u);
}
#define EPI_FENCE() do { asm volatile("" ::: "memory"); __builtin_amdgcn_sched_barrier(0); } while (0)
struct EpiInProj {
    static constexpr bool PERM = true, F8 = INPROJ_FP8_ALL, PREFETCH = false;
    static constexpr float ASC = F8 ? 1.0f / W8_SCALE : 1.0f;
    unsigned char* ws; const float *qna, *kna, *qnb, *knb;
    __device__ __forceinline__ bool keep_acc(const pg8::Unit&) const { return false; }
    __device__ __forceinline__ void operator()(pg8::f32x4 (&acc)[2][2][4][2], const pg8::Unit& u, int wr, int wc, int fr_in, int fq_in) const {
        int fr = fr_in, fq = fq_in; asm volatile("" : "+v"(fr), "+v"(fq));
        typedef pg8::f32x4 f32x4; typedef pg8::u32x4 u32x4;
        const int pm = u.pm, pn = u.pn, b = pm / 33, within = pm % 33; const bool isctx = within == 32;
        int kind; size_t wsoff; int colb; int pitch; const float* gn = qna; float scale = 1.0f; bool qrows = true;
        constexpr float QSC = ATT_FP8 ? 2.0f * C2 : C2, KSC = ATT_FP8 ? 0.5f : 1.0f;
        if (pn < 2) { kind = 0; wsoff = WS_QA; colb = (pn * 4 + wc) * 64; pitch = 512; gn = qna; scale = QSC; }
        else if (pn == 2) { qrows = false; pitch = 128; if (wc < 2) { kind = 0; wsoff = WS_KA; colb = wc * 64; gn = kna; scale = KSC; } else { kind = 1; wsoff = WS_VA; colb = (wc - 2) * 64; } }
        else if (pn < 5) { kind = 0; wsoff = WS_QB; colb = ((pn - 3) * 4 + wc) * 64; pitch = 512; gn = qnb; scale = QSC; }
        else if (pn < 7) { kind = 0; qrows = false; wsoff = WS_KB; colb = ((pn - 5) * 4 + wc) * 64; pitch = 512; gn = knb; scale = KSC; }
        else if (pn < 9) { kind = 1; qrows = false; wsoff = WS_VB; colb = ((pn - 7) * 4 + wc) * 64; pitch = 512; }
        else if (pn < 13) { kind = 2; wsoff = WS_G; colb = ((pn - 9) * 4 + wc) * 64; pitch = 2048; }
        else { kind = 2; wsoff = WS_G; colb = 1024 + ((pn - 13) * 4 + wc) * 64; pitch = 2048; }
        char* const dbase = (char*)(ws + wsoff);
        const int rowbase = (qrows ? (pm - b) : pm) * 256 + wr * 64 + fr;
        const unsigned o0 = (unsigned)(rowbase * pitch + colb + 8 * fq) * 2u, pb2 = (unsigned)pitch * 2u;
        if (kind == 0) {
            f32x4 gv[2][2];
#pragma unroll
            for (int bj = 0; bj < 2; ++bj)
#pragma unroll
                for (int n = 0; n < 2; ++n) gv[bj][n] = *(const f32x4*)(gn + 32 * bj + 8 * fq + 4 * n) * scale;
            float irev[4];
#pragma unroll
            for (int q = 0; q < 4; ++q) irev[q] = exp2f(-(float)(4 * fq + q) * (13.287712379549449f / 16.0f)) * 0.15915494309189535f;
#pragma unroll
            for (int ai = 0; ai < 2; ++ai) {
                float cr[4], sr[4];
                { const float pos = (float)(within * 4 + 2 * ai + wr);
#pragma unroll
                  for (int q = 0; q < 4; ++q) { float rev = pos * irev[q]; rev = rev - floorf(rev); cr[q] = __builtin_amdgcn_cosf(rev); sr[q] = __builtin_amdgcn_sinf(rev); } }
#pragma unroll
                for (int m = 0; m < 4; ++m) {
                    float ss = 0.f;
#pragma unroll
                    for (int bj = 0; bj < 2; ++bj)
#pragma unroll
                        for (int n = 0; n < 2; ++n) { const f32x4 x = acc[ai][bj][m][n]; ss += (x[0] * x[0] + x[1] * x[1]) + (x[2] * x[2] + x[3] * x[3]); }
                    ss += __shfl_xor(ss, 16); ss += __shfl_xor(ss, 32);
                    const float rstd = 1.0f / sqrtf(ss * (1.0f / 64.0f) + 1e-6f / (ASC * ASC));
                    float cc[4], sc[4];
                    { const float pos = (float)(16 * m + fr);
#pragma unroll
                      for (int q = 0; q < 4; ++q) { float rev = pos * irev[q]; rev = rev - floorf(rev); cc[q] = __builtin_amdgcn_cosf(rev); sc[q] = __builtin_amdgcn_sinf(rev); } }
                    const unsigned orow = o0 + (unsigned)(ai * 128 + m * 16) * pb2;
#pragma unroll
                    for (int bj = 0; bj < 2; ++bj) {
                        f32x4 x0 = acc[ai][bj][m][0] * rstd * gv[bj][0], x1 = acc[ai][bj][m][1] * rstd * gv[bj][1];
                        if (!isctx) {
                            const float c0 = bj ? cc[0] : cr[0], s0 = bj ? sc[0] : sr[0], c1 = bj ? cc[1] : cr[1], s1 = bj ? sc[1] : sr[1];
                            const float c2 = bj ? cc[2] : cr[2], s2 = bj ? sc[2] : sr[2], c3 = bj ? cc[3] : cr[3], s3 = bj ? sc[3] : sr[3];
                            x0 = (f32x4){x0[0] * c0 - x0[1] * s0, x0[0] * s0 + x0[1] * c0, x0[2] * c1 - x0[3] * s1, x0[2] * s1 + x0[3] * c1};
                            x1 = (f32x4){x1[0] * c2 - x1[1] * s2, x1[0] * s2 + x1[1] * c2, x1[2] * c3 - x1[3] * s3, x1[2] * s3 + x1[3] * c3};
                        }
                        if (ATT_FP8) { typedef unsigned u32x2 __attribute__((ext_vector_type(2))); u32x2 w; w.x = pk4_fp8(x0[0], x0[1], x0[2], x0[3]); w.y = pk4_fp8(x1[0], x1[1], x1[2], x1[3]);
                            *(u32x2*)(dbase + (orow >> 1) + 32 * bj) = w; }
                        else { u32x4 w; w.x = pg8::cvt_pk_bf16(x0[0], x0[1]); w.y = pg8::cvt_pk_bf16(x0[2], x0[3]); w.z = pg8::cvt_pk_bf16(x1[0], x1[1]); w.w = pg8::cvt_pk_bf16(x1[2], x1[3]);
                        *(u32x4*)(dbase + orow + 64 * bj) = w; }
                    }
                    EPI_FENCE();
                }
            }
        } else if (ATT_FP8 && kind == 1) {
            const int dvw = (pn == 2) ? 64 : 128;
            const int head = (pn == 2) ? (wc - 2) : (colb >> 7), dv0 = (pn == 2) ? 0 : (colb & 127);
            unsigned char* const vt = (unsigned char*)dbase + (size_t)((b * (pn == 2 ? 2 : 4) + head) * (SK / 64)) * (size_t)(dvw * 64);
#pragma unroll
            for (int ai = 0; ai < 2; ++ai)
#pragma unroll
                for (int m = 0; m < 4; ++m) {
                    const int t = within * 4 + 2 * ai + wr, k5 = (m & 1) * 16 + fr, slot = 16 * (m >> 1) + (k5 & 3) + 4 * (k5 >> 3), hh = (k5 >> 2) & 1;
                    unsigned char* const rowp = vt + (size_t)t * (size_t)(dvw * 64) + hh * 32 + slot;
#pragma unroll
                    for (int bj = 0; bj < 2; ++bj) {
                        const f32x4 x0 = acc[ai][bj][m][0] * ASC, x1 = acc[ai][bj][m][1] * ASC;
                        const unsigned w0 = pk4_fp8(x0[0], x0[1], x0[2], x0[3]), w1 = pk4_fp8(x1[0], x1[1], x1[2], x1[3]);
                        unsigned char* const q = rowp + (dv0 + 32 * bj + 8 * fq) * 64;
                        q[0] = (unsigned char)w0; q[64] = (unsigned char)(w0 >> 8); q[128] = (unsigned char)(w0 >> 16); q[192] = (unsigned char)(w0 >> 24);
                        q[256] = (unsigned char)w1; q[320] = (unsigned char)(w1 >> 8); q[384] = (unsigned char)(w1 >> 16); q[448] = (unsigned char)(w1 >> 24);
                    }
                    EPI_FENCE();
                }
        } else {
#pragma unroll
            for (int ai = 0; ai < 2; ++ai)
#pragma unroll
                for (int m = 0; m < 4; ++m) {
                    const unsigned orow = o0 + (unsigned)(ai * 128 + m * 16) * pb2;
#pragma unroll
                    for (int bj = 0; bj < 2; ++bj) {
                        f32x4 x0 = acc[ai][bj][m][0] * ASC, x1 = acc[ai][bj][m][1] * ASC;
                        if (kind == 2) { x0 = (f32x4){fast_sigmoid(x0[0]), fast_sigmoid(x0[1]), fast_sigmoid(x0[2]), fast_sigmoid(x0[3])}; x1 = (f32x4){fast_sigmoid(x1[0]), fast_sigmoid(x1[1]), fast_sigmoid(x1[2]), fast_sigmoid(x1[3])}; }
                        if (G_U8 && kind == 2) { typedef unsigned u32x2 __attribute__((ext_vector_type(2))); u32x2 w; w.x = pk4_u8(x0[0], x0[1], x0[2], x0[3]); w.y = pk4_u8(x1[0], x1[1], x1[2], x1[3]);
                            *(u32x2*)(dbase + (orow >> 1) + 32 * bj) = w; }
                        else { u32x4 w; w.x = pg8::cvt_pk_bf16(x0[0], x0[1]); w.y = pg8::cvt_pk_bf16(x0[2], x0[3]); w.z = pg8::cvt_pk_bf16(x1[0], x1[1]); w.w = pg8::cvt_pk_bf16(x1[2], x1[3]);
                        *(u32x4*)(dbase + orow + 64 * bj) = w; }
                    }
                    EPI_FENCE();
                }
        }
    }
};
struct EpiInProjG {
    static constexpr bool PERM = true, F8 = true, PREFETCH = false;
    unsigned char* ws;
    __device__ __forceinline__ bool keep_acc(const pg8::Unit&) const { return false; }
    __device__ __forceinline__ void operator()(pg8::f32x4 (&acc)[2][2][4][2], const pg8::Unit& u, int wr, int wc, int fr_in, int fq_in) const {
        int fr = fr_in, fq = fq_in; asm volatile("" : "+v"(fr), "+v"(fq));
        typedef pg8::f32x4 f32x4; typedef pg8::u32x4 u32x4;
        const int pm = u.pm, pn = u.pn, b = pm / 33;
        const int colb = ((pn - 9) * 4 + wc) * 64;
        char* const dbase = (char*)(ws + WS_G);
        const int rowbase = (pm - b) * 256 + wr * 64 + fr;
        const unsigned o0 = (unsigned)(rowbase * 2048 + colb + 8 * fq) * 2u, pb2 = 2048u * 2u;
        constexpr float ASC = 1.0f / W8_SCALE;
#pragma unroll
        for (int ai = 0; ai < 2; ++ai)
#pragma unroll
            for (int m = 0; m < 4; ++m) {
                const unsigned orow = o0 + (unsigned)(ai * 128 + m * 16) * pb2;
#pragma unroll
                for (int bj = 0; bj < 2; ++bj) {
                    f32x4 x0 = acc[ai][bj][m][0] * ASC, x1 = acc[ai][bj][m][1] * ASC;
                    x0 = (f32x4){fast_sigmoid(x0[0]), fast_sigmoid(x0[1]), fast_sigmoid(x0[2]), fast_sigmoid(x0[3])}; x1 = (f32x4){fast_sigmoid(x1[0]), fast_sigmoid(x1[1]), fast_sigmoid(x1[2]), fast_sigmoid(x1[3])};
                    u32x4 w; w.x = pg8::cvt_pk_bf16(x0[0], x0[1]); w.y = pg8::cvt_pk_bf16(x0[2], x0[3]); w.z = pg8::cvt_pk_bf16(x1[0], x1[1]); w.w = pg8::cvt_pk_bf16(x1[2], x1[3]);
                    *(u32x4*)(dbase + orow + 64 * bj) = w;
                }
                EPI_FENCE();
            }
    }
};
struct EpiMerge {
    static constexpr bool PERM = true, F8 = MERGE_FP8, PREFETCH = false;
    const bf16* G; bf16* MG;
    __device__ __forceinline__ bool keep_acc(const pg8::Unit& u) const { return u.e == 0; }
    __device__ __forceinline__ void operator()(pg8::f32x4 (&acc)[2][2][4][2], const pg8::Unit& u, int wr, int wc, int fr_in, int fq_in) const {
        int fr = fr_in, fq = fq_in; asm volatile("" : "+v"(fr), "+v"(fq));
        typedef pg8::f32x4 f32x4; typedef pg8::u32x4 u32x4;
        const int part = u.e; const unsigned row0 = (unsigned)(u.pm * 256 + wr * 64 + fr), col0 = (unsigned)(u.pn * 256 + wc * 32 + 8 * fq);
        const char* const gb = (const char*)G; char* const mb = (char*)MG;
        constexpr float P0SC = F8 ? 1.0f / YA8_SCALE : 1.0f;
        constexpr float P1SC = (F8 ? MG8_SCALE / W8_SCALE : 1.0f) * (G_U8 ? 1.0f / 255.0f : 1.0f);
        constexpr float GFLOOR = G_U8 ? 1e-6f : 1e-30f;
#define UNPK(WW, LO, HI) const f32x4 LO = G_U8 ? (f32x4){(float)(WW.x & 0xffu), (float)((WW.x >> 8) & 0xffu), (float)((WW.x >> 16) & 0xffu), (float)(WW.x >> 24)} \
                                              : (f32x4){__uint_as_float(WW.x << 16), __uint_as_float(WW.x & 0xffff0000u), __uint_as_float(WW.y << 16), __uint_as_float(WW.y & 0xffff0000u)}; \
                        const f32x4 HI = G_U8 ? (f32x4){(float)(WW.y & 0xffu), (float)((WW.y >> 8) & 0xffu), (float)((WW.y >> 16) & 0xffu), (float)(WW.y >> 24)} \
                                              : (f32x4){__uint_as_float(WW.z << 16), __uint_as_float(WW.z & 0xffff0000u), __uint_as_float(WW.w << 16), __uint_as_float(WW.w & 0xffff0000u)}
#pragma unroll
        for (int ai = 0; ai < 2; ++ai) {
            u32x4 wbv[8], wav[8];
#pragma unroll
            for (int q = 0; q < 8; ++q) { const unsigned row = row0 + (unsigned)(ai * 128 + (q >> 1) * 16), col = col0 + (unsigned)((q & 1) * 128); const unsigned gel = (row * 2048u + col) * (G_U8 ? 1u : 2u);
                if (G_U8) { typedef unsigned u32x2 __attribute__((ext_vector_type(2))); const u32x2 tb_ = *(const u32x2*)(gb + gel + 1024u), ta_ = *(const u32x2*)(gb + gel);
                    wbv[q] = (u32x4){tb_.x, tb_.y, 0u, 0u}; wav[q] = (u32x4){ta_.x, ta_.y, 0u, 0u}; }
                else { wbv[q] = *(const u32x4*)(gb + gel + 2048u); wav[q] = *(const u32x4*)(gb + gel); } }
#pragma unroll
            for (int q = 0; q < 8; ++q) { const int m = q >> 1, bj = q & 1;
                const unsigned row = row0 + (unsigned)(ai * 128 + m * 16), col = col0 + (unsigned)(bj * 128);
                const u32x4 wb = wbv[q];
                UNPK(wb, b0, b1);
                f32x4 c0, c1;
#pragma unroll
                for (int j = 0; j < 4; ++j) { c0[j] = fmaxf(b0[j], GFLOOR); c1[j] = fmaxf(b1[j], GFLOOR); }
                if (part == 0) {
                    const u32x4 wa = wav[q];
                    UNPK(wa, a0, a1);
#pragma unroll
                    for (int j = 0; j < 4; ++j) { acc[ai][bj][m][0][j] *= a0[j] * P0SC * __builtin_amdgcn_rcpf(c0[j]); acc[ai][bj][m][1][j] *= a1[j] * P0SC * __builtin_amdgcn_rcpf(c1[j]); }
                } else {
                    const f32x4 x0 = acc[ai][bj][m][0] * c0 * P1SC, x1 = acc[ai][bj][m][1] * c1 * P1SC;
                    if constexpr (F8) { typedef unsigned u32x2 __attribute__((ext_vector_type(2))); u32x2 w; w.x = pk4_fp8(x0[0], x0[1], x0[2], x0[3]); w.y = pk4_fp8(x1[0], x1[1], x1[2], x1[3]); *(u32x2*)(mb + (row * 1024u + col)) = w; }
                    else { u32x4 w; w.x = pg8::cvt_pk_bf16(x0[0], x0[1]); w.y = pg8::cvt_pk_bf16(x0[2], x0[3]); w.z = pg8::cvt_pk_bf16(x1[0], x1[1]); w.w = pg8::cvt_pk_bf16(x1[2], x1[3]);
                    *(u32x4*)(mb + (row * 1024u + col) * 2u) = w; } }
            }
            EPI_FENCE();
        }
#undef UNPK
    }
};
struct EpiOut {
    static constexpr bool PERM = false, F8 = MERGE_FP8, PREFETCH = false;
    const float* x; const float* MOD; float* out;
    __device__ __forceinline__ bool keep_acc(const pg8::Unit&) const { return false; }
    __device__ __forceinline__ void operator()(pg8::f32x4 (&acc)[2][2][4][2], const pg8::Unit& u, int wr, int wc, int fr_in, int fq_in) const {
        int fr = fr_in, fq = fq_in; asm volatile("" : "+v"(fr), "+v"(fq));
        typedef pg8::f32x4 f32x4;
        const unsigned row0 = (unsigned)(u.pm * 256 + wr * 64 + fr), col0 = (unsigned)(u.pn * 256 + wc * 32 + 4 * fq); const int b = u.pm >> 5;
        const float* ga = MOD + b * NMOD + 2 * D; const char* const xb = (const char*)x; char* const ob = (char*)out;
        const unsigned e0 = (row0 * 1024u + col0) * 4u;
#pragma unroll
        for (int bj = 0; bj < 2; ++bj)
#pragma unroll
            for (int n = 0; n < 2; ++n) { const f32x4 gv = *(const f32x4*)(ga + col0 + bj * 128 + n * 16) * (F8 ? 1.0f / (MG8_SCALE * W8_SCALE) : 1.0f);
                f32x4 xv[8];
#pragma unroll
                for (int q = 0; q < 8; ++q) xv[q] = *(const f32x4*)(xb + e0 + (unsigned)((((q >> 2) * 128 + (q & 3) * 16) * 1024 + bj * 128 + n * 16) * 4));
#pragma unroll
                for (int q = 0; q < 8; ++q) { const f32x4 r_ = xv[q] + gv * acc[q >> 2][bj][q & 3][n];
                    const unsigned eo = e0 + (unsigned)((((q >> 2) * 128 + (q & 3) * 16) * 1024 + bj * 128 + n * 16) * 4);
                    if (X1_BF16) { uint2 w_; w_.x = pk2(r_.x, r_.y); w_.y = pk2(r_.z, r_.w); *(uint2*)(ob + (eo >> 1)) = w_; }
                    else *(f32x4*)(ob + eo) = r_; }
                EPI_FENCE(); }
    }
};
struct EpiMoe1 {
    static constexpr bool PERM = true, F8 = MOE_FP8, PREFETCH = EPI_PREFETCH;
    const float *bg, *bu; bf16* ACT; const LAS unsigned char* pfl;
    __device__ __forceinline__ void prefetch(const pg8::Unit& u, LAS unsigned char* pf, int wid, int lane) const {
        if (wid == 0) { const float* src = (lane < 32 ? bg : bu) + u.e * D + u.pn * 128 + 4 * (lane & 31);
            __builtin_amdgcn_global_load_lds((const unsigned*)src, (LAS unsigned*)pf, 16, 0, 0); } }
    __device__ __forceinline__ bool keep_acc(const pg8::Unit&) const { return false; }
    __device__ __forceinline__ void operator()(pg8::f32x4 (&acc)[2][2][4][2], const pg8::Unit& u, int wr, int wc, int fr_in, int fq_in) const {
        int fr = fr_in, fq = fq_in; asm volatile("" : "+v"(fr), "+v"(fq));
        typedef pg8::f32x4 f32x4; typedef pg8::u32x4 u32x4; typedef float f32x2 __attribute__((ext_vector_type(2)));
        const int col0 = u.pn * 128 + wc * 32 + 8 * fq; const unsigned row0 = (unsigned)(u.pm * 256 + wr * 64 + fr);
        f32x4 bg0, bg1, bu0, bu1;
        if constexpr (PREFETCH) { const LAS float* pf = (const LAS float*)pfl + wc * 32 + 8 * fq; bg0 = *(const LAS f32x4*)pf; bg1 = *(const LAS f32x4*)(pf + 4); bu0 = *(const LAS f32x4*)(pf + 128); bu1 = *(const LAS f32x4*)(pf + 132); }
        else { bg0 = *(const f32x4*)(bg + u.e * D + col0); bg1 = *(const f32x4*)(bg + u.e * D + col0 + 4); bu0 = *(const f32x4*)(bu + u.e * D + col0); bu1 = *(const f32x4*)(bu + u.e * D + col0 + 4); }
        char* const ab = (char*)ACT; const unsigned e0 = (row0 * 1024u + (unsigned)col0) * (F8 ? 1u : 2u);
        constexpr float ASC = F8 ? 1.0f / W8_SCALE : 1.0f;
#pragma unroll
        for (int ai = 0; ai < 2; ++ai)
#pragma unroll
            for (int m = 0; m < 4; ++m) {
                unsigned w[4] = {0u, 0u, 0u, 0u}; f32x2 oo[2][2];
#pragma unroll
                for (int n = 0; n < 2; ++n) { const f32x4 gt = acc[ai][0][m][n] * ASC + (n ? bg1 : bg0), up = acc[ai][1][m][n] * ASC + (n ? bu1 : bu0);
#pragma unroll
                    for (int hj = 0; hj < 2; ++hj) {
                        f32x2 g2 = {fminf(gt[2 * hj], 7.0f), fminf(gt[2 * hj + 1], 7.0f)};
                        const f32x2 u2 = {__builtin_amdgcn_fmed3f(up[2 * hj], -7.0f, 7.0f), __builtin_amdgcn_fmed3f(up[2 * hj + 1], -7.0f, 7.0f)};
                        const f32x2 tt = g2 * (-1.702f * 1.4426950408889634f);
                        f32x2 den = {__builtin_amdgcn_exp2f(tt.x), __builtin_amdgcn_exp2f(tt.y)}; den = den + 1.0f;
                        const f32x2 sg = {__builtin_amdgcn_rcpf(den.x), __builtin_amdgcn_rcpf(den.y)};
                        const f32x2 gs = g2 * sg, o2 = u2 * gs + gs;
                        if constexpr (F8) oo[n][hj] = o2 * ACT8_SCALE;
                        else w[2 * n + hj] = pg8::cvt_pk_bf16(o2.x, o2.y); } }
                if constexpr (F8) {
#pragma unroll
                    for (int n = 0; n < 2; ++n) { int r = __builtin_amdgcn_cvt_pk_fp8_f32(oo[n][0].x, oo[n][0].y, 0, false); r = __builtin_amdgcn_cvt_pk_fp8_f32(oo[n][1].x, oo[n][1].y, r, true); w[n] = (unsigned)r; } }
                if constexpr (F8) { typedef unsigned u32x2 __attribute__((ext_vector_type(2))); u32x2 wv; wv.x = w[0]; wv.y = w[1]; *(u32x2*)(ab + e0 + (unsigned)((ai * 128 + m * 16) * 1024)) = wv; }
                else { u32x4 wv; wv.x = w[0]; wv.y = w[1]; wv.z = w[2]; wv.w = w[3];
                *(u32x4*)(ab + e0 + (unsigned)((ai * 128 + m * 16) * 2048)) = wv; }
                EPI_FENCE();
            }
    }
};
struct EpiMoe2 {
    static constexpr bool PERM = true, F8 = MOE_FP8, PREFETCH = EPI_PREFETCH;
    const float* bd; const float* SW; const int* SDST; bf16* Y; const LAS unsigned char* pfl;
    __device__ __forceinline__ void prefetch(const pg8::Unit& u, LAS unsigned char* pf, int wid, int lane) const {
        if (wid < 3) { const void* src = wid == 0 ? (const void*)(bd + u.e * D + u.pn * 256 + 4 * lane) : wid == 1 ? (const void*)(SW + u.e * ECAP + u.pos0 + 4 * lane) : (const void*)(SDST + u.e * ECAP + u.pos0 + 4 * lane);
            __builtin_amdgcn_global_load_lds((const unsigned*)src, (LAS unsigned*)(pf + wid * 1024), 16, 0, 0); } }
    __device__ __forceinline__ bool keep_acc(const pg8::Unit&) const { return false; }
    __device__ __forceinline__ void operator()(pg8::f32x4 (&acc)[2][2][4][2], const pg8::Unit& u, int wr, int wc, int fr_in, int fq_in) const {
        int fr = fr_in, fq = fq_in; asm volatile("" : "+v"(fr), "+v"(fq));
        typedef pg8::f32x4 f32x4; typedef pg8::u32x4 u32x4;
        const int col0 = u.pn * 256 + wc * 32 + 8 * fq;
        f32x4 bv[2][2];
#pragma unroll
        for (int bj = 0; bj < 2; ++bj)
#pragma unroll
            for (int n = 0; n < 2; ++n) { if constexpr (PREFETCH) bv[bj][n] = *(const LAS f32x4*)((const LAS float*)pfl + wc * 32 + 8 * fq + bj * 128 + 4 * n); else bv[bj][n] = *(const f32x4*)(bd + u.e * D + col0 + bj * 128 + 4 * n); }
        char* const yb = (char*)Y;
        constexpr float ASC = F8 ? 1.0f / (W8_SCALE * ACT8_SCALE) : 1.0f;
        float wv[8]; int dv[8];
#pragma unroll
        for (int q = 0; q < 8; ++q) { const int rl = (q >> 2) * 128 + wr * 64 + (q & 3) * 16 + fr, pos = u.pos0 + rl; const bool ok = pos < u.cnt; const int pc = ok ? pos : u.cnt - 1; int d;
            if constexpr (PREFETCH) { wv[q] = *((const LAS float*)pfl + 256 + rl); d = *((const LAS int*)pfl + 512 + rl); }
            else { wv[q] = SW[u.e * ECAP + pc]; d = SDST[u.e * ECAP + pc]; }
            dv[q] = ok ? d : (int)((WS_TRASH - WS_Y) / ((Y_FP8 ? 1 : 2) * D)); }
#pragma unroll
        for (int ai = 0; ai < 2; ++ai)
#pragma unroll
            for (int m = 0; m < 4; ++m) {
                const float w = wv[ai * 4 + m] * (Y_FP8 ? Y8_SCALE : 1.0f); const unsigned dst = ((unsigned)dv[ai * 4 + m] * 1024u + (unsigned)col0) * (Y_FP8 ? 1u : 2u);
#pragma unroll
                for (int bj = 0; bj < 2; ++bj) { const f32x4 x0 = (acc[ai][bj][m][0] * ASC + bv[bj][0]) * w, x1 = (acc[ai][bj][m][1] * ASC + bv[bj][1]) * w;
                    if constexpr (Y_FP8 != 0) { typedef unsigned u32x2 __attribute__((ext_vector_type(2))); u32x2 o; o.x = pk4_fp8(x0[0], x0[1], x0[2], x0[3]); o.y = pk4_fp8(x1[0], x1[1], x1[2], x1[3]); *(u32x2*)(yb + dst + bj * 128) = o; }
                    else { u32x4 o; o.x = pg8::cvt_pk_bf16(x0[0], x0[1]); o.y = pg8::cvt_pk_bf16(x0[2], x0[3]); o.z = pg8::cvt_pk_bf16(x1[0], x1[1]); o.w = pg8::cvt_pk_bf16(x1[2], x1[3]);
                    *(u32x4*)(yb + dst + bj * 256) = o; } }
            }
    }
};
#include <hip/hip_bf16.h>
#ifndef ATT_DMAPOS
#define ATT_DMAPOS 0
#endif
#ifndef ATT_PRIO
#define ATT_PRIO 1
#endif
namespace attn_body {
using bf16=__hip_bfloat16;
using bf16x8=__attribute__((ext_vector_type(8)))short;
using s16x4=__attribute__((ext_vector_type(4)))short;
using f32x16=__attribute__((ext_vector_type(16)))float;
using u32x4=__attribute__((ext_vector_type(4)))unsigned;
constexpr int D=64;
constexpr int NW=8,QBLK=32,QB=QBLK*NW,KVBLK=64;
#ifndef ONES8_PIN_B
#define ONES8_PIN_B 1
#endif
__device__ __forceinline__ int crow(int r,int hi){return (r&3)+8*(r>>2)+4*hi;}
#define SBAR() __builtin_amdgcn_sched_barrier(0)
constexpr int NSLOT=3, SLOTB=8192;
constexpr int LDS_K=0, LDS_V=NSLOT*SLOTB, LDS_WS=2*NSLOT*SLOTB, LDS_OST=LDS_WS+NW*64*4, LDS_BYTES=LDS_OST+NW*4096;
__device__ __forceinline__ void glds16(const void*gsrc,unsigned lds_dst){unsigned keep;
  asm volatile("s_mov_b32 %0, m0\n\ts_mov_b32 m0, %2\n\ts_nop 0\n\tglobal_load_lds_dwordx4 %1, off\n\ts_mov_b32 m0, %0":"=&s"(keep):"v"(gsrc),"s"(lds_dst):"memory");}
__device__ __forceinline__ float max3f(float a,float b,float c){float r;asm("v_max3_f32 %0, %1, %2, %3":"=v"(r):"v"(a),"v"(b),"v"(c));return r;}
__device__ __forceinline__ float max2f(float a,float b){float r;asm("v_max_f32_e32 %0, %1, %2":"=v"(r):"v"(a),"v"(b));return r;}
__device__ __forceinline__ float fadd_s(float a,float b){float r;asm("v_add_f32_e32 %0, %1, %2":"=v"(r):"v"(a),"v"(b));return r;}
__device__ __forceinline__ float fsub_s(float a,float b){float r;asm("v_sub_f32_e32 %0, %1, %2":"=v"(r):"v"(a),"v"(b));return r;}
typedef float f32x2_t __attribute__((ext_vector_type(2))); typedef __bf16 bf16x2_t __attribute__((ext_vector_type(2)));
__device__ __forceinline__ unsigned cvtpk_s(float lo,float hi){f32x2_t v={lo,hi};bf16x2_t b=__builtin_convertvector(v,bf16x2_t);return __builtin_bit_cast(unsigned,b);}
#define WAIT_BAR(N) asm volatile("s_waitcnt vmcnt(" #N ") lgkmcnt(0)\n\ts_barrier":::"memory")

__device__ __forceinline__ void qkt(f32x16&p0,f32x16&p1,const char*Kslot,const bf16x8*qr,const f32x16&negm,int r32,int hi){
  const char*kb=Kslot+hi*1024+r32*16;
  #pragma unroll
  for(int d0=0;d0<4;++d0){
    const bf16x8 b0=*reinterpret_cast<const bf16x8*>(kb+d0*2048);
    const bf16x8 b1=*reinterpret_cast<const bf16x8*>(kb+d0*2048+512);
    if(d0==0){p0=__builtin_amdgcn_mfma_f32_32x32x16_bf16(b0,qr[0],negm,0,0,0);p1=__builtin_amdgcn_mfma_f32_32x32x16_bf16(b1,qr[0],negm,0,0,0);}
    else{p0=__builtin_amdgcn_mfma_f32_32x32x16_bf16(b0,qr[d0],p0,0,0,0);p1=__builtin_amdgcn_mfma_f32_32x32x16_bf16(b1,qr[d0],p1,0,0,0);}}
}
typedef __attribute__((address_space(3))) const char* lds_cptr;
typedef short v4i16_t __attribute__((ext_vector_type(4)));
__device__ __forceinline__ void kload8(bf16x8*kf,lds_cptr kp){
  kf[0]=*(const __attribute__((address_space(3))) bf16x8*)(kp);      kf[1]=*(const __attribute__((address_space(3))) bf16x8*)(kp+512);
  kf[2]=*(const __attribute__((address_space(3))) bf16x8*)(kp+2048); kf[3]=*(const __attribute__((address_space(3))) bf16x8*)(kp+2560);
  kf[4]=*(const __attribute__((address_space(3))) bf16x8*)(kp+4096); kf[5]=*(const __attribute__((address_space(3))) bf16x8*)(kp+4608);
  kf[6]=*(const __attribute__((address_space(3))) bf16x8*)(kp+6144); kf[7]=*(const __attribute__((address_space(3))) bf16x8*)(kp+6656);
}
__device__ __forceinline__ void kload2(bf16x8*kf,lds_cptr kp,int j){ kf[2*j]=*(const __attribute__((address_space(3))) bf16x8*)(kp+j*2048); kf[2*j+1]=*(const __attribute__((address_space(3))) bf16x8*)(kp+j*2048+512); }
__device__ __forceinline__ s16x4 vtr(lds_cptr p){ return __builtin_bit_cast(s16x4,__builtin_amdgcn_ds_read_tr16_b64_v4i16((__attribute__((address_space(3))) v4i16_t*)p)); }
template<int DV> struct Lds2 { static constexpr int VSLOT=DV*128, K=0, V=NSLOT*SLOTB, WS=V+NSLOT*VSLOT, OST=WS+NW*64*4, BYTES=OST+NW*4096; };
template<int DV,bool ONES,int NT,int QP,int KP,int VP,int OP,int O8=0> __device__ __forceinline__ void attn_unit2(const bf16*Qu,const bf16*__restrict__ Kb,const bf16*__restrict__ Vb,bf16*Ou,char*shm){
  typedef Lds2<DV> L; constexpr int ND=DV/32, NV=DV/64, VSLOT=L::VSLOT;
  const int tid=threadIdx.x,lane=tid&63,r32=lane&31,hi=lane>>5; const int wid=__builtin_amdgcn_readfirstlane(tid>>6);
  const bf16*Qw=Qu+(long)(wid*QBLK)*QP;
  const unsigned lds0=(unsigned)(uintptr_t)shm;
  float*wsf=(float*)(shm+L::WS)+wid*64;
  const bf16*ksrc=Kb+(long)lane*KP+wid*8;
  const bf16*vsrc=Vb+(long)(16*(wid&3)+(lane>>2))*VP+(wid>>2)*32+(lane&3)*8;
  const unsigned kdst=lds0+L::K+wid*1024, vdst=lds0+L::V+wid*1024;
  #define DMA_K(t,slot) glds16(ksrc+(long)(t)*KVBLK*KP,(unsigned)__builtin_amdgcn_readfirstlane(kdst+(slot)*SLOTB))
  #define DMA_V(t,slot) do{ _Pragma("unroll") for(int q_=0;q_<NV;++q_) glds16(vsrc+(long)(t)*KVBLK*VP+q_*64,(unsigned)__builtin_amdgcn_readfirstlane(vdst+(slot)*VSLOT+q_*8192)); }while(0)
  #define WAITB_KV() do{ if constexpr(NV==1) asm volatile("s_waitcnt vmcnt(2) lgkmcnt(0)\n\ts_barrier":::"memory"); else asm volatile("s_waitcnt vmcnt(3) lgkmcnt(0)\n\ts_barrier":::"memory"); }while(0)
  #define WAITB_V()  do{ if constexpr(NV==1) asm volatile("s_waitcnt vmcnt(1) lgkmcnt(0)\n\ts_barrier":::"memory"); else asm volatile("s_waitcnt vmcnt(2) lgkmcnt(0)\n\ts_barrier":::"memory"); }while(0)
  #define WAITB_0()  asm volatile("s_waitcnt vmcnt(0) lgkmcnt(0)\n\ts_barrier":::"memory")
  const char*Kbase=shm+L::K; bf16x8 kf[8];
  const lds_cptr shm3=(lds_cptr)shm; const lds_cptr kp0=shm3+L::K+hi*1024+r32*16; const lds_cptr vp0=shm3+L::V+((lane>>4)&1)*32+(lane&3)*8+(4*hi+((lane&15)>>2))*64;
  DMA_K(0,0);DMA_V(0,0);DMA_K(1,1);
  bf16x8 qr[4];
  #pragma unroll
  for(int d0=0;d0<4;++d0)qr[d0]=*reinterpret_cast<const bf16x8*>(&Qw[(long)r32*QP+d0*16+hi*8]);
  float l_reg=0.f; f32x16 o[ND]; f32x16 os=f32x16{};
  #pragma unroll
  for(int d_=0;d_<ND;++d_)o[d_]=f32x16{};
  const f32x16 zero16=f32x16{};
  const bf16x8 ones={(short)0x3F80,(short)0x3F80,(short)0x3F80,(short)0x3F80,(short)0x3F80,(short)0x3F80,(short)0x3F80,(short)0x3F80};
  f32x16 pA0,pA1,pB0,pB1;
  int sp=0,sc=0,sn=1;
  #define ROT() do{sp=sc;sc=sn;sn=(sn==NSLOT-1)?0:sn+1;}while(0)
  DMA_K(2,2);
  asm volatile("s_waitcnt vmcnt(3) lgkmcnt(0)\n\ts_barrier":::"memory");
  qkt(pA0,pA1,Kbase,qr,zero16,r32,hi);asm volatile("s_nop 15\n\ts_nop 7":"+v"(pA0),"+v"(pA1));
  _Pragma("unroll") for(int r=0;r<16;++r){pA0[r]=__builtin_amdgcn_exp2f(pA0[r]);pA1[r]=__builtin_amdgcn_exp2f(pA1[r]);}
  WAITB_0();
  DMA_K(3,0);DMA_V(1,1);
  ROT();
  kload8(kf,kp0+sc*SLOTB);
  WAITB_KV();
  s16x4 vlo[4*ND],vhi[4*ND]; u32x4 pw0,pw1,pw2,pw3;
  #define PKW(P,B) cvtpk_s(P[B],P[B+1])
  #define PAF(k) __builtin_bit_cast(bf16x8,pw##k)
  #define VFR(i) (bf16x8){vlo[i][0],vlo[i][1],vlo[i][2],vlo[i][3],vhi[i][0],vhi[i][1],vhi[i][2],vhi[i][3]}
  #define PIN(x) asm volatile("":"+v"(x))
  #define MF(a,b,c) __builtin_amdgcn_mfma_f32_32x32x16_bf16(a,b,c,0,0,0)
  #define EX(v) __builtin_amdgcn_exp2f(v)
  #define EXQ(C0,C1,e) do{ if((e)<16) C0[(e)&15]=EX(C0[(e)&15]); else C1[(e)&15]=EX(C1[(e)&15]); }while(0)
  #define VRD(i) do{ vlo[i]=vtr(vp_+(((i)>>2)*4096+((i)&3)*1024)); vhi[i]=vtr(vp_+(((i)>>2)*4096+((i)&3)*1024+512)); }while(0)
  #define KRD(G,j) do{ if(G){ kload2(kf,kp0+sn*SLOTB,j); SBAR(); } }while(0)
  #define GAPA(DST,MFX,A0,A1,A2,A3,W0,W1,PW) do{ DST=MFX; PIN(DST); if constexpr(!ONES){ sacc+=A0; sacc+=A1; sacc+=A2; sacc+=A3; PIN(sacc); } W0; W1; PIN(PW); SBAR(); }while(0)
  #define GAPB(DST,MFX,C0,C1,e0,NE) do{ DST=MFX; PIN(DST); _Pragma("unroll") for(int e_=0;e_<(NE);++e_) EXQ(C0,C1,(e0)+e_); PIN(C0); PIN(C1); SBAR(); }while(0)
  #define STEP(C0,C1,P0,P1,t,GK,GV,GL) do{ SBAR(); \
    const lds_cptr vp_=vp0+sp*VSLOT; \
    VRD(0); SBAR(); float sacc=0.f; if constexpr(!ONES){ sacc=(P0[0]+P0[1]); } \
    GAPA(C0,MF(kf[0],qr[0],zero16), P0[2],P0[3],P0[4],P0[5],     pw0[0]=PKW(P0,0), pw0[1]=PKW(P0,2), pw0); \
    VRD(4); SBAR(); GAPA(C1,MF(kf[1],qr[0],zero16), P0[6],P0[7],P0[8],P0[9],     pw0[2]=PKW(P0,4), pw0[3]=PKW(P0,6), pw0); \
    VRD(1); SBAR(); GAPA(C0,MF(kf[2],qr[1],C0),   P0[10],P0[11],P0[12],P0[13], pw1[0]=PKW(P0,8), pw1[1]=PKW(P0,10), pw1); \
    VRD(5); SBAR(); GAPA(C1,MF(kf[3],qr[1],C1),   P0[14],P0[15],P1[0],P1[1],   pw1[2]=PKW(P0,12),pw1[3]=PKW(P0,14), pw1); \
    VRD(2); SBAR(); GAPA(C0,MF(kf[4],qr[2],C0),   P1[2],P1[3],P1[4],P1[5],     pw2[0]=PKW(P1,0), pw2[1]=PKW(P1,2), pw2); \
    VRD(6); SBAR(); GAPA(C1,MF(kf[5],qr[2],C1),   P1[6],P1[7],P1[8],P1[9],     pw2[2]=PKW(P1,4), pw2[3]=PKW(P1,6), pw2); \
    VRD(3); SBAR(); GAPA(C0,MF(kf[6],qr[3],C0),   P1[10],P1[11],P1[12],P1[13], pw3[0]=PKW(P1,8), pw3[1]=PKW(P1,10), pw3); \
    VRD(7); SBAR(); GAPA(C1,MF(kf[7],qr[3],C1),   P1[14],P1[15],0.f,0.f,       pw3[2]=PKW(P1,12),pw3[3]=PKW(P1,14), pw3); \
    if constexpr(!ONES){ l_reg+=sacc; } \
    if constexpr(ATT_DMAPOS==0){ if(GK){DMA_K((t)+3,sc);} if(GV){DMA_V((t)+1,sn);} } \
    SBAR(); \
    if constexpr(DV==64 && !ONES){ \
      GAPB(o[0],MF(PAF(0),VFR(0),o[0]), C0,C1,0,4); \
      GAPB(o[1],MF(PAF(0),VFR(4),o[1]), C0,C1,4,4); \
      KRD(GL,0); GAPB(o[0],MF(PAF(1),VFR(1),o[0]), C0,C1,8,4); \
      KRD(GL,1); GAPB(o[1],MF(PAF(1),VFR(5),o[1]), C0,C1,12,4); \
      KRD(GL,2); GAPB(o[0],MF(PAF(2),VFR(2),o[0]), C0,C1,16,4); \
      KRD(GL,3); GAPB(o[1],MF(PAF(2),VFR(6),o[1]), C0,C1,20,4); \
      GAPB(o[0],MF(PAF(3),VFR(3),o[0]), C0,C1,24,4); \
      GAPB(o[1],MF(PAF(3),VFR(7),o[1]), C0,C1,28,4); \
    } else if constexpr(DV==64){ \
      GAPB(o[0],MF(PAF(0),VFR(0),o[0]), C0,C1,0,3); \
      GAPB(o[1],MF(PAF(0),VFR(4),o[1]), C0,C1,3,3); \
      KRD(GL,0); GAPB(o[0],MF(PAF(1),VFR(1),o[0]), C0,C1,6,3); \
      KRD(GL,1); GAPB(o[1],MF(PAF(1),VFR(5),o[1]), C0,C1,9,3); \
      KRD(GL,2); GAPB(o[0],MF(PAF(2),VFR(2),o[0]), C0,C1,12,3); \
      KRD(GL,3); GAPB(o[1],MF(PAF(2),VFR(6),o[1]), C0,C1,15,3); \
      GAPB(o[0],MF(PAF(3),VFR(3),o[0]), C0,C1,18,3); \
      GAPB(o[1],MF(PAF(3),VFR(7),o[1]), C0,C1,21,3); \
      GAPB(os,MF(PAF(0),ones,os), C0,C1,24,2); \
      GAPB(os,MF(PAF(1),ones,os), C0,C1,26,2); \
      GAPB(os,MF(PAF(2),ones,os), C0,C1,28,2); \
      GAPB(os,MF(PAF(3),ones,os), C0,C1,30,2); \
    } else { \
      GAPB(o[0],MF(PAF(0),VFR(0),o[0]), C0,C1,0,2);  VRD(8);  SBAR(); \
      GAPB(o[1],MF(PAF(0),VFR(4),o[1]), C0,C1,2,2);  VRD(12); SBAR(); \
      KRD(GL,0); GAPB(o[0],MF(PAF(1),VFR(1),o[0]), C0,C1,4,2);  VRD(9);  SBAR(); \
      KRD(GL,1); GAPB(o[1],MF(PAF(1),VFR(5),o[1]), C0,C1,6,2);  VRD(13); SBAR(); \
      KRD(GL,2); GAPB(o[0],MF(PAF(2),VFR(2),o[0]), C0,C1,8,2);  VRD(10); SBAR(); \
      KRD(GL,3); GAPB(o[1],MF(PAF(2),VFR(6),o[1]), C0,C1,10,2); VRD(14); SBAR(); \
      GAPB(o[0],MF(PAF(3),VFR(3),o[0]), C0,C1,12,2); VRD(11); SBAR(); \
      GAPB(o[1],MF(PAF(3),VFR(7),o[1]), C0,C1,14,2); VRD(15); SBAR(); \
      if constexpr(!ONES){ \
      GAPB(o[ND-2],MF(PAF(0),VFR(8 %(4*ND)),o[ND-2]),  C0,C1,16,2); \
      GAPB(o[ND-1],MF(PAF(0),VFR(12%(4*ND)),o[ND-1]), C0,C1,18,2); \
      GAPB(o[ND-2],MF(PAF(1),VFR(9 %(4*ND)),o[ND-2]),  C0,C1,20,2); \
      GAPB(o[ND-1],MF(PAF(1),VFR(13%(4*ND)),o[ND-1]), C0,C1,22,2); \
      GAPB(o[ND-2],MF(PAF(2),VFR(10%(4*ND)),o[ND-2]), C0,C1,24,2); \
      GAPB(o[ND-1],MF(PAF(2),VFR(14%(4*ND)),o[ND-1]), C0,C1,26,2); \
      GAPB(o[ND-2],MF(PAF(3),VFR(11%(4*ND)),o[ND-2]), C0,C1,28,2); \
      GAPB(o[ND-1],MF(PAF(3),VFR(15%(4*ND)),o[ND-1]), C0,C1,30,2); \
      } else { \
      GAPB(o[ND-2],MF(PAF(0),VFR(8 %(4*ND)),o[ND-2]),  C0,C1,16,1); \
      GAPB(o[ND-1],MF(PAF(0),VFR(12%(4*ND)),o[ND-1]), C0,C1,17,1); \
      GAPB(o[ND-2],MF(PAF(1),VFR(9 %(4*ND)),o[ND-2]),  C0,C1,18,1); \
      GAPB(o[ND-1],MF(PAF(1),VFR(13%(4*ND)),o[ND-1]), C0,C1,19,1); \
      GAPB(o[ND-2],MF(PAF(2),VFR(10%(4*ND)),o[ND-2]), C0,C1,20,1); \
      GAPB(o[ND-1],MF(PAF(2),VFR(14%(4*ND)),o[ND-1]), C0,C1,21,1); \
      GAPB(o[ND-2],MF(PAF(3),VFR(11%(4*ND)),o[ND-2]), C0,C1,22,1); \
      GAPB(o[ND-1],MF(PAF(3),VFR(15%(4*ND)),o[ND-1]), C0,C1,23,1); \
      GAPB(os,MF(PAF(0),ones,os), C0,C1,24,2); \
      GAPB(os,MF(PAF(1),ones,os), C0,C1,26,2); \
      GAPB(os,MF(PAF(2),ones,os), C0,C1,28,2); \
      GAPB(os,MF(PAF(3),ones,os), C0,C1,30,2); \
      } \
    } \
    if constexpr(ATT_DMAPOS==1){ SBAR(); if(GK){DMA_K((t)+3,sc);} if(GV){DMA_V((t)+1,sn);} } \
    }while(0)
  if(ATT_PRIO && wid>=4) __builtin_amdgcn_s_setprio(1);
  int t=1;
  for(;t+5<NT;t+=2){
    STEP(pB0,pB1,pA0,pA1,t,true,true,true);     WAITB_KV(); ROT();
    STEP(pA0,pA1,pB0,pB1,t+1,true,true,true);   WAITB_KV(); ROT();
  }
  #define ENDW(tt) do{ if((tt)+3<NT){WAITB_KV();} else if((tt)+2<NT){WAITB_V();} else {WAITB_0();} }while(0)
  for(;t+1<NT;t+=2){
    STEP(pB0,pB1,pA0,pA1,t,(t+3<NT),(t+1<NT),(t+1<NT));       ENDW(t);   ROT();
    STEP(pA0,pA1,pB0,pB1,t+1,(t+4<NT),(t+2<NT),(t+2<NT));     ENDW(t+1); ROT();
  }
  STEP(pB0,pB1,pA0,pA1,NT-1,false,false,false);
  { if constexpr(!ONES){ float sacc=pB0[0]+pB0[1]; _Pragma("unroll") for(int r=2;r<16;++r)sacc+=pB0[r]; _Pragma("unroll") for(int r=0;r<16;++r)sacc+=pB1[r]; l_reg+=sacc; }
    pw0=(u32x4){PKW(pB0,0),PKW(pB0,2),PKW(pB0,4),PKW(pB0,6)};pw1=(u32x4){PKW(pB0,8),PKW(pB0,10),PKW(pB0,12),PKW(pB0,14)};pw2=(u32x4){PKW(pB1,0),PKW(pB1,2),PKW(pB1,4),PKW(pB1,6)};pw3=(u32x4){PKW(pB1,8),PKW(pB1,10),PKW(pB1,12),PKW(pB1,14)};
    SBAR();
    const lds_cptr vp_=vp0+sc*VSLOT;
    #pragma unroll
    for(int d0=0;d0<ND;++d0){
      #pragma unroll
      for(int ks=0;ks<4;++ks){ const int i=(d0&1)*4+ks; vlo[i]=vtr(vp_+(d0*4096+ks*1024)); vhi[i]=vtr(vp_+(d0*4096+ks*1024+512)); }
      o[d0]=MF(PAF(0),VFR((d0&1)*4+0),o[d0]); o[d0]=MF(PAF(1),VFR((d0&1)*4+1),o[d0]); o[d0]=MF(PAF(2),VFR((d0&1)*4+2),o[d0]); o[d0]=MF(PAF(3),VFR((d0&1)*4+3),o[d0]); }
    if constexpr(ONES){ os=MF(PAF(0),ones,os); os=MF(PAF(1),ones,os); os=MF(PAF(2),ones,os); os=MF(PAF(3),ones,os); } }
  #undef PKW
  #undef PAF
  #undef VFR
  #undef PIN
  #undef MF
  #undef EX
  #undef EXQ
  #undef GAPA
  #undef GAPB
  #undef VRD
  #undef KRD
  #undef STEP
  #undef ENDW
  if(ATT_PRIO && wid>=4) __builtin_amdgcn_s_setprio(0);
  float rli[16];
  if constexpr(ONES){
    #pragma unroll
    for(int r=0;r<16;++r)rli[r]=__builtin_amdgcn_rcpf(os[r]);
  } else {
    {auto rr=__builtin_amdgcn_permlane32_swap(__float_as_uint(l_reg),__float_as_uint(l_reg),false,false);l_reg=__uint_as_float(rr[0])+__uint_as_float(rr[1]);}
    if(hi==0)wsf[32+r32]=l_reg;asm volatile("s_waitcnt lgkmcnt(0)":::"memory");
    #pragma unroll
    for(int r=0;r<16;++r)rli[r]=__builtin_amdgcn_rcpf(wsf[32+crow(r,hi)]);
  }
  if constexpr(O8!=0){ unsigned char*Ow8=(unsigned char*)Ou+(long)(wid*QBLK)*OP; unsigned char*stg8=(unsigned char*)(shm+L::OST)+wid*4096;
    #pragma unroll
    for(int hf=0;hf<NV;++hf){
      #pragma unroll
      for(int r=0;r<16;++r){const int orow=crow(r,hi);
        #pragma unroll
        for(int d0=0;d0<2;++d0){ const float v=__builtin_amdgcn_fmed3f(o[2*hf+d0][r]*rli[r]*YA8_SCALE,-448.0f,448.0f); stg8[orow*64+d0*32+r32]=(unsigned char)__builtin_amdgcn_cvt_pk_fp8_f32(v,v,0,false); } }
      asm volatile("s_waitcnt lgkmcnt(0)":::"memory");
      #pragma unroll
      for(int i=0;i<2;++i){const int row=i*16+(lane>>2),ch=lane&3; const u32x4 v=*(const u32x4*)(stg8+row*64+ch*16); *(u32x4*)(Ow8+(long)row*OP+hf*64+ch*16)=v;}
      asm volatile("s_waitcnt lgkmcnt(0)":::"memory");
    } } else {
  bf16*Ow=Ou+(long)(wid*QBLK)*OP;
  { bf16*stg=(bf16*)(shm+L::OST)+wid*2048;
    #pragma unroll
    for(int hf=0;hf<NV;++hf){
      #pragma unroll
      for(int r=0;r<16;++r){const int orow=crow(r,hi);
        #pragma unroll
        for(int d0=0;d0<2;++d0)stg[orow*64+d0*32+r32]=__float2bfloat16(o[2*hf+d0][r]*rli[r]);}
      asm volatile("s_waitcnt lgkmcnt(0)":::"memory");
      #pragma unroll
      for(int i=0;i<4;++i){const int row=i*8+(lane>>3),ch=lane&7; const u32x4 v=*(const u32x4*)(stg+row*64+ch*8); *(u32x4*)(Ow+(long)row*OP+hf*64+ch*8)=v;}
      asm volatile("s_waitcnt lgkmcnt(0)":::"memory");
    } } }
  asm volatile("s_waitcnt lgkmcnt(0)\n\ts_barrier":::"memory");
  #undef DMA_K
  #undef DMA_V
  #undef WAITB_KV
  #undef WAITB_V
  #undef WAITB_0
  #undef ROT
}

template<int DV> struct Lds3 { static constexpr int NS=4, VSLOT=DV*128, K=0, V=NS*SLOTB, WS=V+NS*VSLOT, OST=WS+NW*64*4, BYTES=OST+NW*4096; };
template<int HALF_,int DV,bool ONES,int NT,int QP,int KP,int VP,int OP> __device__ __forceinline__ void attn_unit3h(const bf16*Qu,const bf16*__restrict__ Kb,const bf16*__restrict__ Vb,bf16*Ou,char*shm){
  typedef Lds3<DV> L; constexpr int ND=DV/32, NV=DV/64, VSLOT=L::VSLOT;
  const int tid=threadIdx.x,lane=tid&63,r32=lane&31,hi=lane>>5; const int wid=__builtin_amdgcn_readfirstlane(tid>>6);
  const bf16*Qw=Qu+(long)(wid*QBLK)*QP;
  const unsigned lds0=(unsigned)(uintptr_t)shm;
  float*wsf=(float*)(shm+L::WS)+wid*64;
  const bf16*ksrc=Kb+(long)lane*KP+wid*8;
  const bf16*vsrc=Vb+(long)(16*(wid&3)+(lane>>2))*VP+(wid>>2)*32+(lane&3)*8;
  const unsigned kdst=lds0+L::K+wid*1024, vdst=lds0+L::V+wid*1024;
  #define DMA_K(t,slot) glds16(ksrc+(long)(t)*KVBLK*KP,(unsigned)__builtin_amdgcn_readfirstlane(kdst+(slot)*SLOTB))
  #define DMA_V(t,slot) do{ _Pragma("unroll") for(int q_=0;q_<NV;++q_) glds16(vsrc+(long)(t)*KVBLK*VP+q_*64,(unsigned)__builtin_amdgcn_readfirstlane(vdst+(slot)*VSLOT+q_*8192)); }while(0)
  #define WAITB_KV() do{ if constexpr(NV==1) asm volatile("s_waitcnt vmcnt(2) lgkmcnt(0)\n\ts_barrier":::"memory"); else asm volatile("s_waitcnt vmcnt(3) lgkmcnt(0)\n\ts_barrier":::"memory"); }while(0)
  #define WAITB_V()  do{ if constexpr(NV==1) asm volatile("s_waitcnt vmcnt(1) lgkmcnt(0)\n\ts_barrier":::"memory"); else asm volatile("s_waitcnt vmcnt(2) lgkmcnt(0)\n\ts_barrier":::"memory"); }while(0)
  #define WAITB_0()  asm volatile("s_waitcnt vmcnt(0) lgkmcnt(0)\n\ts_barrier":::"memory")
  const char*Kbase=shm+L::K; bf16x8 kf[8];
  const lds_cptr shm3=(lds_cptr)shm; const lds_cptr kp0=shm3+L::K+hi*1024+r32*16; const lds_cptr vp0=shm3+L::V+((lane>>4)&1)*32+(lane&3)*8+(4*hi+((lane&15)>>2))*64;
  DMA_K(0,0);DMA_V(0,0);DMA_K(1,1);
  bf16x8 qr[4];
  #pragma unroll
  for(int d0=0;d0<4;++d0)qr[d0]=*reinterpret_cast<const bf16x8*>(&Qw[(long)r32*QP+d0*16+hi*8]);
  float l_reg=0.f; f32x16 o[ND]; f32x16 os=f32x16{};
  #pragma unroll
  for(int d_=0;d_<ND;++d_)o[d_]=f32x16{};
  const f32x16 zero16=f32x16{};
  const bf16x8 ones={(short)0x3F80,(short)0x3F80,(short)0x3F80,(short)0x3F80,(short)0x3F80,(short)0x3F80,(short)0x3F80,(short)0x3F80};
  f32x16 pA0,pA1,pB0,pB1;
  DMA_K(2,2);
  asm volatile("s_waitcnt vmcnt(3) lgkmcnt(0)\n\ts_barrier":::"memory");
  qkt(pA0,pA1,Kbase,qr,zero16,r32,hi);asm volatile("s_nop 15\n\ts_nop 7":"+v"(pA0),"+v"(pA1));
  _Pragma("unroll") for(int r=0;r<16;++r){pA0[r]=__builtin_amdgcn_exp2f(pA0[r]);pA1[r]=__builtin_amdgcn_exp2f(pA1[r]);}
  WAITB_0();
  DMA_K(3,3);DMA_V(1,1);
  kload8(kf,kp0+1*SLOTB);
  s16x4 vlo[4*ND],vhi[4*ND]; u32x4 pw0,pw1,pw2,pw3;
  #define PKW(P,B) cvtpk_s(P[B],P[B+1])
  #define PAF(k) __builtin_bit_cast(bf16x8,pw##k)
  #define VFR(i) (bf16x8){vlo[i][0],vlo[i][1],vlo[i][2],vlo[i][3],vhi[i][0],vhi[i][1],vhi[i][2],vhi[i][3]}
  #define PIN(x) asm volatile("":"+v"(x))
  #define MF(a,b,c) __builtin_amdgcn_mfma_f32_32x32x16_bf16(a,b,c,0,0,0)
  #define EX(v) __builtin_amdgcn_exp2f(v)
  #define EXQ(C0,C1,e) do{ if((e)<16) C0[(e)&15]=EX(C0[(e)&15]); else C1[(e)&15]=EX(C1[(e)&15]); }while(0)
  #define VRD(VP_,i) do{ vlo[i]=vtr(VP_+(((i)>>2)*4096+((i)&3)*1024)); vhi[i]=vtr(VP_+(((i)>>2)*4096+((i)&3)*1024+512)); }while(0)
  #define KRD(G,KP_,j) do{ if(G){ kload2(kf,KP_,j); SBAR(); } }while(0)
  #define GAPA(DST,MFX,A0,A1,A2,A3,W0,W1,PW) do{ DST=MFX; PIN(DST); if constexpr(!ONES){ sacc+=A0; sacc+=A1; sacc+=A2; sacc+=A3; PIN(sacc); } W0; W1; PIN(PW); SBAR(); }while(0)
  #define GAPB(DST,MFX,C0,C1,e0,NE) do{ DST=MFX; PIN(DST); _Pragma("unroll") for(int e_=0;e_<(NE);++e_) EXQ(C0,C1,(e0)+e_); PIN(C0); PIN(C1); SBAR(); }while(0)
  #define PH_A(C0,C1,P0,P1,VS) do{ SBAR(); \
    const lds_cptr vp_=vp0+(VS)*VSLOT; \
    VRD(vp_,0); SBAR(); float sacc=0.f; if constexpr(!ONES){ sacc=(P0[0]+P0[1]); } \
    GAPA(C0,MF(kf[0],qr[0],zero16), P0[2],P0[3],P0[4],P0[5],     pw0[0]=PKW(P0,0), pw0[1]=PKW(P0,2), pw0); \
    VRD(vp_,4); SBAR(); GAPA(C1,MF(kf[1],qr[0],zero16), P0[6],P0[7],P0[8],P0[9],     pw0[2]=PKW(P0,4), pw0[3]=PKW(P0,6), pw0); \
    VRD(vp_,1); SBAR(); GAPA(C0,MF(kf[2],qr[1],C0),   P0[10],P0[11],P0[12],P0[13], pw1[0]=PKW(P0,8), pw1[1]=PKW(P0,10), pw1); \
    VRD(vp_,5); SBAR(); GAPA(C1,MF(kf[3],qr[1],C1),   P0[14],P0[15],P1[0],P1[1],   pw1[2]=PKW(P0,12),pw1[3]=PKW(P0,14), pw1); \
    VRD(vp_,2); SBAR(); GAPA(C0,MF(kf[4],qr[2],C0),   P1[2],P1[3],P1[4],P1[5],     pw2[0]=PKW(P1,0), pw2[1]=PKW(P1,2), pw2); \
    VRD(vp_,6); SBAR(); GAPA(C1,MF(kf[5],qr[2],C1),   P1[6],P1[7],P1[8],P1[9],     pw2[2]=PKW(P1,4), pw2[3]=PKW(P1,6), pw2); \
    VRD(vp_,3); SBAR(); GAPA(C0,MF(kf[6],qr[3],C0),   P1[10],P1[11],P1[12],P1[13], pw3[0]=PKW(P1,8), pw3[1]=PKW(P1,10), pw3); \
    VRD(vp_,7); SBAR(); GAPA(C1,MF(kf[7],qr[3],C1),   P1[14],P1[15],0.f,0.f,       pw3[2]=PKW(P1,12),pw3[3]=PKW(P1,14), pw3); \
    if constexpr(!ONES){ l_reg+=sacc; } SBAR(); }while(0)
  #define PH_B(C0,C1,KS,VS2,GL) do{ SBAR(); \
    const lds_cptr kq_=kp0+(KS)*SLOTB; const lds_cptr vq_=vp0+(VS2)*VSLOT; (void)vq_; \
    if constexpr(DV==64 && !ONES){ \
      GAPB(o[0],MF(PAF(0),VFR(0),o[0]), C0,C1,0,4); \
      GAPB(o[1],MF(PAF(0),VFR(4),o[1]), C0,C1,4,4); \
      KRD(GL,kq_,0); GAPB(o[0],MF(PAF(1),VFR(1),o[0]), C0,C1,8,4); \
      KRD(GL,kq_,1); GAPB(o[1],MF(PAF(1),VFR(5),o[1]), C0,C1,12,4); \
      KRD(GL,kq_,2); GAPB(o[0],MF(PAF(2),VFR(2),o[0]), C0,C1,16,4); \
      KRD(GL,kq_,3); GAPB(o[1],MF(PAF(2),VFR(6),o[1]), C0,C1,20,4); \
      GAPB(o[0],MF(PAF(3),VFR(3),o[0]), C0,C1,24,4); \
      GAPB(o[1],MF(PAF(3),VFR(7),o[1]), C0,C1,28,4); \
    } else if constexpr(DV==64){ \
      GAPB(o[0],MF(PAF(0),VFR(0),o[0]), C0,C1,0,3); \
      GAPB(o[1],MF(PAF(0),VFR(4),o[1]), C0,C1,3,3); \
      KRD(GL,kq_,0); GAPB(o[0],MF(PAF(1),VFR(1),o[0]), C0,C1,6,3); \
      KRD(GL,kq_,1); GAPB(o[1],MF(PAF(1),VFR(5),o[1]), C0,C1,9,3); \
      KRD(GL,kq_,2); GAPB(o[0],MF(PAF(2),VFR(2),o[0]), C0,C1,12,3); \
      KRD(GL,kq_,3); GAPB(o[1],MF(PAF(2),VFR(6),o[1]), C0,C1,15,3); \
      GAPB(o[0],MF(PAF(3),VFR(3),o[0]), C0,C1,18,3); \
      GAPB(o[1],MF(PAF(3),VFR(7),o[1]), C0,C1,21,3); \
      GAPB(os,MF(PAF(0),ones,os), C0,C1,24,2); \
      GAPB(os,MF(PAF(1),ones,os), C0,C1,26,2); \
      GAPB(os,MF(PAF(2),ones,os), C0,C1,28,2); \
      GAPB(os,MF(PAF(3),ones,os), C0,C1,30,2); \
    } else { \
      GAPB(o[0],MF(PAF(0),VFR(0),o[0]), C0,C1,0,2);  VRD(vq_,8%(4*ND));  SBAR(); \
      GAPB(o[1],MF(PAF(0),VFR(4),o[1]), C0,C1,2,2);  VRD(vq_,12%(4*ND)); SBAR(); \
      KRD(GL,kq_,0); GAPB(o[0],MF(PAF(1),VFR(1),o[0]), C0,C1,4,2);  VRD(vq_,9%(4*ND));  SBAR(); \
      KRD(GL,kq_,1); GAPB(o[1],MF(PAF(1),VFR(5),o[1]), C0,C1,6,2);  VRD(vq_,13%(4*ND)); SBAR(); \
      KRD(GL,kq_,2); GAPB(o[0],MF(PAF(2),VFR(2),o[0]), C0,C1,8,2);  VRD(vq_,10%(4*ND)); SBAR(); \
      KRD(GL,kq_,3); GAPB(o[1],MF(PAF(2),VFR(6),o[1]), C0,C1,10,2); VRD(vq_,14%(4*ND)); SBAR(); \
      GAPB(o[0],MF(PAF(3),VFR(3),o[0]), C0,C1,12,2); VRD(vq_,11%(4*ND)); SBAR(); \
      GAPB(o[1],MF(PAF(3),VFR(7),o[1]), C0,C1,14,2); VRD(vq_,15%(4*ND)); SBAR(); \
      GAPB(o[ND-2],MF(PAF(0),VFR(8 %(4*ND)),o[ND-2]),  C0,C1,16,2); \
      GAPB(o[ND-1],MF(PAF(0),VFR(12%(4*ND)),o[ND-1]), C0,C1,18,2); \
      GAPB(o[ND-2],MF(PAF(1),VFR(9 %(4*ND)),o[ND-2]),  C0,C1,20,2); \
      GAPB(o[ND-1],MF(PAF(1),VFR(13%(4*ND)),o[ND-1]), C0,C1,22,2); \
      GAPB(o[ND-2],MF(PAF(2),VFR(10%(4*ND)),o[ND-2]), C0,C1,24,2); \
      GAPB(o[ND-1],MF(PAF(2),VFR(14%(4*ND)),o[ND-1]), C0,C1,26,2); \
      GAPB(o[ND-2],MF(PAF(3),VFR(11%(4*ND)),o[ND-2]), C0,C1,28,2); \
      GAPB(o[ND-1],MF(PAF(3),VFR(15%(4*ND)),o[ND-1]), C0,C1,30,2); \
    } }while(0)
  #define DMAS(t,GK,GV) do{ if(GK){DMA_K((t)+3,((t)+3)&3);} if(GV){DMA_V((t)+1,((t)+1)&3);} }while(0)
  #define ENDW(tt) do{ if((tt)+3<NT){WAITB_KV();} else if((tt)+2<NT){WAITB_V();} else {WAITB_0();} }while(0)
  #define S0_ODD(t,GK,GV,GL)  do{ PH_A(pB0,pB1,pA0,pA1,((t)-1)&3); DMAS(t,GK,GV); PH_B(pB0,pB1,((t)+1)&3,((t)-1)&3,GL); }while(0)
  #define S0_EVEN(t,GK,GV,GL) do{ PH_A(pA0,pA1,pB0,pB1,((t)-1)&3); DMAS(t,GK,GV); PH_B(pA0,pA1,((t)+1)&3,((t)-1)&3,GL); }while(0)
  #define S1_EVEN(t,GK,GV)    do{ PH_B(pB0,pB1,(t)&3,((t)-2)&3,true); DMAS(t,GK,GV); PH_A(pA0,pA1,pB0,pB1,((t)-1)&3); }while(0)
  #define S1_ODD(t,GK,GV)     do{ PH_B(pA0,pA1,(t)&3,((t)-2)&3,true); DMAS(t,GK,GV); PH_A(pB0,pB1,pA0,pA1,((t)-1)&3); }while(0)
  if constexpr(HALF_==0){
    int t=1;
    for(;t+5<NT;t+=2){ S0_ODD(t,true,true,true); WAITB_KV(); S0_EVEN(t+1,true,true,true); WAITB_KV(); }
    for(;t+1<NT;t+=2){ S0_ODD(t,(t+3<NT),(t+1<NT),(t+1<NT)); ENDW(t); S0_EVEN(t+1,(t+4<NT),(t+2<NT),(t+2<NT)); ENDW(t+1); }
    S0_ODD(NT-1,false,false,false);
  } else {
    DMAS(1,true,true); PH_A(pB0,pB1,pA0,pA1,0); WAITB_KV();
    int t=2;
    for(;t+4<NT;t+=2){ S1_EVEN(t,true,true); WAITB_KV(); S1_ODD(t+1,true,true); WAITB_KV(); }
    for(;t+2<NT;t+=2){ S1_EVEN(t,(t+3<NT),(t+1<NT)); ENDW(t); S1_ODD(t+1,(t+4<NT),(t+2<NT)); ENDW(t+1); }
    S1_EVEN(NT-2,false,true); ENDW(NT-2);
    S1_ODD(NT-1,false,false);
    PH_B(pB0,pB1,0,(NT-2)&3,false);
  }
  { if constexpr(!ONES){ float sacc=pB0[0]+pB0[1]; _Pragma("unroll") for(int r=2;r<16;++r)sacc+=pB0[r]; _Pragma("unroll") for(int r=0;r<16;++r)sacc+=pB1[r]; l_reg+=sacc; }
    pw0=(u32x4){PKW(pB0,0),PKW(pB0,2),PKW(pB0,4),PKW(pB0,6)};pw1=(u32x4){PKW(pB0,8),PKW(pB0,10),PKW(pB0,12),PKW(pB0,14)};pw2=(u32x4){PKW(pB1,0),PKW(pB1,2),PKW(pB1,4),PKW(pB1,6)};pw3=(u32x4){PKW(pB1,8),PKW(pB1,10),PKW(pB1,12),PKW(pB1,14)};
    SBAR();
    const lds_cptr vp_=vp0+((NT-1)&3)*VSLOT;
    #pragma unroll
    for(int d0=0;d0<ND;++d0){
      #pragma unroll
      for(int ks=0;ks<4;++ks){ const int i=(d0&1)*4+ks; vlo[i]=vtr(vp_+(d0*4096+ks*1024)); vhi[i]=vtr(vp_+(d0*4096+ks*1024+512)); }
      o[d0]=MF(PAF(0),VFR((d0&1)*4+0),o[d0]); o[d0]=MF(PAF(1),VFR((d0&1)*4+1),o[d0]); o[d0]=MF(PAF(2),VFR((d0&1)*4+2),o[d0]); o[d0]=MF(PAF(3),VFR((d0&1)*4+3),o[d0]); }
    if constexpr(ONES){ os=MF(PAF(0),ones,os); os=MF(PAF(1),ones,os); os=MF(PAF(2),ones,os); os=MF(PAF(3),ones,os); } }
  #undef PKW
  #undef PAF
  #undef VFR
  #undef PIN
  #undef MF
  #undef EX
  #undef EXQ
  #undef GAPA
  #undef GAPB
  #undef VRD
  #undef KRD
  #undef PH_A
  #undef PH_B
  #undef DMAS
  #undef ENDW
  #undef S0_ODD
  #undef S0_EVEN
  #undef S1_ODD
  #undef S1_EVEN
  float rli[16];
  if constexpr(ONES){
    #pragma unroll
    for(int r=0;r<16;++r)rli[r]=__builtin_amdgcn_rcpf(os[r]);
  } else {
    {auto rr=__builtin_amdgcn_permlane32_swap(__float_as_uint(l_reg),__float_as_uint(l_reg),false,false);l_reg=__uint_as_float(rr[0])+__uint_as_float(rr[1]);}
    if(hi==0)wsf[32+r32]=l_reg;asm volatile("s_waitcnt lgkmcnt(0)":::"memory");
    #pragma unroll
    for(int r=0;r<16;++r)rli[r]=__builtin_amdgcn_rcpf(wsf[32+crow(r,hi)]);
  }
  bf16*Ow=Ou+(long)(wid*QBLK)*OP;
  { bf16*stg=(bf16*)(shm+L::OST)+wid*2048;
    #pragma unroll
    for(int hf=0;hf<NV;++hf){
      #pragma unroll
      for(int r=0;r<16;++r){const int orow=crow(r,hi);
        #pragma unroll
        for(int d0=0;d0<2;++d0)stg[orow*64+d0*32+r32]=__float2bfloat16(o[2*hf+d0][r]*rli[r]);}
      asm volatile("s_waitcnt lgkmcnt(0)":::"memory");
      #pragma unroll
      for(int i=0;i<4;++i){const int row=i*8+(lane>>3),ch=lane&7; const u32x4 v=*(const u32x4*)(stg+row*64+ch*8); *(u32x4*)(Ow+(long)row*OP+hf*64+ch*8)=v;}
      asm volatile("s_waitcnt lgkmcnt(0)":::"memory");
    } }
  asm volatile("s_waitcnt lgkmcnt(0)\n\ts_barrier":::"memory");
  #undef DMA_K
  #undef DMA_V
  #undef WAITB_KV
  #undef WAITB_V
  #undef WAITB_0
}
template<int DV,bool ONES,int NT,int QP,int KP,int VP,int OP> __device__ __forceinline__ void attn_unit3(const bf16*Qu,const bf16*__restrict__ Kb,const bf16*__restrict__ Vb,bf16*Ou,char*shm){
  if(__builtin_amdgcn_readfirstlane(threadIdx.x>>6)<4) attn_unit3h<0,DV,ONES,NT,QP,KP,VP,OP>(Qu,Kb,Vb,Ou,shm); else attn_unit3h<1,DV,ONES,NT,QP,KP,VP,OP>(Qu,Kb,Vb,Ou,shm);
}

typedef int i32x4_t __attribute__((ext_vector_type(4)));
typedef int i32x8_t __attribute__((ext_vector_type(8)));
typedef __attribute__((address_space(3))) const i32x4_t* lds_i4p;
template<int DV> struct Lds8 { static constexpr int KSLOT=4096, VSLOT=DV*64, K=0, V=NSLOT*KSLOT, WS=V+NSLOT*VSLOT, OST=WS+NW*64*4, BYTES=OST+NW*4096; };
__device__ __forceinline__ void glds16s(const void*sbase,unsigned voff,unsigned lds_dst){unsigned keep;
  asm volatile("s_mov_b32 %0, m0\n\ts_mov_b32 m0, %3\n\ts_nop 0\n\tglobal_load_lds_dwordx4 %1, %2\n\ts_mov_b32 m0, %0":"=&s"(keep):"v"(voff),"s"(sbase),"s"(lds_dst):"memory");}
__device__ __forceinline__ void glds16s2(const void*sb0,unsigned vo0,unsigned ld0,const void*sb1,unsigned vo1,unsigned ld1){unsigned keep;
  asm volatile("s_mov_b32 %0, m0\n\ts_mov_b32 m0, %3\n\ts_nop 0\n\tglobal_load_lds_dwordx4 %1, %2\n\ts_mov_b32 m0, %6\n\ts_nop 0\n\tglobal_load_lds_dwordx4 %4, %5\n\ts_mov_b32 m0, %0"
    :"=&s"(keep):"v"(vo0),"s"(sb0),"s"(ld0),"v"(vo1),"s"(sb1),"s"(ld1):"memory");}
__device__ __forceinline__ unsigned pk4c(float a,float b,float c,float d,unsigned old){ int r=__builtin_amdgcn_cvt_pk_fp8_f32(a,b,(int)old,false); r=__builtin_amdgcn_cvt_pk_fp8_f32(c,d,r,true); return (unsigned)r; }
template<int DV,bool ONES,int NT,int QP,int KP,int OP,int O8,int ABL=0> __device__ __forceinline__ void attn_unit8(const unsigned char*Q8u,const unsigned char*__restrict__ K8b,const unsigned char*__restrict__ VTb,bf16*Ou,char*shm){
  typedef Lds8<DV> L; constexpr int ND=DV/32, NV=DV/64, VSLOT=L::VSLOT, KSLOT=L::KSLOT;
  const int tid=threadIdx.x,lane=tid&63,r32=lane&31,hi=lane>>5; const int wid=__builtin_amdgcn_readfirstlane(tid>>6);
  const unsigned lds0=(unsigned)(uintptr_t)shm;
  const unsigned koff=(unsigned)((32*(wid&1)+r32)*KP+16*(wid>>1));
  const int pv=(DV==64)?32*wid+r32:64*wid+lane;
  const unsigned voff=(unsigned)((pv&(DV-1))*64+16*(pv/DV));
  const unsigned kdst=(unsigned)__builtin_amdgcn_readfirstlane(lds0+L::K+wid*512), vdst=(unsigned)__builtin_amdgcn_readfirstlane(lds0+L::V+wid*(DV==64?512:1024));
  #define RFL(x) ((unsigned)__builtin_amdgcn_readfirstlane((int)(x)))
  #define DMA_K(t,slot) do{ const unsigned kd_=RFL(kdst+(slot)*KSLOT); if(hi==0){ glds16s(K8b+(long)(t)*KVBLK*KP,koff,kd_); } }while(0)
  #define DMA_V(t,slot) do{ const unsigned vd_=RFL(vdst+(slot)*VSLOT); if(DV==128||hi==0){ glds16s(VTb+(long)(t)*VSLOT,voff,vd_); } }while(0)
  #define DMA_KV(tk,ks,tv,vs) do{ if constexpr(DV==64){ const unsigned kd_=RFL(kdst+(ks)*KSLOT), vd_=RFL(vdst+(vs)*VSLOT); if(hi==0){ glds16s2(K8b+(long)(tk)*KVBLK*KP,koff,kd_,VTb+(long)(tv)*VSLOT,voff,vd_); } } else { DMA_K(tk,ks); DMA_V(tv,vs); } }while(0)
  #define WAITB_KV() do{ if constexpr(ABL&4) asm volatile("s_waitcnt lgkmcnt(0)":::"memory"); else asm volatile("s_waitcnt vmcnt(2) lgkmcnt(0)\n\ts_barrier":::"memory"); }while(0)
  #define WAITB_V()  asm volatile("s_waitcnt vmcnt(1) lgkmcnt(0)\n\ts_barrier":::"memory")
  #define WAITB_0()  asm volatile("s_waitcnt vmcnt(0) lgkmcnt(0)\n\ts_barrier":::"memory")
  const lds_cptr shm3=(lds_cptr)shm; const lds_cptr kp0=shm3+L::K+(2*hi)*1024+r32*16; const lds_cptr vp0=shm3+L::V+(2*hi)*(DV*16)+r32*16;
  i32x8_t kf[2], vf[ND], q8, pw8={0,0,0,0,0,0,0,0};
  #define KLD(slot) do{ const lds_cptr kp_=kp0+(slot)*KSLOT; _Pragma("unroll") for(int b_=0;b_<2;++b_){ kf[b_].lo=*(lds_i4p)(kp_+b_*512); kf[b_].hi=*(lds_i4p)(kp_+1024+b_*512); } }while(0)
  #define VLD(slot) do{ const lds_cptr vp_=vp0+(slot)*VSLOT; _Pragma("unroll") for(int d_=0;d_<ND;++d_){ vf[d_].lo=*(lds_i4p)(vp_+d_*512); vf[d_].hi=*(lds_i4p)(vp_+DV*16+d_*512); } }while(0)
  DMA_K(0,0);DMA_V(0,0);DMA_K(1,1);
  { const unsigned char*qp=Q8u+(long)(wid*QBLK+r32)*QP+32*hi; q8.lo=*(const i32x4_t*)qp; q8.hi=*(const i32x4_t*)(qp+16); }
  f32x16 o[ND]; f32x16 os=f32x16{}; float l_reg=0.f; float*wsf=(float*)(shm+L::WS)+wid*64;
  #pragma unroll
  for(int d_=0;d_<ND;++d_)o[d_]=f32x16{};
  i32x8_t ones8={0x38383838,0x38383838,0x38383838,0x38383838,0x38383838,0x38383838,0x38383838,0x38383838};
  if constexpr(DV==64||ONES8_PIN_B){ int one_=0x38383838; asm volatile("":"+s"(one_)); ones8=(i32x8_t){one_,one_,one_,one_,one_,one_,one_,one_}; asm volatile("":"+v"(ones8)); }
  f32x16 c0,c1;
  i32x8_t pwB={0,0,0,0,0,0,0,0};
  int sp=0,sc=0,sn=1;
  #define ROT() do{sp=sc;sc=sn;sn=(sn==NSLOT-1)?0:sn+1;}while(0)
  #define MFZ(D,A_,B_) do{ if constexpr(ABL&2){ asm volatile("":"=v"(D):"v"(A_),"v"(B_)); } else asm volatile("v_mfma_f32_32x32x64_f8f6f4 %0, %1, %2, -4.0":"=&v"(D):"v"(A_),"v"(B_)); }while(0)
  #define MFA(D,A_,B_) do{ if constexpr(ABL&2){ asm volatile("":"+v"(D):"v"(A_),"v"(B_)); } else asm volatile("v_mfma_f32_32x32x64_f8f6f4 %0, %1, %2, %0":"+v"(D):"v"(A_),"v"(B_)); }while(0)
  #define MFAO(D,A_,B_) do{ if constexpr(ABL&2){ asm volatile("":"+v"(D):"v"(A_),"v"(B_)); } else asm volatile("s_nop 1\n\tv_mfma_f32_32x32x64_f8f6f4 %0, %1, %2, %0":"+v"(D):"v"(A_),"v"(B_)); }while(0)
  #define EXR(C,lo_,n_) do{ if constexpr(!(ABL&1)){ _Pragma("unroll") for(int e_=(lo_);e_<(lo_)+(n_);++e_) C[e_]=__builtin_amdgcn_exp2f(C[e_]); } asm volatile("":"+v"(C)); }while(0)
  #define PACK(P,W,base) do{ if constexpr(!(ABL&8)){ _Pragma("unroll") for(int j_=0;j_<4;++j_) W[(base)+j_]=(int)pk4c(P[4*j_],P[4*j_+1],P[4*j_+2],P[4*j_+3],(unsigned)W[(base)+j_]); } asm volatile("":"+v"(W)); \
    if constexpr(!ONES){ float s_=(P[0]+P[1])+(P[2]+P[3]); _Pragma("unroll") for(int j_=1;j_<4;++j_) s_+=(P[4*j_]+P[4*j_+1])+(P[4*j_+2]+P[4*j_+3]); l_reg+=s_; asm volatile("":"+v"(l_reg)); } }while(0)
  DMA_K(2,2);
  asm volatile("s_waitcnt vmcnt(3) lgkmcnt(0)\n\ts_barrier":::"memory");
  KLD(0);
  MFZ(c0,kf[0],q8); MFZ(c1,kf[1],q8);
  asm volatile("s_nop 15\n\ts_nop 15":"+v"(c0),"+v"(c1));
  EXR(c0,0,16); EXR(c1,0,16); PACK(c0,pw8,0); PACK(c1,pw8,4);
  WAITB_0();
  DMA_K(3,0);DMA_V(1,1);
  ROT();
  KLD(sc);
  WAITB_KV();
  #define STEP9(WP,WN,t,GK,GV,GL) do{ SBAR(); \
    VLD(sp); SBAR(); \
    MFZ(c0,kf[0],q8); SBAR(); \
    if((GK)&&(GV)){ DMA_KV((t)+3,sc,(t)+1,sn); } else { if(GK){DMA_K((t)+3,sc);} if(GV){DMA_V((t)+1,sn);} } SBAR(); \
    MFZ(c1,kf[1],q8); SBAR(); \
    if(GL){KLD(sn);} SBAR(); \
    MFA(o[0],WP,vf[0]); SBAR(); \
    if constexpr(ND==2){ \
      EXR(c0,0,16); PACK(c0,WN,0); SBAR(); \
      MFA(o[1],WP,vf[1]); SBAR(); EXR(c1,0,8); SBAR(); \
      if constexpr(ONES){ MFAO(os,WP,ones8); SBAR(); } EXR(c1,8,8); PACK(c1,WN,4); SBAR(); \
    } else { \
      EXR(c0,0,10); SBAR(); \
      MFA(o[1],WP,vf[1]); SBAR(); EXR(c0,10,6); PACK(c0,WN,0); SBAR(); \
      MFA(o[ND-2],WP,vf[ND-2]); SBAR(); EXR(c1,0,8); SBAR(); \
      MFA(o[ND-1],WP,vf[ND-1]); SBAR(); EXR(c1,8,4); SBAR(); \
      if constexpr(ONES){ MFAO(os,WP,ones8); SBAR(); } EXR(c1,12,4); PACK(c1,WN,4); SBAR(); \
    } }while(0)
  if(ATT_PRIO && wid>=4) __builtin_amdgcn_s_setprio(1);
  int t=1;
  for(;t+5<NT;t+=2){
    STEP9(pw8,pwB,t,true,true,true);     WAITB_KV(); ROT();
    STEP9(pwB,pw8,t+1,true,true,true);   WAITB_KV(); ROT();
  }
  #define ENDW(tt) do{ if((tt)+3<NT){WAITB_KV();} else if((tt)+2<NT){WAITB_V();} else {WAITB_0();} }while(0)
  for(;t+1<NT;t+=2){
    STEP9(pw8,pwB,t,(t+3<NT),(t+1<NT),(t+1<NT));       ENDW(t);   ROT();
    STEP9(pwB,pw8,t+1,(t+4<NT),(t+2<NT),(t+2<NT));     ENDW(t+1); ROT();
  }
  STEP9(pw8,pwB,NT-1,false,false,false);
  if(ATT_PRIO && wid>=4) __builtin_amdgcn_s_setprio(0);
  { VLD(sc); SBAR();
    #pragma unroll
    for(int d_=0;d_<ND;++d_) MFA(o[d_],pwB,vf[d_]);
    if constexpr(ONES){ MFAO(os,pwB,ones8); asm volatile("s_nop 15\n\ts_nop 15":"+v"(os)); }
    else { asm volatile("s_nop 15\n\ts_nop 15":"+v"(o[ND-1])); } }
  #undef STEP9
  #undef ENDW
  #undef MFZ
  #undef MFA
  #undef MFAO
  #undef EXR
  #undef PACK
  #undef KLD
  #undef VLD
  float rli[16];
  if constexpr(ONES){
    #pragma unroll
    for(int r=0;r<16;++r)rli[r]=__builtin_amdgcn_rcpf(os[r]);
  } else {
    {auto rr=__builtin_amdgcn_permlane32_swap(__float_as_uint(l_reg),__float_as_uint(l_reg),false,false);l_reg=__uint_as_float(rr[0])+__uint_as_float(rr[1]);}
    if(hi==0)wsf[32+r32]=l_reg;asm volatile("s_waitcnt lgkmcnt(0)":::"memory");
    #pragma unroll
    for(int r=0;r<16;++r)rli[r]=__builtin_amdgcn_rcpf(wsf[32+crow(r,hi)]);
  }
  if constexpr(O8!=0){ unsigned char*Ow8=(unsigned char*)Ou+(long)(wid*QBLK)*OP; unsigned char*stg8=(unsigned char*)(shm+L::OST)+wid*4096;
    #pragma unroll
    for(int hf=0;hf<NV;++hf){
      #pragma unroll
      for(int r=0;r<16;++r){const int orow=crow(r,hi);
        #pragma unroll
        for(int d0=0;d0<2;++d0){ const float v=__builtin_amdgcn_fmed3f(o[2*hf+d0][r]*rli[r]*YA8_SCALE,-448.0f,448.0f); stg8[orow*64+d0*32+r32]=(unsigned char)__builtin_amdgcn_cvt_pk_fp8_f32(v,v,0,false); } }
      asm volatile("s_waitcnt lgkmcnt(0)":::"memory");
      #pragma unroll
      for(int i=0;i<2;++i){const int row=i*16+(lane>>2),ch=lane&3; const u32x4 v=*(const u32x4*)(stg8+row*64+ch*16); *(u32x4*)(Ow8+(long)row*OP+hf*64+ch*16)=v;}
      asm volatile("s_waitcnt lgkmcnt(0)":::"memory");
    } } else {
  bf16*Ow=Ou+(long)(wid*QBLK)*OP;
  { bf16*stg=(bf16*)(shm+L::OST)+wid*2048;
    #pragma unroll
    for(int hf=0;hf<NV;++hf){
      #pragma unroll
      for(int r=0;r<16;++r){const int orow=crow(r,hi);
        #pragma unroll
        for(int d0=0;d0<2;++d0)stg[orow*64+d0*32+r32]=__float2bfloat16(o[2*hf+d0][r]*rli[r]);}
      asm volatile("s_waitcnt lgkmcnt(0)":::"memory");
      #pragma unroll
      for(int i=0;i<4;++i){const int row=i*8+(lane>>3),ch=lane&7; const u32x4 v=*(const u32x4*)(stg+row*64+ch*8); *(u32x4*)(Ow+(long)row*OP+hf*64+ch*8)=v;}
      asm volatile("s_waitcnt lgkmcnt(0)":::"memory");
    } } }
  asm volatile("s_waitcnt lgkmcnt(0)\n\ts_barrier":::"memory");
  #undef DMA_K
  #undef DMA_KV
  #undef RFL
  #undef DMA_V
  #undef WAITB_KV
  #undef WAITB_V
  #undef WAITB_0
  #undef ROT
}

struct Lds8w { static constexpr int KSLOT=8192, VSLOT=8192, K=0, V=NSLOT*KSLOT, WS=V+NSLOT*VSLOT, OST=WS+NW*64*4, BYTES=OST+NW*4096; };
template<int NT,int QP,int KP,int OP,int O8> __device__ __forceinline__ void attn_unit8w(const unsigned char*Q8u,const unsigned char*__restrict__ K8b,const unsigned char*__restrict__ VTb,bf16*Ou,char*shm){
  typedef Lds8w L; constexpr int ND=2, NV=1, VSLOT=L::VSLOT, KSLOT=L::KSLOT, NS=NT/2;
  static_assert((NT&3)==0 && NS>8,"attn_unit8w");
  const int tid=threadIdx.x,lane=tid&63,r32=lane&31,hi=lane>>5; const int wid=__builtin_amdgcn_readfirstlane(tid>>6);
  const unsigned lds0=(unsigned)(uintptr_t)shm;
  const unsigned koff=(unsigned)((64*(wid&1)+lane)*KP+16*(wid>>1));
  const unsigned voff=(unsigned)((wid>>2)*4096+lane*64+16*(wid&3));
  const unsigned kdst=(unsigned)__builtin_amdgcn_readfirstlane(lds0+L::K+wid*1024), vdst=(unsigned)__builtin_amdgcn_readfirstlane(lds0+L::V+wid*1024);
  #define RFL(x) ((unsigned)__builtin_amdgcn_readfirstlane((int)(x)))
  #define DMA_K(t,slot) do{ glds16s(K8b+(long)(t)*128*KP,koff,RFL(kdst+(slot)*KSLOT)); }while(0)
  #define DMA_V(t,slot) do{ glds16s(VTb+(long)(t)*VSLOT,voff,RFL(vdst+(slot)*VSLOT)); }while(0)
  #define DMA_KV(tk,ks,tv,vs) do{ glds16s2(K8b+(long)(tk)*128*KP,koff,RFL(kdst+(ks)*KSLOT),VTb+(long)(tv)*VSLOT,voff,RFL(vdst+(vs)*VSLOT)); }while(0)
  #define WAITB_KV() asm volatile("s_waitcnt vmcnt(2) lgkmcnt(0)\n\ts_barrier":::"memory")
  #define WAITB_V()  asm volatile("s_waitcnt vmcnt(1) lgkmcnt(0)\n\ts_barrier":::"memory")
  #define WAITB_0()  asm volatile("s_waitcnt vmcnt(0) lgkmcnt(0)\n\ts_barrier":::"memory")
  const lds_cptr shm3=(lds_cptr)shm; const lds_cptr kp0=shm3+L::K+(2*hi)*2048+r32*16; const lds_cptr vp0=shm3+L::V+(2*hi)*1024+r32*16;
  i32x8_t kf[4], vf[2][2], q8, wA[2]={{0,0,0,0,0,0,0,0},{0,0,0,0,0,0,0,0}}, wB[2]={{0,0,0,0,0,0,0,0},{0,0,0,0,0,0,0,0}};
  #define KLD(slot) do{ const lds_cptr kp_=kp0+(slot)*KSLOT; _Pragma("unroll") for(int b_=0;b_<4;++b_){ kf[b_].lo=*(lds_i4p)(kp_+b_*512); kf[b_].hi=*(lds_i4p)(kp_+2048+b_*512); } }while(0)
  #define VLD(slot) do{ const lds_cptr vp_=vp0+(slot)*VSLOT; _Pragma("unroll") for(int h_=0;h_<2;++h_) _Pragma("unroll") for(int d_=0;d_<2;++d_){ vf[h_][d_].lo=*(lds_i4p)(vp_+h_*4096+d_*512); vf[h_][d_].hi=*(lds_i4p)(vp_+h_*4096+1024+d_*512); } }while(0)
  DMA_K(0,0);DMA_V(0,0);DMA_K(1,1);
  { const unsigned char*qp=Q8u+(long)(wid*QBLK+r32)*QP+32*hi; q8.lo=*(const i32x4_t*)qp; q8.hi=*(const i32x4_t*)(qp+16); }
  f32x16 o[ND]; f32x16 os=f32x16{};
  #pragma unroll
  for(int d_=0;d_<ND;++d_)o[d_]=f32x16{};
  i32x8_t ones8; { int one_=0x38383838; asm volatile("":"+s"(one_)); ones8=(i32x8_t){one_,one_,one_,one_,one_,one_,one_,one_}; asm volatile("":"+v"(ones8)); }
  f32x16 c0,c1,c2,c3;
  int sp=0,sc=0,sn=1;
  #define ROT() do{sp=sc;sc=sn;sn=(sn==NSLOT-1)?0:sn+1;}while(0)
  #define MFZ(D,A_,B_) asm volatile("v_mfma_f32_32x32x64_f8f6f4 %0, %1, %2, -4.0":"=&v"(D):"v"(A_),"v"(B_))
  #define MFA(D,A_,B_) asm volatile("v_mfma_f32_32x32x64_f8f6f4 %0, %1, %2, %0":"+v"(D):"v"(A_),"v"(B_))
  #define EXR(C,lo_,n_) do{ _Pragma("unroll") for(int e_=(lo_);e_<(lo_)+(n_);++e_) C[e_]=__builtin_amdgcn_exp2f(C[e_]); asm volatile("":"+v"(C)); }while(0)
  #define PACK(P,W,base) do{ _Pragma("unroll") for(int j_=0;j_<4;++j_) W[(base)+j_]=(int)pk4c(P[4*j_],P[4*j_+1],P[4*j_+2],P[4*j_+3],(unsigned)W[(base)+j_]); asm volatile("":"+v"(W)); }while(0)
  DMA_K(2,2);
  asm volatile("s_waitcnt vmcnt(3) lgkmcnt(0)\n\ts_barrier":::"memory");
  KLD(0);
  MFZ(c0,kf[0],q8); MFZ(c1,kf[1],q8); MFZ(c2,kf[2],q8); MFZ(c3,kf[3],q8);
  asm volatile("s_nop 15\n\ts_nop 15":"+v"(c0),"+v"(c1),"+v"(c2),"+v"(c3));
  EXR(c0,0,16); PACK(c0,wA[0],0); EXR(c1,0,16); PACK(c1,wA[0],4); EXR(c2,0,16); PACK(c2,wA[1],0); EXR(c3,0,16); PACK(c3,wA[1],4);
  WAITB_0();
  DMA_K(3,0);DMA_V(1,1);
  ROT();
  KLD(sc);
  WAITB_KV();
  #define STEP9W(WP,WN,t,GK,GV,GL) do{ SBAR(); \
    VLD(sp); SBAR(); \
    MFZ(c0,kf[0],q8); SBAR(); \
    if((GK)&&(GV)){ DMA_KV((t)+3,sc,(t)+1,sn); } else { if(GK){DMA_K((t)+3,sc);} if(GV){DMA_V((t)+1,sn);} } SBAR(); \
    MFZ(c1,kf[1],q8); MFZ(c2,kf[2],q8); MFZ(c3,kf[3],q8); SBAR(); \
    if(GL){KLD(sn);} SBAR(); \
    MFA(o[0],WP[0],vf[0][0]); SBAR(); EXR(c0,0,16); PACK(c0,WN[0],0); SBAR(); \
    MFA(o[1],WP[0],vf[0][1]); SBAR(); EXR(c1,0,8); SBAR(); \
    asm volatile("s_nop 1":::); MFA(os,WP[0],ones8); SBAR(); EXR(c1,8,8); PACK(c1,WN[0],4); SBAR(); \
    MFA(o[0],WP[1],vf[1][0]); SBAR(); EXR(c2,0,16); PACK(c2,WN[1],0); SBAR(); \
    MFA(o[1],WP[1],vf[1][1]); SBAR(); EXR(c3,0,8); SBAR(); \
    asm volatile("s_nop 1":::); MFA(os,WP[1],ones8); SBAR(); EXR(c3,8,8); PACK(c3,WN[1],4); SBAR(); \
    }while(0)
  if(ATT_PRIO && wid>=4) __builtin_amdgcn_s_setprio(1);
  int t=1;
  for(;t+5<NS;t+=2){
    STEP9W(wA,wB,t,true,true,true);     WAITB_KV(); ROT();
    STEP9W(wB,wA,t+1,true,true,true);   WAITB_KV(); ROT();
  }
  #define ENDW(tt) do{ if((tt)+3<NS){WAITB_KV();} else if((tt)+2<NS){WAITB_V();} else {WAITB_0();} }while(0)
  for(;t+1<NS;t+=2){
    STEP9W(wA,wB,t,(t+3<NS),(t+1<NS),(t+1<NS));       ENDW(t);   ROT();
    STEP9W(wB,wA,t+1,(t+4<NS),(t+2<NS),(t+2<NS));     ENDW(t+1); ROT();
  }
  STEP9W(wA,wB,NS-1,false,false,false);
  if(ATT_PRIO && wid>=4) __builtin_amdgcn_s_setprio(0);
  { VLD(sc); SBAR();
    MFA(o[0],wB[0],vf[0][0]); MFA(o[1],wB[0],vf[0][1]); MFA(o[0],wB[1],vf[1][0]); MFA(o[1],wB[1],vf[1][1]);
    asm volatile("s_nop 1":::); MFA(os,wB[0],ones8); MFA(os,wB[1],ones8); asm volatile("s_nop 15\n\ts_nop 15":"+v"(os)); }
  #undef STEP9W
  #undef ENDW
  #undef MFZ
  #undef MFA
  #undef EXR
  #undef PACK
  #undef KLD
  #undef VLD
  #undef RFL
  float rli[16];
  #pragma unroll
  for(int r=0;r<16;++r)rli[r]=__builtin_amdgcn_rcpf(os[r]);
  if constexpr(O8!=0){ unsigned char*Ow8=(unsigned char*)Ou+(long)(wid*QBLK)*OP; unsigned char*stg8=(unsigned char*)(shm+L::OST)+wid*4096;
      #pragma unroll
      for(int r=0;r<16;++r){const int orow=crow(r,hi);
        #pragma unroll
        for(int d0=0;d0<2;++d0){ const float v=__builtin_amdgcn_fmed3f(o[d0][r]*rli[r]*YA8_SCALE,-448.0f,448.0f); stg8[orow*64+d0*32+r32]=(unsigned char)__builtin_amdgcn_cvt_pk_fp8_f32(v,v,0,false); } }
      asm volatile("s_waitcnt lgkmcnt(0)":::"memory");
      #pragma unroll
      for(int i=0;i<2;++i){const int row=i*16+(lane>>2),ch=lane&3; const u32x4 v=*(const u32x4*)(stg8+row*64+ch*16); *(u32x4*)(Ow8+(long)row*OP+ch*16)=v;}
      asm volatile("s_waitcnt lgkmcnt(0)":::"memory");
  } else {
  bf16*Ow=Ou+(long)(wid*QBLK)*OP;
  { bf16*stg=(bf16*)(shm+L::OST)+wid*2048;
      #pragma unroll
      for(int r=0;r<16;++r){const int orow=crow(r,hi);
        #pragma unroll
        for(int d0=0;d0<2;++d0)stg[orow*64+d0*32+r32]=__float2bfloat16(o[d0][r]*rli[r]);}
      asm volatile("s_waitcnt lgkmcnt(0)":::"memory");
      #pragma unroll
      for(int i=0;i<4;++i){const int row=i*8+(lane>>3),ch=lane&7; const u32x4 v=*(const u32x4*)(stg+row*64+ch*8); *(u32x4*)(Ow+(long)row*OP+ch*8)=v;}
      asm volatile("s_waitcnt lgkmcnt(0)":::"memory");
  } }
  asm volatile("s_waitcnt lgkmcnt(0)\n\ts_barrier":::"memory");
  #undef DMA_K
  #undef DMA_V
  #undef DMA_KV
  #undef WAITB_KV
  #undef WAITB_V
  #undef WAITB_0
  #undef ROT
}
constexpr int ATTN_LDS_BYTES=LDS_BYTES;
#undef SBAR
#undef WAIT_BAR
}
constexpr int NWAVES = 8;
constexpr int RING_OFF = 0, RING_BYTES = 135168;
constexpr int LDSCTL_OFF = RING_BYTES, MISC_OFF = LDSCTL_OFF + 320;
constexpr int TB_OFF = LDSCTL_OFF + 512;
constexpr int LDS_BYTES = 151552;
constexpr int CW_BAR = 4096;
constexpr int N_PHASES = 11;
static_assert(attn_body::Lds8<128>::BYTES <= RING_BYTES && attn_body::Lds8<64>::BYTES <= RING_BYTES, "attention LDS");
static_assert(RING_OFF == 0 && LDSCTL_OFF + 6144 == pg8::PF_OFF && TB_OFF + 4 * (128 + 4 * 320) <= LDSCTL_OFF + 6144 && pg8::PF_OFF + 3072 <= LDS_BYTES, "LDS map");
#ifndef ABL_PROBE
#define ABL_PROBE 0
#endif
#ifndef ATT8_ONES_B
#define ATT8_ONES_B true
#endif
#ifndef ATT8_WIDE_A
#define ATT8_WIDE_A 1
#endif
#if ATT8_WIDE_A
#define ATT8_UNIT_A attn_unit8w<SK / 64, 512, 128, 1024, MERGE_FP8>
#else
#define ATT8_UNIT_A attn_unit8<64, true, SK / 64, 512, 128, 1024, MERGE_FP8>
#endif
#ifndef ATT_XCD_ROWS
#define ATT_XCD_ROWS 1
#endif
#ifndef W8_TALL
#define W8_TALL 1
#endif
#ifndef TOPO_SYNC
#define TOPO_SYNC 1
#endif
constexpr int CW_TOPO = 3072;
#ifndef CENSUS_PAR
#define CENSUS_PAR 1
#endif
#ifndef FUSE_DIFFOUT
#define FUSE_DIFFOUT 1
#endif
#ifndef WSTAGGER
#define WSTAGGER 1
#endif
#ifndef ATT_UNIT_A
#define ATT_UNIT_A attn_unit2
#endif
#ifndef ATT_UNIT_B
#define ATT_UNIT_B attn_unit2
#endif
#ifndef ATT_ONES_A
#define ATT_ONES_A true
#endif
#ifndef ATT_ONES_B
#define ATT_ONES_B false
#endif

typedef GAS unsigned gu32;
#define XB_TMO      128
#define XB_XCNT(j)  (256  + 64 * (j))
#define XB_XSUB(j)  (1280 + 64 * (j))
#define XB_XGEN(j)  (2304 + 64 * (j))
#define XB_TOP      3328
#define XB_TOPGEN   3392
#define XCD_BAR_WORDS 3456
#define XB_SPIN_CAP (1u << 18)

__device__ __forceinline__ unsigned xb_ld(unsigned* p)              { return __hip_atomic_load(p, __ATOMIC_RELAXED, __HIP_MEMORY_SCOPE_AGENT); }
__device__ __forceinline__ unsigned xb_add(unsigned* p, unsigned v) { return __hip_atomic_fetch_add(p, v, __ATOMIC_RELAXED, __HIP_MEMORY_SCOPE_AGENT); }
__device__ __forceinline__ unsigned xb_xcc_id() { return (unsigned)__builtin_amdgcn_s_getreg((3 << 11) | 20) & 0xFu; }
#define XB_SPIN(cond, bar) do { unsigned _sp = 0; while (cond) { __builtin_amdgcn_s_sleep(1); \
    if ((++_sp & 255u) == 0u) { if (xb_ld(&(bar)[XB_TMO])) break; if (_sp > XB_SPIN_CAP) { atomicAdd(&(bar)[XB_TMO], 1u); break; } } } } while (0)

struct XcdBarrier {
    unsigned* bar; unsigned x;
    volatile LAS unsigned* st;
};

__device__ __forceinline__ XcdBarrier xcd_barrier_post(unsigned* bar, volatile LAS unsigned* st) {
    XcdBarrier b; b.bar = bar; b.x = xb_xcc_id(); b.st = st;
    if (threadIdx.x == 0) (void)xb_add(&bar[XB_XCNT(b.x)], 1u);
    return b;
}
__device__ __forceinline__ void xcd_barrier_complete(unsigned* bar, unsigned x, unsigned& nloc, unsigned& nx) {
    const unsigned G = gridDim.x * gridDim.y * gridDim.z;
    unsigned sum, cnt, mine, sp = 0u;
    for (;;) {
        sum = 0u; cnt = 0u; mine = 0u;
#pragma unroll
        for (unsigned j = 0; j < 16; ++j) { const unsigned c = xb_ld(&bar[XB_XCNT(j)]); sum += c; cnt += (c > 0u) ? 1u : 0u; mine = (j == x) ? c : mine; }
        if (sum == G) break;
        __builtin_amdgcn_s_sleep(1);
        if ((++sp & 255u) == 0u) { if (xb_ld(&bar[XB_TMO])) break; if (sp > XB_SPIN_CAP) { atomicAdd(&bar[XB_TMO], 1u); break; } }
    }
    nloc = mine > 0u ? mine : 1u; nx = cnt > 0u ? cnt : 1u;
}

__device__ __forceinline__ void xcd_barrier(const XcdBarrier& b) {
    asm volatile("s_waitcnt vmcnt(0)" ::: "memory");
    __syncthreads();
    if (threadIdx.x == 0) {
        unsigned* bar = b.bar;
        __builtin_amdgcn_s_waitcnt(0);
        unsigned nloc = b.st[0], nx = b.st[1];
        if (nloc == 0u) { xcd_barrier_complete(bar, b.x, nloc, nx); b.st[0] = nloc; b.st[1] = nx; }
        const unsigned old = xb_add(&bar[XB_XSUB(b.x)], 1u);
        const unsigned gen = old / nloc;
        if (old + 1u == (gen + 1u) * nloc) {
            __builtin_amdgcn_fence(__ATOMIC_RELEASE, "agent");
            asm volatile("s_waitcnt vmcnt(0)" ::: "memory");
            const unsigned og = xb_add(&bar[XB_TOP], 1u);
            const unsigned tg = og / nx;
            if (og + 1u == (tg + 1u) * nx) xb_add(&bar[XB_TOPGEN], 1u);
            else XB_SPIN(xb_ld(&bar[XB_TOPGEN]) == tg, bar);
            __builtin_amdgcn_fence(__ATOMIC_ACQUIRE, "agent");
            xb_add(&bar[XB_XGEN(b.x)], 1u);
            asm volatile("s_waitcnt vmcnt(0)" ::: "memory");
        } else {
            XB_SPIN(xb_ld(&bar[XB_XGEN(b.x)]) == gen, bar);
            __builtin_amdgcn_fence(__ATOMIC_ACQUIRE, "agent");
            asm volatile("s_waitcnt vmcnt(0)" ::: "memory");
        }
    }
    __syncthreads();
}


struct TItem { const float* src; bf16* dst; int K, N, k0, n0, kind; };
__device__ __forceinline__ int titem_drow(int kind, int c) {
    return kind == 0 ? c : kind == 1 ? (c & ~255) + 128 * ((c >> 5) & 1) + 32 * ((c >> 6) & 3) + (c & 31) : kind == 2 ? 256 * (c >> 7) + (c & 127) : 256 * (c >> 7) + 128 + (c & 127);
}
__device__ __forceinline__ void titem_load(const TItem& t, int lane, f32x4 (&va)[8], f32x4 (&vb)[8]) {
    const float* src = t.src + (size_t)(t.k0 + 2 * (lane >> 4)) * t.N + t.n0 + 4 * (lane & 15);
#pragma unroll
    for (int i = 0; i < 8; ++i) { va[i] = __builtin_nontemporal_load((const f32x4*)(src + (size_t)(8 * i) * t.N)); vb[i] = __builtin_nontemporal_load((const f32x4*)(src + (size_t)(8 * i + 1) * t.N)); }
}
__device__ __forceinline__ void titem_finish(const TItem& t, int lane, LAS unsigned* scr, const f32x4 (&va)[8], const f32x4 (&vb)[8]) {
    const int kp = lane >> 4, n4 = lane & 15;
#pragma unroll
    for (int i = 0; i < 8; ++i) { pg8::u32x4 w; w.x = pg8::cvt_pk_bf16(va[i].x, vb[i].x); w.y = pg8::cvt_pk_bf16(va[i].y, vb[i].y); w.z = pg8::cvt_pk_bf16(va[i].z, vb[i].z); w.w = pg8::cvt_pk_bf16(va[i].w, vb[i].w);
        *(LAS pg8::u32x4*)(scr + (4 * i + kp) * 68 + 4 * n4) = w; }
    asm volatile("s_waitcnt lgkmcnt(0)" ::: "memory");
    const int c = lane & 7;
#pragma unroll
    for (int j = 0; j < 8; ++j) { const int n = (lane >> 3) + 8 * j; const LAS unsigned* s = scr + (4 * c) * 68 + n;
        pg8::u32x4 o; o.x = s[0]; o.y = s[68]; o.z = s[136]; o.w = s[204];
        __builtin_nontemporal_store(o, (pg8::u32x4*)(t.dst + (size_t)titem_drow(t.kind, t.n0 + n) * t.K + t.k0 + 8 * c)); }
    asm volatile("s_waitcnt lgkmcnt(0)" ::: "memory");
}
__device__ __forceinline__ void titem8_load(const TItem& t, int lane, f32x4 (&v)[16]) {
    const float* src = t.src + (size_t)(t.k0 + 4 * (lane >> 4)) * t.N + t.n0 + 4 * (lane & 15);
#pragma unroll
    for (int i = 0; i < 4; ++i)
#pragma unroll
        for (int j = 0; j < 4; ++j) v[4 * i + j] = __builtin_nontemporal_load((const f32x4*)(src + (size_t)(16 * i + j) * t.N));
}
__device__ __forceinline__ void titem8_finish(const TItem& t, int lane, LAS unsigned* scr, const f32x4 (&v)[16]) {
    const int kq = lane >> 4, n4 = lane & 15;
#pragma unroll
    for (int i = 0; i < 4; ++i) { pg8::u32x4 w;
        w.x = pk4_fp8(v[4 * i][0] * W8_SCALE, v[4 * i + 1][0] * W8_SCALE, v[4 * i + 2][0] * W8_SCALE, v[4 * i + 3][0] * W8_SCALE);
        w.y = pk4_fp8(v[4 * i][1] * W8_SCALE, v[4 * i + 1][1] * W8_SCALE, v[4 * i + 2][1] * W8_SCALE, v[4 * i + 3][1] * W8_SCALE);
        w.z = pk4_fp8(v[4 * i][2] * W8_SCALE, v[4 * i + 1][2] * W8_SCALE, v[4 * i + 2][2] * W8_SCALE, v[4 * i + 3][2] * W8_SCALE);
        w.w = pk4_fp8(v[4 * i][3] * W8_SCALE, v[4 * i + 1][3] * W8_SCALE, v[4 * i + 2][3] * W8_SCALE, v[4 * i + 3][3] * W8_SCALE);
        *(LAS pg8::u32x4*)(scr + (4 * i + kq) * 68 + 4 * n4) = w; }
    asm volatile("s_waitcnt lgkmcnt(0)" ::: "memory");
    const int c = lane & 3;
#pragma unroll
    for (int j = 0; j < 4; ++j) { const int n = (lane >> 2) + 16 * j; const LAS unsigned* s = scr + (4 * c) * 68 + n;
        pg8::u32x4 o; o.x = s[0]; o.y = s[68]; o.z = s[136]; o.w = s[204];
        __builtin_nontemporal_store(o, (pg8::u32x4*)((unsigned char*)t.dst + (size_t)titem_drow(t.kind, t.n0 + n) * t.K + t.k0 + 16 * c)); }
    asm volatile("s_waitcnt lgkmcnt(0)" ::: "memory");
}
__device__ __forceinline__ void titem8t_load(const TItem& t, int lane, f32x4 (&v)[16]) {
    const float* src = t.src + (size_t)(t.k0 + 4 * (lane >> 3)) * t.N + t.n0 + 4 * (lane & 7);
#pragma unroll
    for (int i = 0; i < 4; ++i)
#pragma unroll
        for (int j = 0; j < 4; ++j) v[4 * i + j] = __builtin_nontemporal_load((const f32x4*)(src + (size_t)(32 * i + j) * t.N));
}
__device__ __forceinline__ void titem8t_finish(const TItem& t, int lane, LAS unsigned* scr, const f32x4 (&v)[16]) {
    const int kq = lane >> 3, n4 = lane & 7;
#pragma unroll
    for (int i = 0; i < 4; ++i) { pg8::u32x4 w;
        w.x = pk4_fp8(v[4 * i][0] * W8_SCALE, v[4 * i + 1][0] * W8_SCALE, v[4 * i + 2][0] * W8_SCALE, v[4 * i + 3][0] * W8_SCALE);
        w.y = pk4_fp8(v[4 * i][1] * W8_SCALE, v[4 * i + 1][1] * W8_SCALE, v[4 * i + 2][1] * W8_SCALE, v[4 * i + 3][1] * W8_SCALE);
        w.z = pk4_fp8(v[4 * i][2] * W8_SCALE, v[4 * i + 1][2] * W8_SCALE, v[4 * i + 2][2] * W8_SCALE, v[4 * i + 3][2] * W8_SCALE);
        w.w = pk4_fp8(v[4 * i][3] * W8_SCALE, v[4 * i + 1][3] * W8_SCALE, v[4 * i + 2][3] * W8_SCALE, v[4 * i + 3][3] * W8_SCALE);
        *(LAS pg8::u32x4*)(scr + (8 * i + kq) * 36 + 4 * n4) = w; }
    asm volatile("s_waitcnt lgkmcnt(0)" ::: "memory");
    const int c = lane & 7;
#pragma unroll
    for (int j = 0; j < 4; ++j) { const int n = (lane >> 3) + 8 * j; const LAS unsigned* s = scr + (4 * c) * 36 + n;
        pg8::u32x4 o; o.x = s[0]; o.y = s[36]; o.z = s[72]; o.w = s[108];
        __builtin_nontemporal_store(o, (pg8::u32x4*)((unsigned char*)t.dst + (size_t)titem_drow(t.kind, t.n0 + n) * t.K + t.k0 + 16 * c)); }
    asm volatile("s_waitcnt lgkmcnt(0)" ::: "memory");
}
constexpr int I_INA = 16 * (INPROJ_FP8_ALL ? 0 : INPROJ_GATE_FP8 ? 36 : 68), I_ING = 16 * (INPROJ_FP8_ALL ? 68 : INPROJ_GATE_FP8 ? 32 : 0), I_OA = 8 * 16, I_OUT = 16 * 16, I_EX = 16 * 16;
constexpr int I_B16 = I_INA + (MERGE_FP8 ? 0 : 2 * I_OA + I_OUT), I_SMALL = I_INA + 2 * I_OA + I_OUT + I_ING, NIT = I_SMALL + NE * 3 * I_EX;
constexpr size_t WS_WOB8 = WS_WOA + (size_t)1024 * 512;
constexpr size_t WS_WIN8 = WS_WIN + (size_t)2304 * 2048;
__device__ __forceinline__ TItem weight_titem(const P& p, int it) {
    TItem t; int r = it; int item;
    if (r < I_INA) { t.src = p.w_in; t.dst = (bf16*)(p.ws + WS_WIN); t.K = D; t.N = INC; t.kind = 1; const int nb = I_INA / 16; t.k0 = 64 * (r / nb); t.n0 = 64 * (r % nb); return t; }
    else if ((r -= I_INA) < I_OA) { t.src = p.w_oa; t.dst = (bf16*)(p.ws + WS_WOA); t.K = 512; t.N = D; t.kind = 0; item = r; }
    else if ((r -= I_OA) < I_OA) { t.src = p.w_ob; t.dst = (bf16*)(p.ws + (MERGE_FP8 ? WS_WOB8 : WS_WOB)); t.K = 512; t.N = D; t.kind = 0; item = r; }
    else if ((r -= I_OA) < I_OUT) { t.src = p.w_out; t.dst = (bf16*)(p.ws + WS_WOUT); t.K = D; t.N = D; t.kind = 0; item = r; }
    else if ((r -= I_OUT) < I_ING) { t.src = p.w_in; t.K = D; t.N = INC; t.kind = 1;
        if (INPROJ_FP8_ALL) { t.dst = (bf16*)(p.ws + WS_WIN); t.k0 = 64 * (r / 68); t.n0 = 64 * (r % 68); }
        else { t.dst = (bf16*)(p.ws + WS_WIN8 - (size_t)2304 * D); t.k0 = 64 * (r / 32); t.n0 = 2304 + 64 * (r % 32); }
        return t; }
    else { r -= I_ING; const int e = r / (3 * I_EX), q = (r / I_EX) % 3; item = r % I_EX; t.K = D; t.N = D;
        constexpr size_t EBW = MOE_FP8 ? 1 : 2;
        if (q == 0) { t.src = p.w_gate + (size_t)e * D * D; t.dst = (bf16*)(p.ws + WS_WGU + (size_t)e * 2048 * D * EBW); t.kind = 2; }
        else if (q == 1) { t.src = p.w_up + (size_t)e * D * D; t.dst = (bf16*)(p.ws + WS_WGU + (size_t)e * 2048 * D * EBW); t.kind = 3; }
        else { t.src = p.w_down + (size_t)e * D * D; t.dst = (bf16*)(p.ws + WS_WD + (size_t)e * D * D * EBW); t.kind = 0; } }
    if (W8_TALL && MOE_FP8 && it >= I_SMALL) { t.k0 = 128 * (item / 32); t.n0 = 32 * (item % 32); return t; }
    const int nblk = t.N / 64; t.k0 = 64 * (item / nblk); t.n0 = 64 * (item % nblk); return t;
}
template <bool F8, bool TALL = false>
__device__ __forceinline__ void weight_items(const P& p, int first, int step, int hi, LAS unsigned* scr, int lane) {
    for (int it = first; it < hi; it += 2 * step) {
        const bool two = it + step < hi;
        const TItem t0 = weight_titem(p, it), t1 = weight_titem(p, two ? it + step : it);
        if constexpr (F8) {
            f32x4 v0[16], v1[16];
            if constexpr (TALL) { titem8t_load(t0, lane, v0); if (two) titem8t_load(t1, lane, v1);
                titem8t_finish(t0, lane, scr, v0); if (two) titem8t_finish(t1, lane, scr, v1); }
            else { titem8_load(t0, lane, v0); if (two) titem8_load(t1, lane, v1);
            titem8_finish(t0, lane, scr, v0); if (two) titem8_finish(t1, lane, scr, v1); }
        } else {
            f32x4 a0[8], b0[8], a1[8], b1[8];
            titem_load(t0, lane, a0, b0); if (two) titem_load(t1, lane, a1, b1);
            titem_finish(t0, lane, scr, a0, b0); if (two) titem_finish(t1, lane, scr, a1, b1);
        }
    }
}
__device__ __forceinline__ void ph_weights(const P& p, int vb, int nvb, LAS unsigned char* lds, int lo, int hi) {
    const int lane = threadIdx.x & 63, wave = threadIdx.x >> 6;
    const int mid = hi < I_B16 ? hi : I_B16;
    if (lo < mid) weight_items<false>(p, lo + vb * NWAVES + wave, nvb * NWAVES, mid, (LAS unsigned*)(lds + wave * 8704), lane);
    if (hi > I_B16 && I_ING > 0) { const int l2 = lo > I_B16 ? lo : I_B16, h2 = hi < I_SMALL ? hi : I_SMALL; weight_items<true>(p, l2 + vb * NWAVES + wave, nvb * NWAVES, h2, (LAS unsigned*)(lds + wave * 8704), lane); }
    if (hi > I_SMALL) { const int l2 = lo > I_SMALL ? lo : I_SMALL; weight_items<MOE_FP8 != 0, (W8_TALL && MOE_FP8)>(p, l2 + vb * NWAVES + wave, nvb * NWAVES, hi, (LAS unsigned*)(lds + wave * 8704), lane); }
}
__device__ __forceinline__ void ph_weights_share(const P& p, int vb, int nvb, LAS unsigned char* lds) {
    int lane = threadIdx.x & 63; const int wave = threadIdx.x >> 6;
    asm volatile("" : "+v"(lane));
    const int per = (NIT - I_SMALL + nvb - 1) / nvb, lo = I_SMALL + vb * per, hi = (lo + per < NIT) ? lo + per : NIT;
    weight_items<MOE_FP8 != 0, (W8_TALL && MOE_FP8)>(p, lo + wave, NWAVES, hi, (LAS unsigned*)(lds + wave * 8704), lane);
}

__device__ __forceinline__ void expert_tables(const P& p, LAS int* tb) {
    if (threadIdx.x < 64) { const int lane = threadIdx.x; const gu32* CNT = (const gu32*)((const unsigned*)(p.ws + WS_CTL) + CW_CNT);
        const int c = (int)__hip_atomic_load(CNT + 64 * (lane & 31), __ATOMIC_RELAXED, __HIP_MEMORY_SCOPE_AGENT);
        int pb = (c + 255) & ~255, pt = (c + 255) >> 8;
#pragma unroll
        for (int o = 1; o < 32; o <<= 1) { const int ub = __shfl_up(pb, o), ut = __shfl_up(pt, o); if ((lane & 31) >= o) { pb += ub; pt += ut; } }
        if (lane < 32) { tb[lane] = c; tb[32 + lane] = pb - ((c + 255) & ~255); tb[64 + lane] = pt - ((c + 255) >> 8); if (lane == 31) tb[64 + NE] = pt; } }
    __syncthreads();
    { const int rt = threadIdx.x; const int ntile = tb[64 + NE];
      if (rt < ntile && rt < 320) { int e = 0;
#pragma unroll 1
          while (tb[64 + e + 1] <= rt) ++e;
          tb[128 + 4 * rt] = e; tb[128 + 4 * rt + 1] = (rt - tb[64 + e]) * 256; tb[128 + 4 * rt + 2] = tb[e]; tb[128 + 4 * rt + 3] = tb[32 + e]; } }
    __syncthreads();
}

struct Args { P p; int ph_lo, ph_hi, li, pad; };
__global__ void __launch_bounds__(NWAVES * 64, 2) mk_fwd(Args a) {
    extern __shared__ __attribute__((aligned(16))) unsigned char lds_raw[];
    LAS unsigned char* lds = (LAS unsigned char*)lds_raw;
    volatile LAS unsigned* MISC = (volatile LAS unsigned*)(lds + MISC_OFF);
    const P& p = a.p;
    const int tid = threadIdx.x, G = gridDim.x, bx = blockIdx.x;
    for (int u = tid; u < (LDS_BYTES - LDSCTL_OFF) / 4; u += NWAVES * 64) ((LAS unsigned*)(lds + LDSCTL_OFF))[u] = 0u;
    __syncthreads();
    unsigned* barw = (unsigned*)(p.ws + WS_CTL) + CW_BAR + a.li * XCD_BAR_WORDS;
    XcdBarrier bar = xcd_barrier_post(barw, MISC + 8);
    unsigned* topo = (unsigned*)(p.ws + WS_CTL) + CW_TOPO + a.li * 768;
    bool topo_ok = false; int vcu = (G % 8 == 0) ? (bx % 8) * (G / 8) + bx / 8 : bx;
    if (TOPO_SYNC && a.li == 0) {
        if (tid == 0) MISC[10] = xb_add(&topo[16 * bar.x], 1u);
        if (tid < 64) { unsigned sp_ = 0u;
            for (;;) { const unsigned c_ = tid < 16 ? xb_ld(&topo[16 * tid]) : 0u; unsigned sum_ = c_;
#pragma unroll
                for (int o_ = 1; o_ < 16; o_ <<= 1) sum_ += __shfl_xor(sum_, o_);
                if (__builtin_amdgcn_readfirstlane(sum_) == (unsigned)G) {
                    const unsigned long long nz = __ballot(c_ > 0u), bad = __ballot(c_ != 0u && c_ != 32u);
                    const bool ok_ = G == 256 && __builtin_popcountll(nz) == 8 && bad == 0ull;
                    if (tid == 0) MISC[11] = ok_ ? 1u + (unsigned)__builtin_popcountll(nz & ((1ull << bar.x) - 1ull)) : 0u;
                    break; }
                __builtin_amdgcn_s_sleep(1); if (++sp_ > (1u << 22)) break; } }
        __syncthreads();
        const unsigned tr_ = MISC[11]; topo_ok = tr_ != 0u;
        if (topo_ok) vcu = (int)((tr_ - 1u) * 32u + MISC[10]);
    }
    unsigned* const lbw = topo + 256 + 16 * bar.x;
#define LOCAL_BAR() do { asm volatile("s_waitcnt vmcnt(0)" ::: "memory"); __syncthreads(); \
        if (tid == 0) { const unsigned old_ = xb_add(&lbw[0], 1u), gen_ = old_ / 32u; \
            if (old_ + 1u == (gen_ + 1u) * 32u) (void)xb_add(&lbw[256], 1u); else XB_SPIN(xb_ld(&lbw[256]) == gen_, barw); } \
        asm volatile("" ::: "memory"); __syncthreads(); } while (0)
    const int lo = a.ph_lo, hi = a.ph_hi;
#ifndef PH_COMPILED
#define PH_COMPILED 0x7ff
#endif
#define IN(k) ((((PH_COMPILED) >> (k)) & 1) && lo <= (k) && (k) < hi)
#define CENSUS() do { if (CENSUS_PAR && tid < 64 && MISC[8] == 0u) { unsigned sp_ = 0u; \
        for (;;) { const unsigned c_ = tid < 16 ? xb_ld(&barw[XB_XCNT(tid)]) : 0u; unsigned sum_ = c_, cnt_ = c_ > 0u ? 1u : 0u; \
            _Pragma("unroll") for (int o_ = 1; o_ < 16; o_ <<= 1) { sum_ += __shfl_xor(sum_, o_); cnt_ += __shfl_xor(cnt_, o_); } \
            const unsigned mine_ = __shfl(c_, (int)bar.x); \
            if (__builtin_amdgcn_readfirstlane(sum_) == (unsigned)G) { if (tid == 0) { MISC[8] = __builtin_amdgcn_readfirstlane(mine_); MISC[9] = __builtin_amdgcn_readfirstlane(cnt_); } break; } \
            __builtin_amdgcn_s_sleep(1); if (++sp_ > 20000u) break; } } } while (0)
#define SEAM(k) do { if (IN(k) && IN((k) + 1)) { CENSUS(); xcd_barrier(bar); } } while (0)
#define SEAM_L(k) do { if (IN(k) && IN((k) + 1)) { if (topo_ok) LOCAL_BAR(); else { CENSUS(); xcd_barrier(bar); } } } while (0)
#ifndef DUP_MASK
#define DUP_MASK 0
#endif
#if ((DUP_MASK) >> 0) & 1
#define REP0 _Pragma("unroll 1") for (int rep_ = 0; rep_ < 2; ++rep_)
#else
#define REP0
#endif
#if ((DUP_MASK) >> 1) & 1
#define REP1 _Pragma("unroll 1") for (int rep_ = 0; rep_ < 2; ++rep_)
#else
#define REP1
#endif
#if ((DUP_MASK) >> 2) & 1
#define REP2 _Pragma("unroll 1") for (int rep_ = 0; rep_ < 2; ++rep_)
#else
#define REP2
#endif
#if ((DUP_MASK) >> 3) & 1
#define REP3 _Pragma("unroll 1") for (int rep_ = 0; rep_ < 2; ++rep_)
#else
#define REP3
#endif
#if ((DUP_MASK) >> 4) & 1
#define REP4 _Pragma("unroll 1") for (int rep_ = 0; rep_ < 2; ++rep_)
#else
#define REP4
#endif
#if ((DUP_MASK) >> 5) & 1
#define REP5 _Pragma("unroll 1") for (int rep_ = 0; rep_ < 2; ++rep_)
#else
#define REP5
#endif
#if ((DUP_MASK) >> 6) & 1
#define REP6 _Pragma("unroll 1") for (int rep_ = 0; rep_ < 2; ++rep_)
#else
#define REP6
#endif
#if ((DUP_MASK) >> 7) & 1
#define REP7 _Pragma("unroll 1") for (int rep_ = 0; rep_ < 2; ++rep_)
#else
#define REP7
#endif
#if ((DUP_MASK) >> 8) & 1
#define REP8 _Pragma("unroll 1") for (int rep_ = 0; rep_ < 2; ++rep_)
#else
#define REP8
#endif
#if ((DUP_MASK) >> 9) & 1
#define REP9 _Pragma("unroll 1") for (int rep_ = 0; rep_ < 2; ++rep_)
#else
#define REP9
#endif
    LAS int* tb = (LAS int*)(lds + TB_OFF);

    if (IN(0)) { ph_mod(p, bx, G, (float*)lds_raw); __syncthreads(); ph_weights(p, bx, G, lds, 0, WSTAGGER ? I_SMALL : NIT);
#if ((DUP_MASK) >> 0) & 1
        __syncthreads(); ph_weights(p, bx, G, lds, 0, WSTAGGER ? I_SMALL : NIT);
#endif
#if ((DUP_MASK) >> 13) & 1
        __syncthreads(); ph_mod(p, bx, G, (float*)lds_raw);
#endif
    }
    SEAM(0);
    if (IN(1)) { ph_norm1(p, INPROJ_XCD_BLOCKS ? vcu : bx, G); ph_router_prep(p, bx, G);
#if ((DUP_MASK) >> 1) & 1
        ph_norm1(p, INPROJ_XCD_BLOCKS ? vcu : bx, G);
#endif
    }
    if (INPROJ_XCD_BLOCKS && INPROJ_FP8_ALL) SEAM_L(1); else SEAM(1);
    if (IN(2)) {
        pg8::Gemm g{(const bf16*)(p.ws + WS_HX), (const bf16*)(p.ws + WS_WIN), D, D};
        EpiInProj E{p.ws, p.q_norm_a, p.k_norm_a, p.q_norm_b, p.k_norm_b};
#if INPROJ_FP8_ALL
        { pg8::Gemm g8{(const bf16*)(p.ws + WS_HX8), (const bf16*)(p.ws + WS_WIN), D, D}; SchedInProj S; S.G = G; S.v = vcu;
          pg8::gemm_phase<EpiInProj, SchedInProj, true>(lds + RING_OFF, g8, S, E);
#if ((DUP_MASK) >> 2) & 1
          pg8::gemm_phase<EpiInProj, SchedInProj, true>(lds + RING_OFF, g8, S, E);
#endif
          }
#elif INPROJ_GATE_FP8
        { SchedInProjA S; S.G = G; S.v = vcu; pg8::gemm_phase<EpiInProj, SchedInProjA, true>(lds + RING_OFF, g, S, E); }
        { pg8::Gemm g8{(const bf16*)(p.ws + WS_HX8), (const bf16*)(p.ws + WS_WIN8), D, D}; SchedInProjG S; S.G = G; S.v = vcu; EpiInProjG E8{p.ws};
          pg8::gemm_phase<EpiInProjG, SchedInProjG, true>(lds + RING_OFF, g8, S, E8); }
#else
        SchedInProj S; S.G = G; S.v = vcu;
        pg8::gemm_phase<EpiInProj, SchedInProj, true>(lds + RING_OFF, g, S, E);
#endif
#if (((DUP_MASK) >> 2) & 1) && !INPROJ_GATE_FP8
        pg8::gemm_phase<EpiInProj, SchedInProj, true>(lds + RING_OFF, g, S, E);
#endif
    }
    SEAM(2);
    REP3 if (IN(3) && G == 256) {
        using attn_body::attn_unit2; using attn_body::attn_unit3; typedef attn_body::bf16 abf;
        const int x = vcu >> 5, j = vcu & 31;
        char* shm = (char*)lds_raw + RING_OFF;
        const int wslot = WSTAGGER ? (j % 5) : -1;
#define WSLOT(s) do { if (wslot == (s)) { ph_weights_share(p, vcu, G, lds); __syncthreads(); } } while (0)
#if ATT_FP8
        { const int b = x >> 2;
#pragma unroll 1
          for (int i = 0; i < 2 * (1 + (((DUP_MASK) >> 11) & 1)); ++i) {
            const int kvh = ATT_XCD_ROWS ? (i & 1) : (x >> 1) & 1, u = j + 32 * (i & 1), h = ATT_XCD_ROWS ? kvh * 4 + (j >> 3) : kvh * 4 + (x & 1) * 2 + (u >> 5), qb = ATT_XCD_ROWS ? (x & 3) * 8 + (j & 7) : u & 31;
            const size_t qrow = (size_t)b * SEQ + qb * 256;
            if (i < 2) { WSLOT(i);
            attn_body::ATT8_UNIT_A(p.ws + WS_QA + qrow * 512 + h * 64, p.ws + WS_KA + (size_t)b * SK * 128 + kvh * 64,
                p.ws + WS_VA + (size_t)((b * 2 + kvh) * (SK / 64)) * 4096, MERGE_FP8 ? (abf*)(p.ws + WS_AY + qrow * 1024 + h * 64) : (abf*)(p.ws + WS_AY) + qrow * 1024 + h * 64, shm); }
#if ((DUP_MASK) >> 11) & 1
            else attn_body::attn_unit8<64, true, SK / 64, 512, 128, 1024, 0, ABL_PROBE>(p.ws + WS_QA + qrow * 512 + h * 64, p.ws + WS_KA + (size_t)b * SK * 128 + kvh * 64,
                p.ws + WS_VA + (size_t)((b * 2 + kvh) * (SK / 64)) * 4096, (abf*)(p.ws + WS_HX8 + (size_t)(vcu >> 4) * 256 * 2048 + (size_t)(vcu & 15) * 128), shm);
#endif
            } }
        { const int b = x >> 2, h = ATT_XCD_ROWS ? (j >> 3) : (x & 3);
#pragma unroll 1
          for (int i = 0; i < 2 * (1 + (((DUP_MASK) >> 12) & 1)); ++i) { const int u = j + 32 * (i & 1), m = ATT_XCD_ROWS ? (i & 1) : u >> 5, qb = ATT_XCD_ROWS ? (x & 3) * 8 + (j & 7) : u & 31; const size_t qrow = (size_t)b * SEQ + qb * 256;
            if (i < 2) WSLOT(2 + i);
            attn_body::attn_unit8<128, ATT8_ONES_B, SK / 64, 512, 512, 512, 0>(p.ws + WS_QB + qrow * 512 + h * 128 + m * 64, p.ws + WS_KB + (size_t)b * SK * 512 + h * 128 + m * 64,
                p.ws + WS_VB + (size_t)((b * 4 + h) * (SK / 64)) * 8192, (abf*)(p.ws + WS_OB) + (size_t)m * T * 512 + qrow * 512 + h * 128, shm); } }
#else
        { const int b = x >> 2, kvh = (x >> 1) & 1;
#pragma unroll 1
          for (int i = 0; i < 2 * (1 + (((DUP_MASK) >> 11) & 1)); ++i) { const int u = j + 32 * (i & 1), h = kvh * 4 + (x & 1) * 2 + (u >> 5), qb = u & 31; const size_t qrow = (size_t)b * SEQ + qb * 256;
            WSLOT(i);
#if MERGE_FP8
            attn_unit2<64, ATT_ONES_A, SK / 64, 512, 128, 128, 1024, 1>((const abf*)(p.ws + WS_QA) + qrow * 512 + h * 64, (const abf*)(p.ws + WS_KA) + (size_t)b * SK * 128 + kvh * 64,
                (const abf*)(p.ws + WS_VA) + (size_t)b * SK * 128 + kvh * 64, (abf*)(p.ws + WS_AY + qrow * 1024 + h * 64), shm); } }
#else
            ATT_UNIT_A<64, ATT_ONES_A, SK / 64, 512, 128, 128, 1024>((const abf*)(p.ws + WS_QA) + qrow * 512 + h * 64, (const abf*)(p.ws + WS_KA) + (size_t)b * SK * 128 + kvh * 64,
                (const abf*)(p.ws + WS_VA) + (size_t)b * SK * 128 + kvh * 64, (abf*)(p.ws + WS_AY) + qrow * 1024 + h * 64, shm); } }
#endif
        { const int b = x >> 2, h = x & 3;
#pragma unroll 1
          for (int i = 0; i < 2 * (1 + (((DUP_MASK) >> 12) & 1)); ++i) { const int u = j + 32 * (i & 1), m = u >> 5, qb = u & 31; const size_t qrow = (size_t)b * SEQ + qb * 256;
            WSLOT(2 + i);
            ATT_UNIT_B<128, ATT_ONES_B, SK / 64, 512, 512, 512, 512>((const abf*)(p.ws + WS_QB) + qrow * 512 + h * 128 + m * 64, (const abf*)(p.ws + WS_KB) + (size_t)b * SK * 512 + h * 128 + m * 64,
                (const abf*)(p.ws + WS_VB) + (size_t)b * SK * 512 + h * 128, (abf*)(p.ws + WS_OB) + (size_t)m * T * 512 + qrow * 512 + h * 128, shm); } }
#endif
        if (FUSE_DIFFOUT) {
            asm volatile("s_waitcnt vmcnt(0)" ::: "memory"); __syncthreads();
            diffout_tile(p, (size_t)(x >> 2) * SEQ + (size_t)(ATT_XCD_ROWS ? (x & 3) * 8 + (j & 7) : j) * 256, ATT_XCD_ROWS ? (j >> 3) : (x & 3)); }
        WSLOT(4);
#undef WSLOT
    }
    if (!FUSE_DIFFOUT) SEAM(3);
    if (IN(4) && !FUSE_DIFFOUT) { ph_diffout(p, bx, G);
#if ((DUP_MASK) >> 4) & 1
        ph_diffout(p, bx, G);
#endif
    }
    if (ATT_XCD_ROWS && ATT_FP8 && FUSE_DIFFOUT) SEAM_L(4); else SEAM(4);
    if (IN(5)) {
        pg8::Gemm g{(const bf16*)(p.ws + WS_AY), (const bf16*)(p.ws + WS_WOA), 1024, 512}; SchedTile<2> S; S.G = G; S.v = vcu;
        EpiMerge E{(const bf16*)(p.ws + WS_G), (bf16*)(p.ws + WS_MERGED)};
        pg8::gemm_phase<EpiMerge, SchedTile<2>, true>(lds + RING_OFF, g, S, E);
#if ((DUP_MASK) >> 5) & 1
        pg8::gemm_phase<EpiMerge, SchedTile<2>, true>(lds + RING_OFF, g, S, E);
#endif
    }
    SEAM_L(5);
    if (IN(6)) {
        pg8::Gemm g{(const bf16*)(p.ws + WS_MERGED), (const bf16*)(p.ws + WS_WOUT), D, D}; SchedTile<1> S; S.G = G; S.v = vcu;
        EpiOut E{p.x, (const float*)(p.ws + WS_MOD), X1_BF16 ? (float*)(p.ws + WS_X1) : p.out};
        pg8::gemm_phase<EpiOut, SchedTile<1>, true>(lds + RING_OFF, g, S, E);
#if ((DUP_MASK) >> 6) & 1
        pg8::gemm_phase<EpiOut, SchedTile<1>, true>(lds + RING_OFF, g, S, E);
#endif
    }
    SEAM_L(6);
    if (IN(7)) ph_router2(p, vcu, G, lds_raw + RING_OFF, lds_raw + LDSCTL_OFF + 1024);
    SEAM(7);
    REP8 if (IN(8)) {
        expert_tables(p, tb);
        pg8::Gemm g{(const bf16*)(p.ws + WS_HM), (const bf16*)(p.ws + WS_WGU), D, D}; SchedMoe<8, true> S; S.G = G; S.v = vcu; S.tb = tb; S.tok = (const int*)(p.ws + WS_TOK);
        EpiMoe1 E{p.b_gate, p.b_up, (bf16*)(p.ws + WS_ACT), (const LAS unsigned char*)(lds + pg8::PF_OFF)};
        pg8::gemm_phase<EpiMoe1, SchedMoe<8, true>, true>(lds + RING_OFF, g, S, E);
    }
    if (MOE_XCD_BLOCKS) SEAM_L(8); else SEAM(8);
    REP9 if (IN(9)) {
        if (!IN(8)) expert_tables(p, tb);
        pg8::Gemm g{(const bf16*)(p.ws + WS_ACT), (const bf16*)(p.ws + WS_WD), D, D}; SchedMoe<4, false> S; S.G = G; S.v = vcu; S.tb = tb; S.tok = nullptr;
        EpiMoe2 E{p.b_down, (const float*)(p.ws + WS_SW), (const int*)(p.ws + WS_SDST), (bf16*)(p.ws + WS_Y), (const LAS unsigned char*)(lds + pg8::PF_OFF)};
        pg8::gemm_phase<EpiMoe2, SchedMoe<4, false>, true>(lds + RING_OFF, g, S, E);
    }
    SEAM(9);
    if (IN(10)) ph_combine(p, bx, G);
#undef IN
#undef SEAM
}

#ifndef FAST_MASK
#define FAST_MASK 0x7ff
#endif
extern "C" void kernel_launch(void* const* d_in, const int* in_sizes, int n_in, void* d_out, int out_size, void* d_ws, size_t ws_size, hipStream_t stream) {
    static int grid = 0;
    if (grid == 0) {
        if (n_in != 29 || out_size != T * D || ws_size < WS_END) { fprintf(stderr, "kernel_launch: unexpected shapes n_in %d out %d ws %zu\n", n_in, out_size, ws_size); grid = -1; return; }
        int dev = 0, cus = 0, per_cu = 0;
        if (hipGetDevice(&dev) != hipSuccess || hipDeviceGetAttribute(&cus, hipDeviceAttributeMultiprocessorCount, dev) != hipSuccess) { grid = -1; return; }
        if (hipFuncSetAttribute((const void*)mk_fwd, hipFuncAttributeMaxDynamicSharedMemorySize, LDS_BYTES) != hipSuccess) { fprintf(stderr, "kernel_launch: hipFuncSetAttribute failed\n"); grid = -1; return; }
        if (hipOccupancyMaxActiveBlocksPerMultiprocessor(&per_cu, (const void*)mk_fwd, NWAVES * 64, LDS_BYTES) != hipSuccess || per_cu < 1) fprintf(stderr, "kernel_launch: occupancy query reports %d\n", per_cu);
        (void)hipGetLastError();
        grid = cus;
        if (grid != 256) fprintf(stderr, "kernel_launch: %d CUs; the unit deals are built for 256\n", grid);
    }
    if (grid < 0) return;
    (void)hipMemsetAsync((char*)d_ws + WS_CTL, 0, CTL_BYTES, stream);
    Args a{};
    const float** f = (const float**)&a.p;
    for (int i = 0; i < 29; ++i) f[i] = (const float*)d_in[i];
    a.p.out = (float*)d_out; a.p.ws = (unsigned char*)d_ws;
    const P& p = a.p;
    const unsigned mask = (unsigned)(FAST_MASK) | 0x493u;
    int li = 0;
    for (int k = 0; k < N_PHASES;) {
        if (mask & (1u << k)) { int e = k; while (e < N_PHASES && (mask & (1u << e))) ++e;
            a.ph_lo = k; a.ph_hi = e; a.li = li++;
            hipLaunchKernelGGL(mk_fwd, dim3(grid), dim3(NWAVES * 64), LDS_BYTES, stream, a);
            k = e; continue; }
        switch (k) {
            case 2: nk_inproj<<<dim3(TK / 64, INC / 64), 256, 0, stream>>>(p); break;
            case 3: nk_attn<0><<<dim3(32, 16), 256, 0, stream>>>(p); nk_attn<1><<<dim3(32, 16), 256, 0, stream>>>(p); break;
            case 5: nk_merge<<<dim3(T / 64, D / 64), 256, 0, stream>>>(p); break;
            case 6: nk_outproj<<<dim3(T / 64, D / 64), 256, 0, stream>>>(p); break;
            case 8: nk_moe1<<<4096, 256, 0, stream>>>(p); break;
            case 9: nk_moe2<<<4096, 256, 0, stream>>>(p); break;
            default: break;
        }
        ++k;
    }
}
```

```cpp
#include <hip/hip_runtime.h>
#include <cstdio>
#include <cstdint>

constexpr int D = 1024, NB = 2, SEQ = 8192, CL = 256, T = NB * SEQ  , SK = SEQ + CL  , TK = NB * SK  ;
constexpr int INC = 4352, NE = 32, NMOD = 6 * D;
constexpr float C2 = 0.125f * 1.4426950408889634f;
constexpr int ECAP = 16384;
#ifndef MOE_FP8
#define MOE_FP8 1
#endif
#ifndef INPROJ_FP8_ALL
#define INPROJ_FP8_ALL 1
#endif
#ifndef INPROJ_GATE_FP8
#define INPROJ_GATE_FP8 1
#endif
#ifndef Y_FP8
#define Y_FP8 1
#endif
#ifndef ATT_FP8
#define ATT_FP8 1
#endif
#ifndef MOE_XCD_BLOCKS
#define MOE_XCD_BLOCKS 1
#endif
#ifndef INPROJ_XCD_BLOCKS
#define INPROJ_XCD_BLOCKS 1
#endif
#ifndef EPI_PREFETCH
#define EPI_PREFETCH 1
#endif
#ifndef MERGE_FP8
#define MERGE_FP8 1
#endif
constexpr float W8_SCALE = 256.0f, ACT8_SCALE = 4.0f, Y8_SCALE = 16.0f, YA8_SCALE = 64.0f, MG8_SCALE = 16.0f;
__device__ __forceinline__ unsigned pk4_fp8(float a, float b, float c, float d) {
    a = __builtin_amdgcn_fmed3f(a, -448.0f, 448.0f); b = __builtin_amdgcn_fmed3f(b, -448.0f, 448.0f); c = __builtin_amdgcn_fmed3f(c, -448.0f, 448.0f); d = __builtin_amdgcn_fmed3f(d, -448.0f, 448.0f);
    int r = __builtin_amdgcn_cvt_pk_fp8_f32(a, b, 0, false); r = __builtin_amdgcn_cvt_pk_fp8_f32(c, d, r, true); return (unsigned)r;
}

typedef unsigned short bf16;
typedef float f32x4 __attribute__((ext_vector_type(4)));
#define GAS __attribute__((address_space(1)))
#define LAS __attribute__((address_space(3)))

constexpr size_t MiB = 1u << 20;
constexpr size_t WS_CTL = 0, CTL_BYTES = 1 * MiB;
constexpr size_t WS_MOD = 1 * MiB;
constexpr size_t WS_LAM = 1 * MiB + 128 * 1024;
constexpr size_t WS_WP = 1 * MiB + 256 * 1024;
constexpr size_t WS_CST = 1 * MiB + 768 * 1024;
constexpr size_t WS_WIN = 2 * MiB;
constexpr size_t WS_WOA = 11 * MiB, WS_WOB = 12 * MiB, WS_WOUT = 13 * MiB;
constexpr size_t WS_WD = 16 * MiB;
constexpr size_t WS_WGU = 80 * MiB;
constexpr size_t WS_Y = 80 * MiB;
constexpr size_t WS_HX8 = 144 * MiB;
constexpr size_t WS_HX = 208 * MiB;
constexpr size_t WS_MERGED = 208 * MiB;
constexpr size_t WS_QA = 241 * MiB, WS_QB = 257 * MiB, WS_KA = 273 * MiB, WS_VA = 278 * MiB, WS_KB = 283 * MiB, WS_VB = 300 * MiB;
constexpr size_t WS_G = 317 * MiB;
constexpr size_t WS_ACT = 208 * MiB;
constexpr size_t WS_AY = 381 * MiB;
constexpr size_t WS_OB = 413 * MiB, WS_HM = 445 * MiB;
constexpr size_t WS_TMP = 241 * MiB;
constexpr size_t WS_TOK = 477 * MiB, WS_SW = 479 * MiB, WS_SDST = 481 * MiB;
#ifndef ROUTER_OVERLAP
#define ROUTER_OVERLAP 1
#endif
#ifndef G_U8
#define G_U8 1
#endif
#ifndef X1_BF16
#define X1_BF16 1
#endif
constexpr size_t WS_X1 = 168 * MiB;
constexpr size_t WS_TRASH = 484 * MiB;
constexpr size_t WS_END = 485 * MiB;
constexpr int CW_CNT = 1024;

struct P {
    const float *x, *c, *ctx, *c_ctx, *w_ada, *b_ada, *norm_attn, *w_in, *q_norm_a, *k_norm_a, *q_norm_b, *k_norm_b, *lq1, *lk1, *lq2, *lk2, *subln,
        *w_oa, *w_ob, *w_out, *norm_mlp, *router_w, *router_b, *w_gate, *b_gate, *w_up, *b_up, *w_down, *b_down;
    float* out; unsigned char* ws;
};

__device__ __forceinline__ float bf2f(bf16 h) { return __uint_as_float((unsigned)h << 16); }
__device__ __forceinline__ unsigned f2bf(float f) { unsigned u = __float_as_uint(f); return (u + 0x7fffu + ((u >> 16) & 1u)) >> 16; }
__device__ __forceinline__ unsigned pk2(float lo, float hi) { return f2bf(lo) | (f2bf(hi) << 16); }
__device__ __forceinline__ float wave_sum(float v) {
#pragma unroll
    for (int o = 1; o < 64; o <<= 1) v += __shfl_xor(v, o);
    return v;
}
__device__ __forceinline__ float sigmoidf_(float v) { return 1.0f / (1.0f + __expf(-v)); }
__device__ __forceinline__ void rope_cs(float pos, int j, float& c, float& s) {
    const float inv_rev = exp2f(-(float)j * (13.287712379549449f / 16.0f)) * 0.15915494309189535f;
    float rev = pos * inv_rev; rev = rev - floorf(rev);
    c = __builtin_amdgcn_cosf(rev); s = __builtin_amdgcn_sinf(rev);
}

__device__ __forceinline__ void ph_mod(const P& p, int vb, int nvb, float* lds) {
    const int t = threadIdx.x, c4 = t & 7, rg = t >> 3;
    float* MOD = (float*)(p.ws + WS_MOD);
    for (int it = vb; it < NMOD / 32; it += nvb) {
        const int n0 = it * 32 + c4 * 4;
        f32x4 a0 = {0, 0, 0, 0}, a1 = a0, a2 = a0;
        for (int k = rg; k < D; k += 64) {
            const f32x4 w = *(const f32x4*)(p.w_ada + (size_t)k * NMOD + n0);
            const float c0 = p.c[k], c1 = p.c[D + k], cc = p.c_ctx[k];
            a0 += w * (c0 * sigmoidf_(c0)); a1 += w * (c1 * sigmoidf_(c1)); a2 += w * (cc * sigmoidf_(cc));
        }
        __syncthreads();
#pragma unroll
        for (int j = 0; j < 4; ++j) { lds[(rg * 3 + 0) * 32 + c4 * 4 + j] = a0[j]; lds[(rg * 3 + 1) * 32 + c4 * 4 + j] = a1[j]; lds[(rg * 3 + 2) * 32 + c4 * 4 + j] = a2[j]; }
        __syncthreads();
        if (t < 96) { const int v = t >> 5, cI = t & 31; float s = 0.f; for (int r = 0; r < 64; ++r) s += lds[(r * 3 + v) * 32 + cI]; MOD[v * NMOD + it * 32 + cI] = s + p.b_ada[it * 32 + cI]; }
    }
    if (vb == 0 && t < 64) {
        float a = p.lq1[t] * p.lk1[t], b = p.lq2[t] * p.lk2[t];
        a = wave_sum(a); b = wave_sum(b);
        if (t == 0) *(float*)(p.ws + WS_LAM) = expf(a) - expf(b) + 0.2f;
    }
}

__device__ __forceinline__ void ph_norm1_row(const P& p, int r, int lane, const f32x4 (&v)[4], const f32x4 (&gq)[4], const f32x4 (&shq)[4]) {
    bf16* HX = (bf16*)(p.ws + WS_HX);
    float ss = 0.f;
#pragma unroll
    for (int j = 0; j < 4; ++j) ss += (v[j].x * v[j].x + v[j].y * v[j].y) + (v[j].z * v[j].z + v[j].w * v[j].w);
    const float rstd = 1.0f / sqrtf(wave_sum(ss) * (1.0f / D) + 1e-6f);
#pragma unroll
    for (int j = 0; j < 4; ++j) { const int n = 4 * (64 * j + lane);
        const f32x4 h = (v[j] * rstd) * gq[j] + shq[j];
        if (!INPROJ_FP8_ALL) { uint2 o; o.x = pk2(h.x, h.y); o.y = pk2(h.z, h.w); *(uint2*)(HX + (size_t)r * D + n) = o; }
        if (INPROJ_GATE_FP8) *(unsigned*)(p.ws + WS_HX8 + (size_t)r * D + n) = pk4_fp8(h.x, h.y, h.z, h.w); }
}
__device__ __forceinline__ void ph_norm1(const P& p, int vb, int nvb) {
    const int lane = threadIdx.x & 63, gw = vb * 8 + (threadIdx.x >> 6), ngw = nvb * 8;
    const float* MOD = (const float*)(p.ws + WS_MOD);
    const bool blk = INPROJ_XCD_BLOCKS && nvb == 256; const int x = vb >> 5, w = (vb & 31) * 8 + (threadIdx.x >> 6);
    const int rb = (8 * x + (x >= 4 ? 1 : 0)) * 256, cb = ((x & 3) == 3) ? (x == 3 ? 32 : 65) * 256 : -1;
    if (blk) {
        const int b = x >> 2; const float* mv = MOD + b * NMOD; f32x4 gq[4], shq[4];
#pragma unroll
        for (int j = 0; j < 4; ++j) { const int n = 4 * (64 * j + lane); gq[j] = *(const f32x4*)(p.norm_attn + n) * (*(const f32x4*)(mv + D + n) + 1.0f); shq[j] = *(const f32x4*)(mv + n); }
#pragma unroll
        for (int k0 = 0; k0 < 8; k0 += 4) { f32x4 vq[4][4];
#pragma unroll
            for (int k = 0; k < 4; ++k) { const int r = rb + w + 256 * (k0 + k), t = r % SK; const float* src = p.x + ((size_t)b * SEQ + t) * D;
#pragma unroll
                for (int j = 0; j < 4; ++j) vq[k][j] = *(const f32x4*)(src + 4 * (64 * j + lane)); }
#pragma unroll
            for (int k = 0; k < 4; ++k) ph_norm1_row(p, rb + w + 256 * (k0 + k), lane, vq[k], gq, shq); }
        if (cb >= 0) { const int r = cb + w, t = r % SK; const float* src = p.ctx + ((size_t)b * CL + (t - SEQ)) * D; const float* mc = MOD + 2 * NMOD; f32x4 v[4];
#pragma unroll
            for (int j = 0; j < 4; ++j) { const int n = 4 * (64 * j + lane); v[j] = *(const f32x4*)(src + n); gq[j] = *(const f32x4*)(p.norm_attn + n) * (*(const f32x4*)(mc + D + n) + 1.0f); shq[j] = *(const f32x4*)(mc + n); }
            ph_norm1_row(p, r, lane, v, gq, shq); }
        return;
    }
    for (int r = gw; r < TK; r += ngw) {
        const int b = r / SK, t = r % SK; const bool isctx = t >= SEQ;
        const float* src = isctx ? p.ctx + ((size_t)b * CL + (t - SEQ)) * D : p.x + ((size_t)b * SEQ + t) * D;
        const float* mv = MOD + (isctx ? 2 : b) * NMOD;
        f32x4 v[4], gq[4], shq[4];
#pragma unroll
        for (int j = 0; j < 4; ++j) { const int n = 4 * (64 * j + lane); v[j] = *(const f32x4*)(src + n); gq[j] = *(const f32x4*)(p.norm_attn + n) * (*(const f32x4*)(mv + D + n) + 1.0f); shq[j] = *(const f32x4*)(mv + n); }
        ph_norm1_row(p, r, lane, v, gq, shq);
    }
}

__device__ __forceinline__ void diffout_tile(const P& p, size_t qrow0, int hh) {
    const int lane = threadIdx.x & 63, wave = threadIdx.x >> 6;
    const bf16* OB = (const bf16*)(p.ws + WS_OB); bf16* YB = (bf16*)(p.ws + WS_AY) + 512;
    const float lam = *(const float*)(p.ws + WS_LAM);
    const int e0 = (lane & 15) * 8;
    float sg[8];
#pragma unroll
    for (int j = 0; j < 8; ++j) sg[j] = p.subln[e0 + j];
#pragma unroll 2
    for (int it = 0; it < 8; ++it) {
        const size_t r = qrow0 + wave * 32 + it * 4 + (lane >> 4); const size_t off = r * 512 + hh * 128 + e0;
        const uint4 a = *(const uint4*)(OB + off), b = *(const uint4*)(OB + (size_t)T * 512 + off);
        const unsigned aw[4] = {a.x, a.y, a.z, a.w}, bw[4] = {b.x, b.y, b.z, b.w};
        float d[8]; float ss = 0.f;
#pragma unroll
        for (int j = 0; j < 4; ++j) { d[2 * j] = __uint_as_float(aw[j] << 16) - lam * __uint_as_float(bw[j] << 16); d[2 * j + 1] = __uint_as_float(aw[j] & 0xffff0000u) - lam * __uint_as_float(bw[j] & 0xffff0000u);
            ss += d[2 * j] * d[2 * j] + d[2 * j + 1] * d[2 * j + 1]; }
        ss += __shfl_xor(ss, 1); ss += __shfl_xor(ss, 2); ss += __shfl_xor(ss, 4); ss += __shfl_xor(ss, 8);
        const float rstd = 1.0f / sqrtf(ss * (1.0f / 128.0f) + 1e-5f) * 0.8f;
        if (MERGE_FP8) { uint2 w; w.x = pk4_fp8(d[0] * rstd * sg[0], d[1] * rstd * sg[1], d[2] * rstd * sg[2], d[3] * rstd * sg[3]); w.y = pk4_fp8(d[4] * rstd * sg[4], d[5] * rstd * sg[5], d[6] * rstd * sg[6], d[7] * rstd * sg[7]);
            *(uint2*)(p.ws + WS_AY + r * 1024 + 512 + hh * 128 + e0) = w; }
        else { uint4 w; w.x = pk2(d[0] * rstd * sg[0], d[1] * rstd * sg[1]); w.y = pk2(d[2] * rstd * sg[2], d[3] * rstd * sg[3]); w.z = pk2(d[4] * rstd * sg[4], d[5] * rstd * sg[5]); w.w = pk2(d[6] * rstd * sg[6], d[7] * rstd * sg[7]);
        *(uint4*)(YB + r * 1024 + hh * 128 + e0) = w; }
    }
}

__device__ __forceinline__ void ph_router_prep(const P& p, int vb, int nvb) {
    const float* MOD = (const float*)(p.ws + WS_MOD); float* WP = (float*)(p.ws + WS_WP); float* CST = (float*)(p.ws + WS_CST);
    for (int idx = vb * 512 + threadIdx.x; idx < 2 * 8192; idx += nvb * 512) {
        const int b = idx >> 13, q = idx & 8191, j = q & 31, kb = 8 * (q >> 6) + 4 * ((q >> 5) & 1); f32x4 o;
#pragma unroll
        for (int s = 0; s < 4; ++s) { const int k = kb + s; o[s] = p.norm_mlp[k] * (1.0f + MOD[b * NMOD + 4 * D + k]) * p.router_w[k * NE + j]; }
        *(f32x4*)(WP + (size_t)b * 32768 + q * 4) = o;
    }
    if (vb == 0) { const int lane = threadIdx.x & 63, wave = threadIdx.x >> 6;
        for (int q = wave; q < 64; q += 8) { const int b = q >> 5, e = q & 31; float s = 0.f;
            for (int k = lane; k < D; k += 64) s += MOD[b * NMOD + 3 * D + k] * p.router_w[k * NE + e];
            s = wave_sum(s); if (lane == 0) CST[b * 32 + e] = s + p.router_b[e]; } }
}

__device__ __forceinline__ void ph_diffout(const P& p, int vb, int nvb) {
    const int lane = threadIdx.x & 63, gw = vb * 8 + (threadIdx.x >> 6), ngw = nvb * 8;
    const bf16* OB = (const bf16*)(p.ws + WS_OB); bf16* YB = (bf16*)(p.ws + WS_AY) + 512;
    const float lam = *(const float*)(p.ws + WS_LAM);
    for (int r = gw; r < T; r += ngw) {
        const uint4 a = *(const uint4*)(OB + (size_t)r * 512 + lane * 8), b = *(const uint4*)(OB + (size_t)T * 512 + (size_t)r * 512 + lane * 8);
        const unsigned aw[4] = {a.x, a.y, a.z, a.w}, bw[4] = {b.x, b.y, b.z, b.w};
        float d[8]; float ss = 0.f;
#pragma unroll
        for (int j = 0; j < 4; ++j) { d[2 * j] = __uint_as_float(aw[j] << 16) - lam * __uint_as_float(bw[j] << 16); d[2 * j + 1] = __uint_as_float(aw[j] & 0xffff0000u) - lam * __uint_as_float(bw[j] & 0xffff0000u);
            ss += d[2 * j] * d[2 * j] + d[2 * j + 1] * d[2 * j + 1]; }
        ss += __shfl_xor(ss, 1); ss += __shfl_xor(ss, 2); ss += __shfl_xor(ss, 4); ss += __shfl_xor(ss, 8);
        const float rstd = 1.0f / sqrtf(ss * (1.0f / 128.0f) + 1e-5f) * 0.8f;
        const int e0 = (lane & 15) * 8; float o[8];
#pragma unroll
        for (int j = 0; j < 8; ++j) o[j] = d[j] * rstd * p.subln[e0 + j];
        if (MERGE_FP8) { uint2 w; w.x = pk4_fp8(o[0], o[1], o[2], o[3]); w.y = pk4_fp8(o[4], o[5], o[6], o[7]); *(uint2*)(p.ws + WS_AY + (size_t)r * 1024 + 512 + lane * 8) = w; }
        else { uint4 w; w.x = pk2(o[0], o[1]); w.y = pk2(o[2], o[3]); w.z = pk2(o[4], o[5]); w.w = pk2(o[6], o[7]);
        *(uint4*)(YB + (size_t)r * 1024 + lane * 8) = w; }
    }
}

__device__ __forceinline__ f32x4 x1_ld4(const P& p, size_t e) {
    if (X1_BF16) { const uint2 w = *(const uint2*)((const bf16*)(p.ws + WS_X1) + e);
        return (f32x4){__uint_as_float(w.x << 16), __uint_as_float(w.x & 0xffff0000u), __uint_as_float(w.y << 16), __uint_as_float(w.y & 0xffff0000u)}; }
    return *(const f32x4*)(p.out + e);
}
__device__ __forceinline__ void ph_router2(const P& p, int vb, int nvb, unsigned char* ldsb, unsigned char* smb) {
    typedef float f32x16_ __attribute__((ext_vector_type(16)));
    const int t = threadIdx.x, lane = t & 63, wave = t >> 6;
    float* wl = (float*)ldsb;
    float* part = (float*)ldsb;
    float* lgt = (float*)ldsb + 8192;
    float* rstd_s = (float*)smb; int* sel_e = (int*)(smb + 256); float* sel_w = (float*)(smb + 1280); int* hist = (int*)(smb + 2304); int* gbase = hist + 32; int* lpos = hist + 64;
    const float* MOD = (const float*)(p.ws + WS_MOD); bf16* HM = (bf16*)(p.ws + WS_HM);
    unsigned* CNT = (unsigned*)(p.ws + WS_CTL) + CW_CNT;
    int* TOK = (int*)(p.ws + WS_TOK); float* SW = (float*)(p.ws + WS_SW); int* SDST = (int*)(p.ws + WS_SDST);
    for (int it = vb; it < T / 64; it += nvb) {
        const int b = it / (SEQ / 64);
#if ROUTER_OVERLAP && X1_BF16
        __syncthreads();
        const int r32 = lane & 31, hh = lane >> 5, rt = wave & 1, kq = wave >> 1;
        uint2 avp[32], vqp[8][4];
#pragma unroll
        for (int rr = 0; rr < 8; ++rr) { const bf16* src = (const bf16*)(p.ws + WS_X1) + (size_t)(it * 64 + wave * 8 + rr) * D;
#pragma unroll
            for (int j = 0; j < 4; ++j) vqp[rr][j] = *(const uint2*)(src + 4 * (64 * j + lane)); }
        { const unsigned char* srcb = (const unsigned char*)((const float*)(p.ws + WS_WP) + (size_t)b * 32768);
#pragma unroll
          for (int i = 0; i < 16; ++i) __builtin_amdgcn_global_load_lds((const unsigned*)(srcb + (size_t)(t + 512 * i) * 16), (LAS unsigned*)(ldsb + (size_t)(wave * 64 + 512 * i) * 16), 16, 0, 0); }
        if (t < 32) hist[t] = 0;
        f32x4 gq[4], shq[4];
        { const float* mv = MOD + b * NMOD;
#pragma unroll
          for (int j = 0; j < 4; ++j) { const int n = 4 * (64 * j + lane); gq[j] = *(const f32x4*)(p.norm_mlp + n) * (*(const f32x4*)(mv + 4 * D + n) + 1.0f); shq[j] = *(const f32x4*)(mv + 3 * D + n); } }
        asm volatile("s_waitcnt vmcnt(0)" ::: "memory");
        __syncthreads();
        { const bf16* ar = (const bf16*)(p.ws + WS_X1) + (size_t)(it * 64 + rt * 32 + r32) * D + kq * 256 + 4 * hh;
#pragma unroll
          for (int c = 0; c < 32; ++c) avp[c] = *(const uint2*)(ar + 8 * c); }
        { const float* bl = wl + ((size_t)(kq * 32) * 64 + hh * 32 + r32) * 4;
          f32x16_ acc = {0.f, 0.f, 0.f, 0.f, 0.f, 0.f, 0.f, 0.f, 0.f, 0.f, 0.f, 0.f, 0.f, 0.f, 0.f, 0.f};
#define X1UNP(W) ((f32x4){__uint_as_float((W).x << 16), __uint_as_float((W).x & 0xffff0000u), __uint_as_float((W).y << 16), __uint_as_float((W).y & 0xffff0000u)})
#pragma unroll
          for (int c8 = 0; c8 < 32; c8 += 8) {
#pragma unroll
              for (int i = 0; i < 8; ++i) { const f32x4 bv = *(const f32x4*)(bl + (size_t)(c8 + i) * 256); const f32x4 av = X1UNP(avp[c8 + i]);
#pragma unroll
                  for (int s = 0; s < 4; ++s) acc = __builtin_amdgcn_mfma_f32_32x32x2f32(av[s], bv[s], acc, 0, 0, 0); }
#pragma unroll
              for (int rr = c8 / 4; rr < c8 / 4 + 2; ++rr) {
                  const int rl = wave * 8 + rr, r = it * 64 + rl;
                  f32x4 v[4]; float ss = 0.f;
#pragma unroll
                  for (int j = 0; j < 4; ++j) { v[j] = X1UNP(vqp[rr][j]); ss += (v[j].x * v[j].x + v[j].y * v[j].y) + (v[j].z * v[j].z + v[j].w * v[j].w); }
                  const float rstd = 1.0f / sqrtf(wave_sum(ss) * (1.0f / D) + 1e-6f);
#pragma unroll
                  for (int j = 0; j < 4; ++j) { const int n = 4 * (64 * j + lane);
                      const f32x4 h = (v[j] * rstd) * gq[j] + shq[j];
                      if (MOE_FP8) *(unsigned*)((unsigned char*)HM + (size_t)r * D + n) = pk4_fp8(h.x, h.y, h.z, h.w);
                      else { uint2 o; o.x = pk2(h.x, h.y); o.y = pk2(h.z, h.w); *(uint2*)(HM + (size_t)r * D + n) = o; } }
                  if (lane == 0) rstd_s[rl] = rstd;
              }
          }
#undef X1UNP
#else
        __syncthreads();
        { const f32x4* src = (const f32x4*)((const float*)(p.ws + WS_WP) + (size_t)b * 32768);
#pragma unroll
          for (int i = 0; i < 16; ++i) ((f32x4*)wl)[t + 512 * i] = src[t + 512 * i]; }
        if (t < 32) hist[t] = 0;
        f32x4 gq[4], shq[4];
        { const float* mv = MOD + b * NMOD;
#pragma unroll
          for (int j = 0; j < 4; ++j) { const int n = 4 * (64 * j + lane); gq[j] = *(const f32x4*)(p.norm_mlp + n) * (*(const f32x4*)(mv + 4 * D + n) + 1.0f); shq[j] = *(const f32x4*)(mv + 3 * D + n); } }
        f32x4 vq[8][4];
#pragma unroll
        for (int rr = 0; rr < 8; ++rr) { const size_t src = (size_t)(it * 64 + wave * 8 + rr) * D;
#pragma unroll
            for (int j = 0; j < 4; ++j) vq[rr][j] = x1_ld4(p, src + 4 * (64 * j + lane)); }
#pragma unroll
        for (int rr = 0; rr < 8; ++rr) {
            const int rl = wave * 8 + rr, r = it * 64 + rl;
            f32x4 v[4]; float ss = 0.f;
#pragma unroll
            for (int j = 0; j < 4; ++j) { v[j] = vq[rr][j]; ss += (v[j].x * v[j].x + v[j].y * v[j].y) + (v[j].z * v[j].z + v[j].w * v[j].w); }
            const float rstd = 1.0f / sqrtf(wave_sum(ss) * (1.0f / D) + 1e-6f);
#pragma unroll
            for (int j = 0; j < 4; ++j) { const int n = 4 * (64 * j + lane);
                const f32x4 h = (v[j] * rstd) * gq[j] + shq[j];
                if (MOE_FP8) *(unsigned*)((unsigned char*)HM + (size_t)r * D + n) = pk4_fp8(h.x, h.y, h.z, h.w);
                else { uint2 o; o.x = pk2(h.x, h.y); o.y = pk2(h.z, h.w); *(uint2*)(HM + (size_t)r * D + n) = o; } }
            if (lane == 0) rstd_s[rl] = rstd;
        }
        __syncthreads();
        { const int r32 = lane & 31, hh = lane >> 5, rt = wave & 1, kq = wave >> 1;
          const size_t arow = (size_t)(it * 64 + rt * 32 + r32) * D + kq * 256 + 4 * hh;
          const float* bl = wl + ((size_t)(kq * 32) * 64 + hh * 32 + r32) * 4;
          f32x16_ acc = {0.f, 0.f, 0.f, 0.f, 0.f, 0.f, 0.f, 0.f, 0.f, 0.f, 0.f, 0.f, 0.f, 0.f, 0.f, 0.f};
#pragma unroll 1
          for (int c8 = 0; c8 < 32; c8 += 8) {
              f32x4 av[8];
#pragma unroll
              for (int i = 0; i < 8; ++i) av[i] = x1_ld4(p, arow + (c8 + i) * 8);
#pragma unroll
              for (int i = 0; i < 8; ++i) { const f32x4 bv = *(const f32x4*)(bl + (size_t)(c8 + i) * 256);
#pragma unroll
                  for (int s = 0; s < 4; ++s) acc = __builtin_amdgcn_mfma_f32_32x32x2f32(av[i][s], bv[s], acc, 0, 0, 0); }
          }
#endif
          __syncthreads();
#pragma unroll
          for (int r = 0; r < 16; ++r) part[wave * 1024 + ((r & 3) + 8 * (r >> 2) + 4 * hh) * 32 + r32] = acc[r];
        }
        __syncthreads();
        for (int i = t; i < 2048; i += 512) { const int row = i >> 5, e = i & 31, rt = row >> 5, rw = row & 31;
            lgt[row * 33 + e] = (part[(0 + rt) * 1024 + rw * 32 + e] + part[(2 + rt) * 1024 + rw * 32 + e]) + (part[(4 + rt) * 1024 + rw * 32 + e] + part[(6 + rt) * 1024 + rw * 32 + e]); }
        __syncthreads();
        if (t < 64) {
            const float rs = rstd_s[t]; const float* cst = (const float*)(p.ws + WS_CST) + b * 32;
            float lg[32];
#pragma unroll
            for (int e = 0; e < 32; ++e) lg[e] = lgt[t * 33 + e] * rs + cst[e];
            unsigned used = 0u; float tv[4]; int ti[4];
#pragma unroll
            for (int q = 0; q < 4; ++q) { float best = -INFINITY; int bi = 0;
#pragma unroll
                for (int e = 0; e < 32; ++e) { const float c = ((used >> e) & 1u) ? -INFINITY : lg[e]; if (c > best) { best = c; bi = e; } }
                tv[q] = best; ti[q] = bi; used |= 1u << bi; }
            const float e1 = __expf(tv[1] - tv[0]), e2 = __expf(tv[2] - tv[0]), e3 = __expf(tv[3] - tv[0]); const float inv = 1.0f / (1.0f + e1 + e2 + e3);
            sel_e[t * 4 + 0] = ti[0]; sel_e[t * 4 + 1] = ti[1]; sel_e[t * 4 + 2] = ti[2]; sel_e[t * 4 + 3] = ti[3];
            sel_w[t * 4 + 0] = inv; sel_w[t * 4 + 1] = e1 * inv; sel_w[t * 4 + 2] = e2 * inv; sel_w[t * 4 + 3] = e3 * inv;
        }
        __syncthreads();
        if (t < 256) lpos[t] = atomicAdd(&hist[sel_e[t]], 1);
        __syncthreads();
        if (t < 32) gbase[t] = (int)__hip_atomic_fetch_add(CNT + 64 * t, (unsigned)hist[t], __ATOMIC_RELAXED, __HIP_MEMORY_SCOPE_AGENT);
        __syncthreads();
        if (t < 256) { const int e = sel_e[t], pos = gbase[e] + lpos[t], tok = it * 64 + (t >> 2);
            TOK[e * ECAP + pos] = tok; SW[e * ECAP + pos] = sel_w[t]; SDST[e * ECAP + pos] = tok * 4 + (t & 3); }
    }
}

__device__ __forceinline__ void ph_combine(const P& p, int vb, int nvb) {
    const float* MOD = (const float*)(p.ws + WS_MOD); const bf16* Y = (const bf16*)(p.ws + WS_Y);
    const size_t n8 = (size_t)T * D / 8;
    for (size_t i = (size_t)vb * 512 + threadIdx.x; i < n8; i += (size_t)nvb * 512) {
        const size_t tok = i / (D / 8); const int n = (int)(i % (D / 8)) * 8; const int b = (int)(tok / SEQ);
        float s[8] = {0, 0, 0, 0, 0, 0, 0, 0};
#pragma unroll
        for (int k = 0; k < 4; ++k) {
            if (Y_FP8) { typedef float f32x2_ __attribute__((ext_vector_type(2)));
                const uint2 y = *(const uint2*)((const unsigned char*)Y + (tok * 4 + k) * D + n);
                const f32x2_ a0 = __builtin_amdgcn_cvt_pk_f32_fp8((int)y.x, false), a1 = __builtin_amdgcn_cvt_pk_f32_fp8((int)y.x, true), a2 = __builtin_amdgcn_cvt_pk_f32_fp8((int)y.y, false), a3 = __builtin_amdgcn_cvt_pk_f32_fp8((int)y.y, true);
                s[0] += a0.x; s[1] += a0.y; s[2] += a1.x; s[3] += a1.y; s[4] += a2.x; s[5] += a2.y; s[6] += a3.x; s[7] += a3.y;
            } else { const uint4 y = *(const uint4*)(Y + (tok * 4 + k) * D + n); const unsigned w[4] = {y.x, y.y, y.z, y.w};
#pragma unroll
            for (int j = 0; j < 4; ++j) { s[2 * j] += __uint_as_float(w[j] << 16); s[2 * j + 1] += __uint_as_float(w[j] & 0xffff0000u); } } }
        if (Y_FP8) {
#pragma unroll
            for (int j = 0; j < 8; ++j) s[j] *= 1.0f / Y8_SCALE; }
        float* o = p.out + tok * D + n; const float* gm = MOD + b * NMOD + 5 * D + n;
        f32x4 o0, o1;
        if (X1_BF16) { const uint4 w = *(const uint4*)((const bf16*)(p.ws + WS_X1) + tok * D + n);
            o0 = (f32x4){__uint_as_float(w.x << 16), __uint_as_float(w.x & 0xffff0000u), __uint_as_float(w.y << 16), __uint_as_float(w.y & 0xffff0000u)};
            o1 = (f32x4){__uint_as_float(w.z << 16), __uint_as_float(w.z & 0xffff0000u), __uint_as_float(w.w << 16), __uint_as_float(w.w & 0xffff0000u)}; }
        else { o0 = *(f32x4*)o; o1 = *(f32x4*)(o + 4); }
        const f32x4 g0 = *(const f32x4*)gm, g1 = *(const f32x4*)(gm + 4);
        o0 += g0 * (f32x4){s[0], s[1], s[2], s[3]}; o1 += g1 * (f32x4){s[4], s[5], s[6], s[7]};
        *(f32x4*)o = o0; *(f32x4*)(o + 4) = o1;
    }
}

template <class FA, class FB>
__device__ __forceinline__ void ngemm_acc(float (&acc)[4][4], float* sA, float* sB, int K, FA fa, FB fb) {
    const int t = threadIdx.x, tx = t & 15, ty = t >> 4;
    for (int k0 = 0; k0 < K; k0 += 16) {
#pragma unroll
        for (int i = 0; i < 4; ++i) { const int idx = t + 256 * i; sA[(idx & 15) * 68 + (idx >> 4)] = fa(idx >> 4, k0 + (idx & 15)); }
#pragma unroll
        for (int i = 0; i < 4; ++i) { const int idx = t + 256 * i; sB[(idx >> 6) * 68 + (idx & 63)] = fb(k0 + (idx >> 6), idx & 63); }
        __syncthreads();
#pragma unroll
        for (int kk = 0; kk < 16; ++kk) { const f32x4 a = *(const f32x4*)(sA + kk * 68 + ty * 4), b = *(const f32x4*)(sB + kk * 68 + tx * 4);
#pragma unroll
            for (int i = 0; i < 4; ++i)
#pragma unroll
                for (int j = 0; j < 4; ++j) acc[i][j] += a[i] * b[j]; }
        __syncthreads();
    }
}
#define ZERO_ACC(acc) _Pragma("unroll") for (int i_ = 0; i_ < 4; ++i_) _Pragma("unroll") for (int j_ = 0; j_ < 4; ++j_) acc[i_][j_] = 0.f

__global__ void __launch_bounds__(256) nk_inproj(P p) {
    __shared__ __attribute__((aligned(16))) float sA[16 * 68]; __shared__ __attribute__((aligned(16))) float sB[16 * 68]; __shared__ float Cs[64 * 65];
    const int rt = blockIdx.x, cb = blockIdx.y, t = threadIdx.x, tx = t & 15, ty = t >> 4;
    const int row0 = rt * 64, bb = row0 / SK, t0 = row0 % SK; const bool isctx = t0 >= SEQ;
    int type, hc;
    if (cb < 8) { type = 0; hc = cb; } else if (cb < 10) { type = 1; hc = cb - 8; } else if (cb < 12) { type = 2; hc = cb - 10; } else if (cb < 20) { type = 3; hc = cb - 12; }
    else if (cb < 28) { type = 4; hc = cb - 20; } else if (cb < 36) { type = 5; hc = cb - 28; } else if (cb < 52) { type = 6; hc = cb - 36; } else { type = 7; hc = cb - 52; }
    if (isctx && !(type == 1 || type == 2 || type == 4 || type == 5)) return;
    const bf16* HX = (const bf16*)(p.ws + WS_HX);
    float acc[4][4]; ZERO_ACC(acc);
    ngemm_acc(acc, sA, sB, D, [&](int r, int k) { return bf2f(HX[(size_t)(row0 + r) * D + k]); }, [&](int k, int c) { return p.w_in[(size_t)k * INC + cb * 64 + c]; });
#pragma unroll
    for (int i = 0; i < 4; ++i)
#pragma unroll
        for (int j = 0; j < 4; ++j) Cs[(ty * 4 + i) * 65 + tx * 4 + j] = acc[i][j];
    __syncthreads();
    if (t < 64) {
        const int r = t, tt = t0 + r, hr = row0 + r, qrow = bb * SEQ + tt;
        float v[64];
#pragma unroll
        for (int d = 0; d < 64; ++d) v[d] = Cs[r * 65 + d];
        if (type == 0 || type == 1 || type == 3 || type == 4) {
            float ss = 0.f;
#pragma unroll
            for (int d = 0; d < 64; ++d) ss += v[d] * v[d];
            const float rstd = 1.0f / sqrtf(ss * (1.0f / 64.0f) + 1e-6f);
            const float* gn = type == 0 ? p.q_norm_a : type == 1 ? p.k_norm_a : type == 3 ? p.q_norm_b : p.k_norm_b;
#pragma unroll
            for (int d = 0; d < 64; ++d) v[d] = v[d] * rstd * gn[d];
            if (!isctx) {
#pragma unroll
                for (int i = 0; i < 32; ++i) { const float pos = (float)(i < 16 ? (tt >> 6) : (tt & 63)); float c, s; rope_cs(pos, i & 15, c, s);
                    const float x0 = v[2 * i], x1 = v[2 * i + 1]; v[2 * i] = x0 * c - x1 * s; v[2 * i + 1] = x0 * s + x1 * c; }
            }
            if (type == 0 || type == 3) {
#pragma unroll
                for (int d = 0; d < 64; ++d) v[d] *= C2;
            }
        } else if (type >= 6) {
#pragma unroll
            for (int d = 0; d < 64; ++d) v[d] = sigmoidf_(v[d]);
        }
        bf16* dst;
        switch (type) {
            case 0: dst = (bf16*)(p.ws + WS_QA) + (size_t)qrow * 512 + hc * 64; break;
            case 1: dst = (bf16*)(p.ws + WS_KA) + (size_t)hr * 128 + hc * 64; break;
            case 2: dst = (bf16*)(p.ws + WS_VA) + (size_t)hr * 128 + hc * 64; break;
            case 3: dst = (bf16*)(p.ws + WS_QB) + (size_t)qrow * 512 + hc * 64; break;
            case 4: dst = (bf16*)(p.ws + WS_KB) + (size_t)hr * 512 + hc * 64; break;
            case 5: dst = (bf16*)(p.ws + WS_VB) + (size_t)hr * 512 + hc * 64; break;
            case 6: dst = (bf16*)(p.ws + WS_G) + (size_t)qrow * 2048 + hc * 64; break;
            default: dst = (bf16*)(p.ws + WS_G) + (size_t)qrow * 2048 + 1024 + hc * 64; break;
        }
#pragma unroll
        for (int d = 0; d < 64; d += 8) { uint4 w; w.x = pk2(v[d], v[d + 1]); w.y = pk2(v[d + 2], v[d + 3]); w.z = pk2(v[d + 4], v[d + 5]); w.w = pk2(v[d + 6], v[d + 7]); *(uint4*)(dst + d) = w; }
    }
}

template <int MODE>
__global__ void __launch_bounds__(256) nk_attn(P p) {
    constexpr int VD = MODE == 0 ? 64 : 128;
    __shared__ __attribute__((aligned(16))) float Ks[64 * 64]; __shared__ __attribute__((aligned(16))) float Vs[64 * VD];
    const int qb = blockIdx.x, y = blockIdx.y, t = threadIdx.x, b = y >> 3;
    const bf16 *Q, *K, *V; bf16* O; int kp, op;
    if (MODE == 0) { const int h = y & 7; Q = (const bf16*)(p.ws + WS_QA) + h * 64; K = (const bf16*)(p.ws + WS_KA) + (h >> 2) * 64; V = (const bf16*)(p.ws + WS_VA) + (h >> 2) * 64; O = (bf16*)(p.ws + WS_AY) + h * 64; kp = 128; op = 1024; }
    else { const int h = (y & 7) >> 1, m = y & 1; Q = (const bf16*)(p.ws + WS_QB) + h * 128 + m * 64; K = (const bf16*)(p.ws + WS_KB) + h * 128 + m * 64; V = (const bf16*)(p.ws + WS_VB) + h * 128;
        O = (bf16*)(p.ws + WS_OB) + (size_t)m * T * 512 + h * 128; kp = 512; op = 512; }
    const size_t qrow = (size_t)b * SEQ + qb * 256 + t;
    float q[64], o[VD]; float mx = -INFINITY, l = 0.f;
#pragma unroll
    for (int d = 0; d < 64; ++d) q[d] = bf2f(Q[qrow * 512 + d]);
#pragma unroll
    for (int e = 0; e < VD; ++e) o[e] = 0.f;
    for (int kt = 0; kt < SK / 64; ++kt) {
        const size_t kr0 = (size_t)b * SK + kt * 64;
        __syncthreads();
        { const int key = t >> 2, d0 = (t & 3) * 16;
#pragma unroll
          for (int d = 0; d < 16; ++d) Ks[key * 64 + d0 + d] = bf2f(K[(kr0 + key) * kp + d0 + d]);
          constexpr int VC = VD / 4; const int e0 = (t & 3) * VC;
#pragma unroll
          for (int e = 0; e < VC; ++e) Vs[key * VD + e0 + e] = bf2f(V[(kr0 + key) * kp + e0 + e]); }
        __syncthreads();
        for (int kk = 0; kk < 64; ++kk) {
            float s = 0.f;
#pragma unroll
            for (int d = 0; d < 64; d += 4) { const f32x4 k4 = *(const f32x4*)(Ks + kk * 64 + d); s += q[d] * k4.x + q[d + 1] * k4.y + q[d + 2] * k4.z + q[d + 3] * k4.w; }
            if (s > mx) { const float f = exp2f(mx - s); l *= f;
#pragma unroll
                for (int e = 0; e < VD; ++e) o[e] *= f;
                mx = s; }
            const float pr = exp2f(s - mx); l += pr;
#pragma unroll
            for (int e = 0; e < VD; e += 4) { const f32x4 v4 = *(const f32x4*)(Vs + kk * VD + e); o[e] += pr * v4.x; o[e + 1] += pr * v4.y; o[e + 2] += pr * v4.z; o[e + 3] += pr * v4.w; }
        }
    }
    const float il = 1.0f / l;
#pragma unroll
    for (int e = 0; e < VD; e += 8) { uint4 w; w.x = pk2(o[e] * il, o[e + 1] * il); w.y = pk2(o[e + 2] * il, o[e + 3] * il); w.z = pk2(o[e + 4] * il, o[e + 5] * il); w.w = pk2(o[e + 6] * il, o[e + 7] * il);
        *(uint4*)(O + qrow * op + e) = w; }
}

__global__ void __launch_bounds__(256) nk_merge(P p) {
    __shared__ __attribute__((aligned(16))) float sA[16 * 68]; __shared__ __attribute__((aligned(16))) float sB[16 * 68];
    const int row0 = blockIdx.x * 64, col0 = blockIdx.y * 64, t = threadIdx.x, tx = t & 15, ty = t >> 4;
    const bf16 *AY = (const bf16*)(p.ws + WS_AY), *G = (const bf16*)(p.ws + WS_G); bf16* MG = (bf16*)(p.ws + WS_MERGED);
    float a1[4][4], a2[4][4]; ZERO_ACC(a1); ZERO_ACC(a2);
    ngemm_acc(a1, sA, sB, 512, [&](int r, int k) { return bf2f(AY[(size_t)(row0 + r) * 1024 + k]); }, [&](int k, int c) { return p.w_oa[(size_t)k * D + col0 + c]; });
    ngemm_acc(a2, sA, sB, 512, [&](int r, int k) { return bf2f(AY[(size_t)(row0 + r) * 1024 + 512 + k]); }, [&](int k, int c) { return p.w_ob[(size_t)k * D + col0 + c]; });
#pragma unroll
    for (int i = 0; i < 4; ++i)
#pragma unroll
        for (int j = 0; j < 4; ++j) { const size_t r = row0 + ty * 4 + i; const int c = col0 + tx * 4 + j;
            MG[r * D + c] = (bf16)f2bf(bf2f(G[r * 2048 + c]) * a1[i][j] + bf2f(G[r * 2048 + 1024 + c]) * a2[i][j]); }
}

__global__ void __launch_bounds__(256) nk_outproj(P p) {
    __shared__ __attribute__((aligned(16))) float sA[16 * 68]; __shared__ __attribute__((aligned(16))) float sB[16 * 68];
    const int row0 = blockIdx.x * 64, col0 = blockIdx.y * 64, t = threadIdx.x, tx = t & 15, ty = t >> 4;
    const bf16* MG = (const bf16*)(p.ws + WS_MERGED); const float* MOD = (const float*)(p.ws + WS_MOD);
    float a1[4][4]; ZERO_ACC(a1);
    ngemm_acc(a1, sA, sB, D, [&](int r, int k) { return bf2f(MG[(size_t)(row0 + r) * D + k]); }, [&](int k, int c) { return p.w_out[(size_t)k * D + col0 + c]; });
#pragma unroll
    for (int i = 0; i < 4; ++i)
#pragma unroll
        for (int j = 0; j < 4; ++j) { const size_t r = row0 + ty * 4 + i; const int c = col0 + tx * 4 + j; const int b = (int)(r / SEQ);
            p.out[r * D + c] = p.x[r * D + c] + MOD[b * NMOD + 2 * D + c] * a1[i][j]; }
}

__device__ __forceinline__ void expert_prefix(const P& p, int* s_cnt, int* s_base, int* s_tile0) {
    const unsigned* CNT = (const unsigned*)(p.ws + WS_CTL) + CW_CNT;
    if (threadIdx.x == 0) { int base = 0, tl = 0; for (int e = 0; e < NE; ++e) { const int c = (int)CNT[64 * e]; s_cnt[e] = c; s_base[e] = base; s_tile0[e] = tl; base += (c + 255) / 256 * 256; tl += (c + 63) / 64; } s_tile0[NE] = tl; }
    __syncthreads();
}

__global__ void __launch_bounds__(256) nk_moe1(P p) {
    __shared__ __attribute__((aligned(16))) float sA[16 * 68]; __shared__ __attribute__((aligned(16))) float sB[16 * 68];
    __shared__ int s_cnt[NE], s_base[NE], s_tile0[NE + 1], s_tok[64];
    const int t = threadIdx.x, tx = t & 15, ty = t >> 4;
    expert_prefix(p, s_cnt, s_base, s_tile0);
    const bf16* HM = (const bf16*)(p.ws + WS_HM); const int* TOK = (const int*)(p.ws + WS_TOK); bf16* ACT = (bf16*)(p.ws + WS_ACT);
    const int ntiles = s_tile0[NE] * 16;
    for (int i = blockIdx.x; i < ntiles; i += gridDim.x) {
        const int rtile = i >> 4, ct = i & 15; int e = 0; while (s_tile0[e + 1] <= rtile) ++e;
        const int pos0 = (rtile - s_tile0[e]) * 64, cnt = s_cnt[e], col0 = ct * 64;
        __syncthreads();
        if (t < 64) s_tok[t] = (pos0 + t < cnt) ? TOK[e * ECAP + pos0 + t] : -1;
        __syncthreads();
        float ag[4][4], au[4][4]; ZERO_ACC(ag); ZERO_ACC(au);
        auto fa = [&](int r, int k) { const int tk = s_tok[r]; return tk >= 0 ? bf2f(HM[(size_t)tk * D + k]) : 0.f; };
        ngemm_acc(ag, sA, sB, D, fa, [&](int k, int c) { return p.w_gate[((size_t)e * D + k) * D + col0 + c]; });
        ngemm_acc(au, sA, sB, D, fa, [&](int k, int c) { return p.w_up[((size_t)e * D + k) * D + col0 + c]; });
#pragma unroll
        for (int ii = 0; ii < 4; ++ii)
#pragma unroll
            for (int j = 0; j < 4; ++j) { const int pos = pos0 + ty * 4 + ii, c = col0 + tx * 4 + j;
                if (pos < cnt) { const float g = fminf(ag[ii][j] + p.b_gate[e * D + c], 7.0f); const float u = fminf(fmaxf(au[ii][j] + p.b_up[e * D + c], -7.0f), 7.0f);
                    ACT[(size_t)(s_base[e] + pos) * D + c] = (bf16)f2bf((u + 1.0f) * (g * sigmoidf_(1.702f * g))); } }
    }
}

__global__ void __launch_bounds__(256) nk_moe2(P p) {
    __shared__ __attribute__((aligned(16))) float sA[16 * 68]; __shared__ __attribute__((aligned(16))) float sB[16 * 68];
    __shared__ int s_cnt[NE], s_base[NE], s_tile0[NE + 1];
    const int t = threadIdx.x, tx = t & 15, ty = t >> 4;
    expert_prefix(p, s_cnt, s_base, s_tile0);
    const bf16* ACT = (const bf16*)(p.ws + WS_ACT); const float* SW = (const float*)(p.ws + WS_SW); const int* SDST = (const int*)(p.ws + WS_SDST); bf16* Y = (bf16*)(p.ws + WS_Y);
    const int ntiles = s_tile0[NE] * 16;
    for (int i = blockIdx.x; i < ntiles; i += gridDim.x) {
        const int rtile = i >> 4, ct = i & 15; int e = 0; while (s_tile0[e + 1] <= rtile) ++e;
        const int pos0 = (rtile - s_tile0[e]) * 64, cnt = s_cnt[e], col0 = ct * 64, base = s_base[e];
        float a1[4][4]; ZERO_ACC(a1);
        ngemm_acc(a1, sA, sB, D, [&](int r, int k) { return (pos0 + r < cnt) ? bf2f(ACT[(size_t)(base + pos0 + r) * D + k]) : 0.f; }, [&](int k, int c) { return p.w_down[((size_t)e * D + k) * D + col0 + c]; });
#pragma unroll
        for (int ii = 0; ii < 4; ++ii)
#pragma unroll
            for (int j = 0; j < 4; ++j) { const int pos = pos0 + ty * 4 + ii, c = col0 + tx * 4 + j;
                if (pos < cnt) { const float w = SW[e * ECAP + pos]; const size_t dst = (size_t)SDST[e * ECAP + pos];
                    Y[dst * D + c] = (bf16)f2bf(w * (a1[ii][j] + p.b_down[e * D + c])); } }
    }
}

namespace pg8 {
#define PG8_LAS __attribute__((address_space(3)))
typedef unsigned short bf16_t;
typedef short bf16x8 __attribute__((ext_vector_type(8)));
typedef float f32x4 __attribute__((ext_vector_type(4)));
typedef unsigned u32x4 __attribute__((ext_vector_type(4)));
typedef int i32x4 __attribute__((ext_vector_type(4)));
typedef int i32x8 __attribute__((ext_vector_type(8)));
__device__ __forceinline__ i32x8 cat8(bf16x8 lo, bf16x8 hi) { const i32x4 a = (i32x4)lo, b = (i32x4)hi; return __builtin_shufflevector(a, b, 0, 1, 2, 3, 4, 5, 6, 7); }
constexpr int BM = 256, BK = 64, HALF = 128, HTB = HALF * BK * 2  , STAGE_BYTES = 8 * HTB;
constexpr int PF_OFF = 135168 + 6144;

__host__ __device__ __forceinline__ int lds_byte(int r, int c) { const int st = (r >> 4) * 2 + (c >> 5), rr = r & 15, cc = c & 31, ob = rr * 64 + cc * 2; return st * 1024 + (ob ^ (((ob >> 9) & 1) << 5)); }
__host__ __device__ __forceinline__ void stage_rc(int b, int& R, int& C) { const int st = b / 1024, sb = b % 1024, swz = sb ^ (((sb >> 9) & 1) << 5); R = (st >> 1) * 16 + swz / 64; C = (st & 1) * 32 + (swz % 64) / 2; }
__host__ __device__ __forceinline__ int perm32(int rho) { const int n = rho >> 4, i = rho & 15; return 8 * (i >> 2) + 4 * n + (i & 3); }

struct Unit { int pm, pn, pb, acol, e, pos0, cnt, base; };
struct Gemm { const bf16_t* A; const bf16_t* Bt; int lda, K; };

__device__ __forceinline__ unsigned cvt_pk_bf16(float lo, float hi) { unsigned r; asm volatile("v_cvt_pk_bf16_f32 %0, %1, %2" : "=v"(r) : "v"(lo), "v"(hi)); return r; }

template <class Epi, class Sched, bool ALIGN_EPI>
__device__ __forceinline__ void gemm_phase(PG8_LAS unsigned char* lds, const Gemm g, const Sched& S, const Epi& E) {
    const int tid = threadIdx.x, wid = __builtin_amdgcn_readfirstlane(tid >> 6), lane = tid & 63, wr = wid >> 2, wc = wid & 3, fr = lane & 15, fq = lane >> 4;
    constexpr bool F8 = Epi::F8;
    constexpr int EB = F8 ? 1 : 2;
    const int K = g.K, nt = K / (F8 ? 2 * BK : BK);
    int RA[2], CA[2]; unsigned voffB[2];
#pragma unroll
    for (int i = 0; i < 2; ++i) { int R, C; stage_rc(tid * 16 + i * 8192, R, C); const int Rb = Epi::PERM ? ((R & ~31) + perm32(R & 31)) : R;
        const int c16 = C >> 3, cb = F8 ? 16 * (2 * (c16 & 3) + (c16 >> 2)) : 2 * C;
        RA[i] = R; CA[i] = cb; voffB[i] = (unsigned)(Rb * K * EB + cb); }
    const size_t kstep = (size_t)(BK * 2);
    const size_t hstep = (size_t)HALF * K * EB;
    const size_t tstep = 2 * hstep;
    const unsigned ldsw = (unsigned)wid * 1024u;
    const int aoff = lds_byte(wr * 64 + fr, fq * 8), boff = lds_byte(wc * 32 + fr, fq * 8);
    const char* const gA = (const char*)g.A;
#define PG8_SA(b, h) (((b) * 2 + (h)) * HTB)
#define PG8_SB(b, h) ((4 + (b) * 2 + (h)) * HTB)
#define PG8_STAGE(bufoff, gbase, voff) do { _Pragma("unroll") for (int _i = 0; _i < 2; ++_i) \
        __builtin_amdgcn_global_load_lds((const unsigned*)((const char*)(gbase) + (voff)[_i]), (PG8_LAS unsigned*)(lds + (bufoff) + ldsw + _i * 8192), 16, 0, 0); } while (0)
#define PG8_STAGE_A(bufoff, kbyte, v, h) do { _Pragma("unroll") for (int _i = 0; _i < 2; ++_i) \
        __builtin_amdgcn_global_load_lds((const unsigned*)(gA + (kbyte) + (v)[(h) * 2 + _i]), (PG8_LAS unsigned*)(lds + (bufoff) + ldsw + _i * 8192), 16, 0, 0); } while (0)
#define PG8_AOFF(dst, u) do { _Pragma("unroll") for (int _h = 0; _h < 2; ++_h) _Pragma("unroll") for (int _i = 0; _i < 2; ++_i) \
        dst[_h * 2 + _i] = (unsigned)(((size_t)S.arow(u, _h * HALF + RA[_i]) * (size_t)g.lda + (size_t)(u).acol) * (size_t)EB + (size_t)CA[_i]); } while (0)
#define PG8_LDA(dst, b, h) do { _Pragma("unroll") for (int m = 0; m < 4; ++m) { if constexpr (F8) { dst##8[m].lo = *(const PG8_LAS i32x4*)(lds + PG8_SA(b, h) + aoff + m * 2048); dst##8[m].hi = *(const PG8_LAS i32x4*)(lds + PG8_SA(b, h) + aoff + m * 2048 + 1024); } \
        else { _Pragma("unroll") for (int k = 0; k < 2; ++k) dst[m][k] = *(const PG8_LAS bf16x8*)(lds + PG8_SA(b, h) + aoff + m * 2048 + k * 1024); } } } while (0)
#define PG8_LDB(dst, b, h) do { _Pragma("unroll") for (int n = 0; n < 2; ++n) { if constexpr (F8) { dst##8[n].lo = *(const PG8_LAS i32x4*)(lds + PG8_SB(b, h) + boff + n * 2048); dst##8[n].hi = *(const PG8_LAS i32x4*)(lds + PG8_SB(b, h) + boff + n * 2048 + 1024); } \
        else { _Pragma("unroll") for (int k = 0; k < 2; ++k) dst[n][k] = *(const PG8_LAS bf16x8*)(lds + PG8_SB(b, h) + boff + n * 2048 + k * 1024); } } } while (0)
#define PG8_MMA(ai, bj, At, Bt) do { __builtin_amdgcn_s_setprio(1); if constexpr (F8) { _Pragma("unroll") for (int m = 0; m < 4; ++m) _Pragma("unroll") for (int n = 0; n < 2; ++n) \
        asm volatile("v_mfma_f32_16x16x128_f8f6f4 %0, %1, %2, %0" : "+v"(acc[ai][bj][m][n]) : "v"(Bt##8[n]), "v"(At##8[m])); } else { \
        _Pragma("unroll") for (int m = 0; m < 4; ++m) _Pragma("unroll") for (int n = 0; n < 2; ++n) _Pragma("unroll") for (int k = 0; k < 2; ++k) \
        acc[ai][bj][m][n] = __builtin_amdgcn_mfma_f32_16x16x32_bf16(Bt[n][k], At[m][k], acc[ai][bj][m][n], 0, 0, 0); } __builtin_amdgcn_s_setprio(0); } while (0)
#define PG8_WAIT_V(n) asm volatile("s_waitcnt vmcnt(" #n ")" ::: "memory")
#define PG8_WAIT_L(n) asm volatile("s_waitcnt lgkmcnt(" #n ")" ::: "memory")
#define PG8_BAR __builtin_amdgcn_s_barrier()
#define PG8_SCHED __builtin_amdgcn_sched_barrier(0)
    Unit cur, nxt; int ui = 0;
    if (!S.next(0, cur)) return;
    f32x4 acc[2][2][4][2];
#pragma unroll
    for (int a = 0; a < 2; ++a)
#pragma unroll
        for (int b = 0; b < 2; ++b)
#pragma unroll
            for (int m = 0; m < 4; ++m)
#pragma unroll
                for (int n = 0; n < 2; ++n) acc[a][b][m][n] = (f32x4){0.f, 0.f, 0.f, 0.f};
    bf16x8 At[4][2], B0[2][2], B1[2][2]; i32x8 At8[4], B08[2], B18[2];
    unsigned vo[4], vn[4];
    PG8_AOFF(vo, cur);
    const char* cB = (const char*)g.Bt + (size_t)cur.pb * tstep;
    S.a_ready(cur);
    PG8_STAGE(PG8_SB(0, 0), cB, voffB); PG8_STAGE(PG8_SB(0, 1), cB + hstep, voffB); PG8_STAGE_A(PG8_SA(0, 0), 0, vo, 0); PG8_STAGE_A(PG8_SA(0, 1), 0, vo, 1);
    if (wr == 1) PG8_BAR;
    PG8_WAIT_V(2); PG8_BAR;
    PG8_STAGE(PG8_SB(1, 0), cB + kstep, voffB); PG8_STAGE_A(PG8_SA(1, 0), kstep, vo, 0); PG8_STAGE(PG8_SB(1, 1), cB + hstep + kstep, voffB);
    PG8_WAIT_V(6); PG8_BAR;
    for (;;) {
        const bool has_next = S.next(ui + 1, nxt);
        if (has_next) { PG8_AOFF(vn, nxt); } else {
#pragma unroll
            for (int q = 0; q < 4; ++q) vn[q] = vo[q]; }
        const char* nB = has_next ? (const char*)g.Bt + (size_t)nxt.pb * tstep : cB;
#pragma unroll 1
        for (int t = 0; t < nt; t += 2) {
            const bool last = (t == nt - 2);
            const size_t k1 = (size_t)(t + 1) * kstep;
            const size_t k2 = last ? (size_t)0 : (size_t)(t + 2) * kstep, k3 = k2 + kstep;
            const char* b2 = last ? nB : cB + (size_t)(t + 2) * kstep; const char* b3 = b2 + kstep;
            unsigned v2[4];
#pragma unroll
            for (int q = 0; q < 4; ++q) v2[q] = last ? vn[q] : vo[q];
            if (last && has_next) S.a_ready(nxt);
            if constexpr (Epi::PREFETCH) { if (last) E.prefetch(cur, lds + PF_OFF, wid, lane); }
            PG8_LDB(B0, 0, 0); PG8_LDB(B1, 0, 1); PG8_SCHED; PG8_LDA(At, 0, 0); PG8_STAGE_A(PG8_SA(1, 1), k1, vo, 1);
            PG8_WAIT_V(8); PG8_WAIT_L(0); PG8_BAR; PG8_MMA(0, 0, At, B0); PG8_MMA(0, 1, At, B1); PG8_BAR; PG8_SCHED;
            PG8_LDA(At, 0, 1); PG8_STAGE(PG8_SB(0, 0), b2, voffB); PG8_STAGE(PG8_SB(0, 1), b2 + hstep, voffB); PG8_STAGE_A(PG8_SA(0, 0), k2, v2, 0);
            PG8_WAIT_V(8); PG8_WAIT_L(0); PG8_BAR; PG8_MMA(1, 0, At, B0); PG8_MMA(1, 1, At, B1); PG8_BAR; PG8_SCHED;
            PG8_LDB(B0, 1, 0); PG8_LDB(B1, 1, 1); PG8_SCHED; PG8_LDA(At, 1, 0); PG8_STAGE_A(PG8_SA(0, 1), k2, v2, 1);
            PG8_WAIT_V(8); PG8_WAIT_L(0); PG8_BAR; PG8_MMA(0, 0, At, B0); PG8_MMA(0, 1, At, B1); PG8_BAR; PG8_SCHED;
            PG8_LDA(At, 1, 1); PG8_STAGE(PG8_SB(1, 0), b3, voffB); PG8_STAGE(PG8_SB(1, 1), b3 + hstep, voffB); PG8_STAGE_A(PG8_SA(1, 0), k3, v2, 0);
            PG8_WAIT_V(8); PG8_WAIT_L(0); PG8_BAR; PG8_MMA(1, 0, At, B0); PG8_MMA(1, 1, At, B1); PG8_BAR; PG8_SCHED;
        }
        if constexpr (ALIGN_EPI) { if (wr == 0) PG8_BAR; }
        if constexpr (F8) asm volatile("s_nop 15\n\ts_nop 15" ::: "memory");
        E(acc, cur, wr, wc, fr, fq); S.done(cur);
        if (!has_next) break;
        if (!E.keep_acc(cur))
#pragma unroll
        for (int a = 0; a < 2; ++a)
#pragma unroll
            for (int b = 0; b < 2; ++b)
#pragma unroll
                for (int m = 0; m < 4; ++m)
#pragma unroll
                    for (int n = 0; n < 2; ++n) acc[a][b][m][n] = (f32x4){0.f, 0.f, 0.f, 0.f};
        cur = nxt; cB = nB; ++ui;
#pragma unroll
        for (int q = 0; q < 4; ++q) vo[q] = vn[q];
        if constexpr (ALIGN_EPI) { if (wr == 1) PG8_BAR; }
    }
    PG8_WAIT_V(0);
    if constexpr (!ALIGN_EPI) { if (wr == 0) PG8_BAR; }
    PG8_BAR;
#undef PG8_SA
#undef PG8_SB
#undef PG8_STAGE
#undef PG8_STAGE_A
#undef PG8_AOFF
#undef PG8_LDA
#undef PG8_LDB
#undef PG8_MMA
#undef PG8_WAIT_V
#undef PG8_WAIT_L
#undef PG8_BAR
#undef PG8_SCHED
}
}

struct SchedBase {
    __device__ __forceinline__ void a_ready(const pg8::Unit&) const {}
    __device__ __forceinline__ void done(const pg8::Unit&) const {}
};
struct SchedInProj : SchedBase {
    int G, v;
    __device__ __forceinline__ bool next(int i, pg8::Unit& u) const {
        if (INPROJ_XCD_BLOCKS && G == 256) {
            const int x = v >> 5, q_ = i * 32 + (v & 31);
            if (q_ < 136) { const int lt = 8 * x + (q_ & 7); u.pn = q_ >> 3; u.pm = lt + (lt >> 5); }
            else if ((x & 3) == 3 && q_ < 141) { const int r = q_ - 136; u.pm = x == 3 ? 32 : 65; u.pn = r == 0 ? 2 : 4 + r; }
            else return false;
            u.pb = u.pn; u.acol = 0; u.e = 0; u.pos0 = 0; u.cnt = 0; u.base = 0; return true;
        }
        const int L = i * G + v; if (L >= 1098) return false;
        if (L < 1088) { const int gI = L / 136, r = L % 136, lt = 8 * gI + (r & 7); u.pn = r >> 3; u.pm = lt + (lt >> 5); }
        else { const int r = L - 1088, q = r % 5; u.pm = r < 5 ? 32 : 65; u.pn = q == 0 ? 2 : 4 + q; }
        u.pb = u.pn; u.acol = 0; u.e = 0; u.pos0 = 0; u.cnt = 0; u.base = 0; return true;
    }
    __device__ __forceinline__ int arow(const pg8::Unit& u, int rloc) const { return u.pm * 256 + rloc; }
};
struct SchedInProjA : SchedBase {
    int G, v;
    __device__ __forceinline__ bool next(int i, pg8::Unit& u) const {
        const int L = i * G + v; if (L >= 586) return false;
        if (L < 576) { const int gI = L / 72, r = L % 72, lt = 8 * gI + (r & 7); u.pn = r >> 3; u.pm = lt + (lt >> 5); }
        else { const int r = L - 576, q = r % 5; u.pm = r < 5 ? 32 : 65; u.pn = q == 0 ? 2 : 4 + q; }
        u.pb = u.pn; u.acol = 0; u.e = 0; u.pos0 = 0; u.cnt = 0; u.base = 0; return true;
    }
    __device__ __forceinline__ int arow(const pg8::Unit& u, int rloc) const { return u.pm * 256 + rloc; }
};
struct SchedInProjG : SchedBase {
    int G, v;
    __device__ __forceinline__ bool next(int i, pg8::Unit& u) const {
        int L;
        if (G != 256) { L = i * G + v; if (L >= 512) return false; }
        else if (i == 0) L = v; else if (i == 1 && v >= 74) L = 256 + v - 74; else if (i == 2 && v >= 74 && v < 148) L = 438 + v - 74; else return false;
        const int gI = L / 64, r = L % 64, lt = 8 * gI + (r & 7); u.pn = 9 + (r >> 3); u.pm = lt + (lt >> 5);
        u.pb = u.pn - 9; u.acol = 0; u.e = 0; u.pos0 = 0; u.cnt = 0; u.base = 0; return true;
    }
    __device__ __forceinline__ int arow(const pg8::Unit& u, int rloc) const { return u.pm * 256 + rloc; }
};
template <int NPART>
struct SchedTile : SchedBase {
    int G, v;
    __device__ __forceinline__ bool next(int i, pg8::Unit& u) const {
        if (i >= NPART || v >= 256) return false;
        u.pm = 8 * (v >> 5) + (v & 7); u.pn = (v & 31) >> 3; u.pb = i * 4 + u.pn; u.acol = i * 512; u.e = i; u.pos0 = 0; u.cnt = 0; u.base = 0; return true;
    }
    __device__ __forceinline__ int arow(const pg8::Unit& u, int rloc) const { return u.pm * 256 + rloc; }
};
template <int NN, bool GATHER>
struct SchedMoe : SchedBase {
    int G, v; const LAS int* tb; const int* tok;
    __device__ __forceinline__ bool next(int i, pg8::Unit& u) const {
        const int ntile = tb[64 + NE]; int rt;
        if (MOE_XCD_BLOCKS && G == 256) {
            const int RB = (ntile + 7) >> 3, q_ = i * 32 + (v & 31);
            if (q_ >= RB * NN) return false;
            rt = (v >> 5) * RB + q_ / NN; if (rt >= ntile) return false; u.pn = q_ % NN;
        } else { const int L = i * G + v; if (L >= ntile * NN) return false; rt = L / NN; u.pn = L % NN; }
        typedef int i32x4 __attribute__((ext_vector_type(4))); const i32x4 q = *(const LAS i32x4*)(tb + 128 + 4 * rt);
        u.e = q.x; u.pos0 = q.y; u.cnt = q.z; u.base = q.w; u.pm = (u.base + u.pos0) >> 8; u.pb = u.e * NN + u.pn; u.acol = 0; return true;
    }
    __device__ __forceinline__ int arow(const pg8::Unit& u, int rloc) const {
        if (GATHER) { const int pos = u.pos0 + rloc; return tok[u.e * ECAP + (pos < u.cnt ? pos : u.cnt - 1)]; }
        return u.pm * 256 + rloc;
    }
};

__device__ __forceinline__ float fast_sigmoid(float v) { return __builtin_amdgcn_rcpf(1.0f + __builtin_amdgcn_exp2f(-1.4426950408889634f * v)); }
__device__ __forceinline__ unsigned pk4_u8(float x0, float x1, float x2, float x3) {
    const unsigned a = __float_as_uint(fmaf(x0, 255.0f, 8388608.0f)), b = __float_as_uint(fmaf(x1, 255.0f, 8388608.0f)), c_ = __float_as_uint(fmaf(x2, 255.0f, 8388608.0f)), d = __float_as_uint(fmaf(x3, 255.0f, 8388608.0f));
    const unsigned lo = __builtin_amdgcn_perm(b, a, 0x0c0c0400u), hi = __builtin_amdgcn_perm(d, c_, 0x0c0c0400u);
    return __builtin_amdgcn_perm(hi, lo, 0x05040100u);
}
#define EPI_FENCE() do { asm volatile("" ::: "memory"); __builtin_amdgcn_sched_barrier(0); } while (0)
struct EpiInProj {
    static constexpr bool PERM = true, F8 = INPROJ_FP8_ALL, PREFETCH = false;
    static constexpr float ASC = F8 ? 1.0f / W8_SCALE : 1.0f;
    unsigned char* ws; const float *qna, *kna, *qnb, *knb;
    __device__ __forceinline__ bool keep_acc(const pg8::Unit&) const { return false; }
    __device__ __forceinline__ void operator()(pg8::f32x4 (&acc)[2][2][4][2], const pg8::Unit& u, int wr, int wc, int fr_in, int fq_in) const {
        int fr = fr_in, fq = fq_in; asm volatile("" : "+v"(fr), "+v"(fq));
        typedef pg8::f32x4 f32x4; typedef pg8::u32x4 u32x4;
        const int pm = u.pm, pn = u.pn, b = pm / 33, within = pm % 33; const bool isctx = within == 32;
        int kind; size_t wsoff; int colb; int pitch; const float* gn = qna; float scale = 1.0f; bool qrows = true;
        constexpr float QSC = ATT_FP8 ? 2.0f * C2 : C2, KSC = ATT_FP8 ? 0.5f : 1.0f;
        if (pn < 2) { kind = 0; wsoff = WS_QA; colb = (pn * 4 + wc) * 64; pitch = 512; gn = qna; scale = QSC; }
        else if (pn == 2) { qrows = false; pitch = 128; if (wc < 2) { kind = 0; wsoff = WS_KA; colb = wc * 64; gn = kna; scale = KSC; } else { kind = 1; wsoff = WS_VA; colb = (wc - 2) * 64; } }
        else if (pn < 5) { kind = 0; wsoff = WS_QB; colb = ((pn - 3) * 4 + wc) * 64; pitch = 512; gn = qnb; scale = QSC; }
        else if (pn < 7) { kind = 0; qrows = false; wsoff = WS_KB; colb = ((pn - 5) * 4 + wc) * 64; pitch = 512; gn = knb; scale = KSC; }
        else if (pn < 9) { kind = 1; qrows = false; wsoff = WS_VB; colb = ((pn - 7) * 4 + wc) * 64; pitch = 512; }
        else if (pn < 13) { kind = 2; wsoff = WS_G; colb = ((pn - 9) * 4 + wc) * 64; pitch = 2048; }
        else { kind = 2; wsoff = WS_G; colb = 1024 + ((pn - 13) * 4 + wc) * 64; pitch = 2048; }
        char* const dbase = (char*)(ws + wsoff);
        const int rowbase = (qrows ? (pm - b) : pm) * 256 + wr * 64 + fr;
        const unsigned o0 = (unsigned)(rowbase * pitch + colb + 8 * fq) * 2u, pb2 = (unsigned)pitch * 2u;
        if (kind == 0) {
            f32x4 gv[2][2];
#pragma unroll
            for (int bj = 0; bj < 2; ++bj)
#pragma unroll
                for (int n = 0; n < 2; ++n) gv[bj][n] = *(const f32x4*)(gn + 32 * bj + 8 * fq + 4 * n) * scale;
            float irev[4];
#pragma unroll
            for (int q = 0; q < 4; ++q) irev[q] = exp2f(-(float)(4 * fq + q) * (13.287712379549449f / 16.0f)) * 0.15915494309189535f;
#pragma unroll
            for (int ai = 0; ai < 2; ++ai) {
                float cr[4], sr[4];
                { const float pos = (float)(within * 4 + 2 * ai + wr);
#pragma unroll
                  for (int q = 0; q < 4; ++q) { float rev = pos * irev[q]; rev = rev - floorf(rev); cr[q] = __builtin_amdgcn_cosf(rev); sr[q] = __builtin_amdgcn_sinf(rev); } }
#pragma unroll
                for (int m = 0; m < 4; ++m) {
                    float ss = 0.f;
#pragma unroll
                    for (int bj = 0; bj < 2; ++bj)
#pragma unroll
                        for (int n = 0; n < 2; ++n) { const f32x4 x = acc[ai][bj][m][n]; ss += (x[0] * x[0] + x[1] * x[1]) + (x[2] * x[2] + x[3] * x[3]); }
                    ss += __shfl_xor(ss, 16); ss += __shfl_xor(ss, 32);
                    const float rstd = 1.0f / sqrtf(ss * (1.0f / 64.0f) + 1e-6f / (ASC * ASC));
                    float cc[4], sc[4];
                    { const float pos = (float)(16 * m + fr);
#pragma unroll
                      for (int q = 0; q < 4; ++q) { float rev = pos * irev[q]; rev = rev - floorf(rev); cc[q] = __builtin_amdgcn_cosf(rev); sc[q] = __builtin_amdgcn_sinf(rev); } }
                    const unsigned orow = o0 + (unsigned)(ai * 128 + m * 16) * pb2;
#pragma unroll
                    for (int bj = 0; bj < 2; ++bj) {
                        f32x4 x0 = acc[ai][bj][m][0] * rstd * gv[bj][0], x1 = acc[ai][bj][m][1] * rstd * gv[bj][1];
                        if (!isctx) {
                            const float c0 = bj ? cc[0] : cr[0], s0 = bj ? sc[0] : sr[0], c1 = bj ? cc[1] : cr[1], s1 = bj ? sc[1] : sr[1];
                            const float c2 = bj ? cc[2] : cr[2], s2 = bj ? sc[2] : sr[2], c3 = bj ? cc[3] : cr[3], s3 = bj ? sc[3] : sr[3];
                            x0 = (f32x4){x0[0] * c0 - x0[1] * s0, x0[0] * s0 + x0[1] * c0, x0[2] * c1 - x0[3] * s1, x0[2] * s1 + x0[3] * c1};
                            x1 = (f32x4){x1[0] * c2 - x1[1] * s2, x1[0] * s2 + x1[1] * c2, x1[2] * c3 - x1[3] * s3, x1[2] * s3 + x1[3] * c3};
                        }
                        if (ATT_FP8) { typedef unsigned u32x2 __attribute__((ext_vector_type(2))); u32x2 w; w.x = pk4_fp8(x0[0], x0[1], x0[2], x0[3]); w.y = pk4_fp8(x1[0], x1[1], x1[2], x1[3]);
                            *(u32x2*)(dbase + (orow >> 1) + 32 * bj) = w; }
                        else { u32x4 w; w.x = pg8::cvt_pk_bf16(x0[0], x0[1]); w.y = pg8::cvt_pk_bf16(x0[2], x0[3]); w.z = pg8::cvt_pk_bf16(x1[0], x1[1]); w.w = pg8::cvt_pk_bf16(x1[2], x1[3]);
                        *(u32x4*)(dbase + orow + 64 * bj) = w; }
                    }
                    EPI_FENCE();
                }
            }
        } else if (ATT_FP8 && kind == 1) {
            const int dvw = (pn == 2) ? 64 : 128;
            const int head = (pn == 2) ? (wc - 2) : (colb >> 7), dv0 = (pn == 2) ? 0 : (colb & 127);
            unsigned char* const vt = (unsigned char*)dbase + (size_t)((b * (pn == 2 ? 2 : 4) + head) * (SK / 64)) * (size_t)(dvw * 64);
#pragma unroll
            for (int ai = 0; ai < 2; ++ai)
#pragma unroll
                for (int m = 0; m < 4; ++m) {
                    const int t = within * 4 + 2 * ai + wr, k5 = (m & 1) * 16 + fr, slot = 16 * (m >> 1) + (k5 & 3) + 4 * (k5 >> 3), hh = (k5 >> 2) & 1;
                    unsigned char* const rowp = vt + (size_t)t * (size_t)(dvw * 64) + hh * 32 + slot;
#pragma unroll
                    for (int bj = 0; bj < 2; ++bj) {
                        const f32x4 x0 = acc[ai][bj][m][0] * ASC, x1 = acc[ai][bj][m][1] * ASC;
                        const unsigned w0 = pk4_fp8(x0[0], x0[1], x0[2], x0[3]), w1 = pk4_fp8(x1[0], x1[1], x1[2], x1[3]);
                        unsigned char* const q = rowp + (dv0 + 32 * bj + 8 * fq) * 64;
                        q[0] = (unsigned char)w0; q[64] = (unsigned char)(w0 >> 8); q[128] = (unsigned char)(w0 >> 16); q[192] = (unsigned char)(w0 >> 24);
                        q[256] = (unsigned char)w1; q[320] = (unsigned char)(w1 >> 8); q[384] = (unsigned char)(w1 >> 16); q[448] = (unsigned char)(w1 >> 24);
                    }
                    EPI_FENCE();
                }
        } else {
#pragma unroll
            for (int ai = 0; ai < 2; ++ai)
#pragma unroll
                for (int m = 0; m < 4; ++m) {
                    const unsigned orow = o0 + (unsigned)(ai * 128 + m * 16) * pb2;
#pragma unroll
                    for (int bj = 0; bj < 2; ++bj) {
                        f32x4 x0 = acc[ai][bj][m][0] * ASC, x1 = acc[ai][bj][m][1] * ASC;
                        if (kind == 2) { x0 = (f32x4){fast_sigmoid(x0[0]), fast_sigmoid(x0[1]), fast_sigmoid(x0[2]), fast_sigmoid(x0[3])}; x1 = (f32x4){fast_sigmoid(x1[0]), fast_sigmoid(x1[1]), fast_sigmoid(x1[2]), fast_sigmoid(x1[3])}; }
                        if (G_U8 && kind == 2) { typedef unsigned u32x2 __attribute__((ext_vector_type(2))); u32x2 w; w.x = pk4_u8(x0[0], x0[1], x0[2], x0[3]); w.y = pk4_u8(x1[0], x1[1], x1[2], x1[3]);
                            *(u32x2*)(dbase + (orow >> 1) + 32 * bj) = w; }
                        else { u32x4 w; w.x = pg8::cvt_pk_bf16(x0[0], x0[1]); w.y = pg8::cvt_pk_bf16(x0[2], x0[3]); w.z = pg8::cvt_pk_bf16(x1[0], x1[1]); w.w = pg8::cvt_pk_bf16(x1[2], x1[3]);
                        *(u32x4*)(dbase + orow + 64 * bj) = w; }
                    }
                    EPI_FENCE();
                }
        }
    }
};
struct EpiInProjG {
    static constexpr bool PERM = true, F8 = true, PREFETCH = false;
    unsigned char* ws;
    __device__ __forceinline__ bool keep_acc(const pg8::Unit&) const { return false; }
    __device__ __forceinline__ void operator()(pg8::f32x4 (&acc)[2][2][4][2], const pg8::Unit& u, int wr, int wc, int fr_in, int fq_in) const {
        int fr = fr_in, fq = fq_in; asm volatile("" : "+v"(fr), "+v"(fq));
        typedef pg8::f32x4 f32x4; typedef pg8::u32x4 u32x4;
        const int pm = u.pm, pn = u.pn, b = pm / 33;
        const int colb = ((pn - 9) * 4 + wc) * 64;
        char* const dbase = (char*)(ws + WS_G);
        const int rowbase = (pm - b) * 256 + wr * 64 + fr;
        const unsigned o0 = (unsigned)(rowbase * 2048 + colb + 8 * fq) * 2u, pb2 = 2048u * 2u;
        constexpr float ASC = 1.0f / W8_SCALE;
#pragma unroll
        for (int ai = 0; ai < 2; ++ai)
#pragma unroll
            for (int m = 0; m < 4; ++m) {
                const unsigned orow = o0 + (unsigned)(ai * 128 + m * 16) * pb2;
#pragma unroll
                for (int bj = 0; bj < 2; ++bj) {
                    f32x4 x0 = acc[ai][bj][m][0] * ASC, x1 = acc[ai][bj][m][1] * ASC;
                    x0 = (f32x4){fast_sigmoid(x0[0]), fast_sigmoid(x0[1]), fast_sigmoid(x0[2]), fast_sigmoid(x0[3])}; x1 = (f32x4){fast_sigmoid(x1[0]), fast_sigmoid(x1[1]), fast_sigmoid(x1[2]), fast_sigmoid(x1[3])};
                    u32x4 w; w.x = pg8::cvt_pk_bf16(x0[0], x0[1]); w.y = pg8::cvt_pk_bf16(x0[2], x0[3]); w.z = pg8::cvt_pk_bf16(x1[0], x1[1]); w.w = pg8::cvt_pk_bf16(x1[2], x1[3]);
                    *(u32x4*)(dbase + orow + 64 * bj) = w;
                }
                EPI_FENCE();
            }
    }
};
struct EpiMerge {
    static constexpr bool PERM = true, F8 = MERGE_FP8, PREFETCH = false;
    const bf16* G; bf16* MG;
    __device__ __forceinline__ bool keep_acc(const pg8::Unit& u) const { return u.e == 0; }
    __device__ __forceinline__ void operator()(pg8::f32x4 (&acc)[2][2][4][2], const pg8::Unit& u, int wr, int wc, int fr_in, int fq_in) const {
        int fr = fr_in, fq = fq_in; asm volatile("" : "+v"(fr), "+v"(fq));
        typedef pg8::f32x4 f32x4; typedef pg8::u32x4 u32x4;
        const int part = u.e; const unsigned row0 = (unsigned)(u.pm * 256 + wr * 64 + fr), col0 = (unsigned)(u.pn * 256 + wc * 32 + 8 * fq);
        const char* const gb = (const char*)G; char* const mb = (char*)MG;
        constexpr float P0SC = F8 ? 1.0f / YA8_SCALE : 1.0f;
        constexpr float P1SC = (F8 ? MG8_SCALE / W8_SCALE : 1.0f) * (G_U8 ? 1.0f / 255.0f : 1.0f);
        constexpr float GFLOOR = G_U8 ? 1e-6f : 1e-30f;
#define UNPK(WW, LO, HI) const f32x4 LO = G_U8 ? (f32x4){(float)(WW.x & 0xffu), (float)((WW.x >> 8) & 0xffu), (float)((WW.x >> 16) & 0xffu), (float)(WW.x >> 24)} \
                                              : (f32x4){__uint_as_float(WW.x << 16), __uint_as_float(WW.x & 0xffff0000u), __uint_as_float(WW.y << 16), __uint_as_float(WW.y & 0xffff0000u)}; \
                        const f32x4 HI = G_U8 ? (f32x4){(float)(WW.y & 0xffu), (float)((WW.y >> 8) & 0xffu), (float)((WW.y >> 16) & 0xffu), (float)(WW.y >> 24)} \
                                              : (f32x4){__uint_as_float(WW.z << 16), __uint_as_float(WW.z & 0xffff0000u), __uint_as_float(WW.w << 16), __uint_as_float(WW.w & 0xffff0000u)}
#pragma unroll
        for (int ai = 0; ai < 2; ++ai) {
            u32x4 wbv[8], wav[8];
#pragma unroll
            for (int q = 0; q < 8; ++q) { const unsigned row = row0 + (unsigned)(ai * 128 + (q >> 1) * 16), col = col0 + (unsigned)((q & 1) * 128); const unsigned gel = (row * 2048u + col) * (G_U8 ? 1u : 2u);
                if (G_U8) { typedef unsigned u32x2 __attribute__((ext_vector_type(2))); const u32x2 tb_ = *(const u32x2*)(gb + gel + 1024u), ta_ = *(const u32x2*)(gb + gel);
                    wbv[q] = (u32x4){tb_.x, tb_.y, 0u, 0u}; wav[q] = (u32x4){ta_.x, ta_.y, 0u, 0u}; }
                else { wbv[q] = *(const u32x4*)(gb + gel + 2048u); wav[q] = *(const u32x4*)(gb + gel); } }
#pragma unroll
            for (int q = 0; q < 8; ++q) { const int m = q >> 1, bj = q & 1;
                const unsigned row = row0 + (unsigned)(ai * 128 + m * 16), col = col0 + (unsigned)(bj * 128);
                const u32x4 wb = wbv[q];
                UNPK(wb, b0, b1);
                f32x4 c0, c1;
#pragma unroll
                for (int j = 0; j < 4; ++j) { c0[j] = fmaxf(b0[j], GFLOOR); c1[j] = fmaxf(b1[j], GFLOOR); }
                if (part == 0) {
                    const u32x4 wa = wav[q];
                    UNPK(wa, a0, a1);
#pragma unroll
                    for (int j = 0; j < 4; ++j) { acc[ai][bj][m][0][j] *= a0[j] * P0SC * __builtin_amdgcn_rcpf(c0[j]); acc[ai][bj][m][1][j] *= a1[j] * P0SC * __builtin_amdgcn_rcpf(c1[j]); }
                } else {
                    const f32x4 x0 = acc[ai][bj][m][0] * c0 * P1SC, x1 = acc[ai][bj][m][1] * c1 * P1SC;
                    if constexpr (F8) { typedef unsigned u32x2 __attribute__((ext_vector_type(2))); u32x2 w; w.x = pk4_fp8(x0[0], x0[1], x0[2], x0[3]); w.y = pk4_fp8(x1[0], x1[1], x1[2], x1[3]); *(u32x2*)(mb + (row * 1024u + col)) = w; }
                    else { u32x4 w; w.x = pg8::cvt_pk_bf16(x0[0], x0[1]); w.y = pg8::cvt_pk_bf16(x0[2], x0[3]); w.z = pg8::cvt_pk_bf16(x1[0], x1[1]); w.w = pg8::cvt_pk_bf16(x1[2], x1[3]);
                    *(u32x4*)(mb + (row * 1024u + col) * 2u) = w; } }
            }
            EPI_FENCE();
        }
#undef UNPK
    }
};
struct EpiOut {
    static constexpr bool PERM = false, F8 = MERGE_FP8, PREFETCH = false;
    const float* x; const float* MOD; float* out;
    __device__ __forceinline__ bool keep_acc(const pg8::Unit&) const { return false; }
    __device__ __forceinline__ void operator()(pg8::f32x4 (&acc)[2][2][4][2], const pg8::Unit& u, int wr, int wc, int fr_in, int fq_in) const {
        int fr = fr_in, fq = fq_in; asm volatile("" : "+v"(fr), "+v"(fq));
        typedef pg8::f32x4 f32x4;
        const unsigned row0 = (unsigned)(u.pm * 256 + wr * 64 + fr), col0 = (unsigned)(u.pn * 256 + wc * 32 + 4 * fq); const int b = u.pm >> 5;
        const float* ga = MOD + b * NMOD + 2 * D; const char* const xb = (const char*)x; char* const ob = (char*)out;
        const unsigned e0 = (row0 * 1024u + col0) * 4u;
#pragma unroll
        for (int bj = 0; bj < 2; ++bj)
#pragma unroll
            for (int n = 0; n < 2; ++n) { const f32x4 gv = *(const f32x4*)(ga + col0 + bj * 128 + n * 16) * (F8 ? 1.0f / (MG8_SCALE * W8_SCALE) : 1.0f);
                f32x4 xv[8];
#pragma unroll
                for (int q = 0; q < 8; ++q) xv[q] = *(const f32x4*)(xb + e0 + (unsigned)((((q >> 2) * 128 + (q & 3) * 16) * 1024 + bj * 128 + n * 16) * 4));
#pragma unroll
                for (int q = 0; q < 8; ++q) { const f32x4 r_ = xv[q] + gv * acc[q >> 2][bj][q & 3][n];
                    const unsigned eo = e0 + (unsigned)((((q >> 2) * 128 + (q & 3) * 16) * 1024 + bj * 128 + n * 16) * 4);
                    if (X1_BF16) { uint2 w_; w_.x = pk2(r_.x, r_.y); w_.y = pk2(r_.z, r_.w); *(uint2*)(ob + (eo >> 1)) = w_; }
                    else *(f32x4*)(ob + eo) = r_; }
                EPI_FENCE(); }
    }
};
struct EpiMoe1 {
    static constexpr bool PERM = true, F8 = MOE_FP8, PREFETCH = EPI_PREFETCH;
    const float *bg, *bu; bf16* ACT; const LAS unsigned char* pfl;
    __device__ __forceinline__ void prefetch(const pg8::Unit& u, LAS unsigned char* pf, int wid, int lane) const {
        if (wid == 0) { const float* src = (lane < 32 ? bg : bu) + u.e * D + u.pn * 128 + 4 * (lane & 31);
            __builtin_amdgcn_global_load_lds((const unsigned*)src, (LAS unsigned*)pf, 16, 0, 0); } }
    __device__ __forceinline__ bool keep_acc(const pg8::Unit&) const { return false; }
    __device__ __forceinline__ void operator()(pg8::f32x4 (&acc)[2][2][4][2], const pg8::Unit& u, int wr, int wc, int fr_in, int fq_in) const {
        int fr = fr_in, fq = fq_in; asm volatile("" : "+v"(fr), "+v"(fq));
        typedef pg8::f32x4 f32x4; typedef pg8::u32x4 u32x4; typedef float f32x2 __attribute__((ext_vector_type(2)));
        const int col0 = u.pn * 128 + wc * 32 + 8 * fq; const unsigned row0 = (unsigned)(u.pm * 256 + wr * 64 + fr);
        f32x4 bg0, bg1, bu0, bu1;
        if constexpr (PREFETCH) { const LAS float* pf = (const LAS float*)pfl + wc * 32 + 8 * fq; bg0 = *(const LAS f32x4*)pf; bg1 = *(const LAS f32x4*)(pf + 4); bu0 = *(const LAS f32x4*)(pf + 128); bu1 = *(const LAS f32x4*)(pf + 132); }
        else { bg0 = *(const f32x4*)(bg + u.e * D + col0); bg1 = *(const f32x4*)(bg + u.e * D + col0 + 4); bu0 = *(const f32x4*)(bu + u.e * D + col0); bu1 = *(const f32x4*)(bu + u.e * D + col0 + 4); }
        char* const ab = (char*)ACT; const unsigned e0 = (row0 * 1024u + (unsigned)col0) * (F8 ? 1u : 2u);
        constexpr float ASC = F8 ? 1.0f / W8_SCALE : 1.0f;
#pragma unroll
        for (int ai = 0; ai < 2; ++ai)
#pragma unroll
            for (int m = 0; m < 4; ++m) {
                unsigned w[4] = {0u, 0u, 0u, 0u}; f32x2 oo[2][2];
#pragma unroll
                for (int n = 0; n < 2; ++n) { const f32x4 gt = acc[ai][0][m][n] * ASC + (n ? bg1 : bg0), up = acc[ai][1][m][n] * ASC + (n ? bu1 : bu0);
#pragma unroll
                    for (int hj = 0; hj < 2; ++hj) {
                        f32x2 g2 = {fminf(gt[2 * hj], 7.0f), fminf(gt[2 * hj + 1], 7.0f)};
                        const f32x2 u2 = {__builtin_amdgcn_fmed3f(up[2 * hj], -7.0f, 7.0f), __builtin_amdgcn_fmed3f(up[2 * hj + 1], -7.0f, 7.0f)};
                        const f32x2 tt = g2 * (-1.702f * 1.4426950408889634f);
                        f32x2 den = {__builtin_amdgcn_exp2f(tt.x), __builtin_amdgcn_exp2f(tt.y)}; den = den + 1.0f;
                        const f32x2 sg = {__builtin_amdgcn_rcpf(den.x), __builtin_amdgcn_rcpf(den.y)};
                        const f32x2 gs = g2 * sg, o2 = u2 * gs + gs;
                        if constexpr (F8) oo[n][hj] = o2 * ACT8_SCALE;
                        else w[2 * n + hj] = pg8::cvt_pk_bf16(o2.x, o2.y); } }
                if constexpr (F8) {
#pragma unroll
                    for (int n = 0; n < 2; ++n) { int r = __builtin_amdgcn_cvt_pk_fp8_f32(oo[n][0].x, oo[n][0].y, 0, false); r = __builtin_amdgcn_cvt_pk_fp8_f32(oo[n][1].x, oo[n][1].y, r, true); w[n] = (unsigned)r; } }
                if constexpr (F8) { typedef unsigned u32x2 __attribute__((ext_vector_type(2))); u32x2 wv; wv.x = w[0]; wv.y = w[1]; *(u32x2*)(ab + e0 + (unsigned)((ai * 128 + m * 16) * 1024)) = wv; }
                else { u32x4 wv; wv.x = w[0]; wv.y = w[1]; wv.z = w[2]; wv.w = w[3];
                *(u32x4*)(ab + e0 + (unsigned)((ai * 128 + m * 16) * 2048)) = wv; }
                EPI_FENCE();
            }
    }
};
struct EpiMoe2 {
    static constexpr bool PERM = true, F8 = MOE_FP8, PREFETCH = EPI_PREFETCH;
    const float* bd; const float* SW; const int* SDST; bf16* Y; const LAS unsigned char* pfl;
    __device__ __forceinline__ void prefetch(const pg8::Unit& u, LAS unsigned char* pf, int wid, int lane) const {
        if (wid < 3) { const void* src = wid == 0 ? (const void*)(bd + u.e * D + u.pn * 256 + 4 * lane) : wid == 1 ? (const void*)(SW + u.e * ECAP + u.pos0 + 4 * lane) : (const void*)(SDST + u.e * ECAP + u.pos0 + 4 * lane);
            __builtin_amdgcn_global_load_lds((const unsigned*)src, (LAS unsigned*)(pf + wid * 1024), 16, 0, 0); } }
    __device__ __forceinline__ bool keep_acc(const pg8::Unit&) const { return false; }
    __device__ __forceinline__ void operator()(pg8::f32x4 (&acc)[2][2][4][2], const pg8::Unit& u, int wr, int wc, int fr_in, int fq_in) const {
        int fr = fr_in, fq = fq_in; asm volatile("" : "+v"(fr), "+v"(fq));
        typedef pg8::f32x4 f32x4; typedef pg8::u32x4 u32x4;
        const int col0 = u.pn * 256 + wc * 32 + 8 * fq;
        f32x4 bv[2][2];
#pragma unroll
        for (int bj = 0; bj < 2; ++bj)
#pragma unroll
            for (int n = 0; n < 2; ++n) { if constexpr (PREFETCH) bv[bj][n] = *(const LAS f32x4*)((const LAS float*)pfl + wc * 32 + 8 * fq + bj * 128 + 4 * n); else bv[bj][n] = *(const f32x4*)(bd + u.e * D + col0 + bj * 128 + 4 * n); }
        char* const yb = (char*)Y;
        constexpr float ASC = F8 ? 1.0f / (W8_SCALE * ACT8_SCALE) : 1.0f;
        float wv[8]; int dv[8];
#pragma unroll
        for (int q = 0; q < 8; ++q) { const int rl = (q >> 2) * 128 + wr * 64 + (q & 3) * 16 + fr, pos = u.pos0 + rl; const bool ok = pos < u.cnt; const int pc = ok ? pos : u.cnt - 1; int d;
            if constexpr (PREFETCH) { wv[q] = *((const LAS float*)pfl + 256 + rl); d = *((const LAS int*)pfl + 512 + rl); }
            else { wv[q] = SW[u.e * ECAP + pc]; d = SDST[u.e * ECAP + pc]; }
            dv[q] = ok ? d : (int)((WS_TRASH - WS_Y) / ((Y_FP8 ? 1 : 2) * D)); }
#pragma unroll
        for (int ai = 0; ai < 2; ++ai)
#pragma unroll
            for (int m = 0; m < 4; ++m) {
                const float w = wv[ai * 4 + m] * (Y_FP8 ? Y8_SCALE : 1.0f); const unsigned dst = ((unsigned)dv[ai * 4 + m] * 1024u + (unsigned)col0) * (Y_FP8 ? 1u : 2u);
#pragma unroll
                for (int bj = 0; bj < 2; ++bj) { const f32x4 x0 = (acc[ai][bj][m][0] * ASC + bv[bj][0]) * w, x1 = (acc[ai][bj][m][1] * ASC + bv[bj][1]) * w;
                    if constexpr (Y_FP8 != 0) { typedef unsigned u32x2 __attribute__((ext_vector_type(2))); u32x2 o; o.x = pk4_fp8(x0[0], x0[1], x0[2], x0[3]); o.y = pk4_fp8(x1[0], x1[1], x1[2], x1[3]); *(u32x2*)(yb + dst + bj * 128) = o; }
                    else { u32x4 o; o.x = pg8::cvt_pk_bf16(x0[0], x0[1]); o.y = pg8::cvt_pk_bf16(x0[2], x0[3]); o.z = pg8::cvt_pk_bf16(x1[0], x1[1]); o.w = pg8::cvt_pk_bf16(x1[2], x1[3]);
                    *(u32x4*)(yb + dst + bj * 256) = o; } }
            }
    }
};
#include <hip/hip_bf16.h>
#ifndef ATT_DMAPOS
#define ATT_DMAPOS 0
#endif
#ifndef ATT_PRIO
#define ATT_PRIO 1
#endif
namespace attn_body {
using bf16=__hip_bfloat16;
using bf16x8=__attribute__((ext_vector_type(8)))short;
using s16x4=__attribute__((ext_vector_type(4)))short;
using f32x16=__attribute__((ext_vector_type(16)))float;
using u32x4=__attribute__((ext_vector_type(4)))unsigned;
constexpr int D=64;
constexpr int NW=8,QBLK=32,QB=QBLK*NW,KVBLK=64;
#ifndef ONES8_PIN_B
#define ONES8_PIN_B 1
#endif
__device__ __forceinline__ int crow(int r,int hi){return (r&3)+8*(r>>2)+4*hi;}
#define SBAR() __builtin_amdgcn_sched_barrier(0)
constexpr int NSLOT=3, SLOTB=8192;
constexpr int LDS_K=0, LDS_V=NSLOT*SLOTB, LDS_WS=2*NSLOT*SLOTB, LDS_OST=LDS_WS+NW*64*4, LDS_BYTES=LDS_OST+NW*4096;
__device__ __forceinline__ void glds16(const void*gsrc,unsigned lds_dst){unsigned keep;
  asm volatile("s_mov_b32 %0, m0\n\ts_mov_b32 m0, %2\n\ts_nop 0\n\tglobal_load_lds_dwordx4 %1, off\n\ts_mov_b32 m0, %0":"=&s"(keep):"v"(gsrc),"s"(lds_dst):"memory");}
__device__ __forceinline__ float max3f(float a,float b,float c){float r;asm("v_max3_f32 %0, %1, %2, %3":"=v"(r):"v"(a),"v"(b),"v"(c));return r;}
__device__ __forceinline__ float max2f(float a,float b){float r;asm("v_max_f32_e32 %0, %1, %2":"=v"(r):"v"(a),"v"(b));return r;}
__device__ __forceinline__ float fadd_s(float a,float b){float r;asm("v_add_f32_e32 %0, %1, %2":"=v"(r):"v"(a),"v"(b));return r;}
__device__ __forceinline__ float fsub_s(float a,float b){float r;asm("v_sub_f32_e32 %0, %1, %2":"=v"(r):"v"(a),"v"(b));return r;}
typedef float f32x2_t __attribute__((ext_vector_type(2))); typedef __bf16 bf16x2_t __attribute__((ext_vector_type(2)));
__device__ __forceinline__ unsigned cvtpk_s(float lo,float hi){f32x2_t v={lo,hi};bf16x2_t b=__builtin_convertvector(v,bf16x2_t);return __builtin_bit_cast(unsigned,b);}
#define WAIT_BAR(N) asm volatile("s_waitcnt vmcnt(" #N ") lgkmcnt(0)\n\ts_barrier":::"memory")

__device__ __forceinline__ void qkt(f32x16&p0,f32x16&p1,const char*Kslot,const bf16x8*qr,const f32x16&negm,int r32,int hi){
  const char*kb=Kslot+hi*1024+r32*16;
  #pragma unroll
  for(int d0=0;d0<4;++d0){
    const bf16x8 b0=*reinterpret_cast<const bf16x8*>(kb+d0*2048);
    const bf16x8 b1=*reinterpret_cast<const bf16x8*>(kb+d0*2048+512);
    if(d0==0){p0=__builtin_amdgcn_mfma_f32_32x32x16_bf16(b0,qr[0],negm,0,0,0);p1=__builtin_amdgcn_mfma_f32_32x32x16_bf16(b1,qr[0],negm,0,0,0);}
    else{p0=__builtin_amdgcn_mfma_f32_32x32x16_bf16(b0,qr[d0],p0,0,0,0);p1=__builtin_amdgcn_mfma_f32_32x32x16_bf16(b1,qr[d0],p1,0,0,0);}}
}
typedef __attribute__((address_space(3))) const char* lds_cptr;
typedef short v4i16_t __attribute__((ext_vector_type(4)));
__device__ __forceinline__ void kload8(bf16x8*kf,lds_cptr kp){
  kf[0]=*(const __attribute__((address_space(3))) bf16x8*)(kp);      kf[1]=*(const __attribute__((address_space(3))) bf16x8*)(kp+512);
  kf[2]=*(const __attribute__((address_space(3))) bf16x8*)(kp+2048); kf[3]=*(const __attribute__((address_space(3))) bf16x8*)(kp+2560);
  kf[4]=*(const __attribute__((address_space(3))) bf16x8*)(kp+4096); kf[5]=*(const __attribute__((address_space(3))) bf16x8*)(kp+4608);
  kf[6]=*(const __attribute__((address_space(3))) bf16x8*)(kp+6144); kf[7]=*(const __attribute__((address_space(3))) bf16x8*)(kp+6656);
}
__device__ __forceinline__ void kload2(bf16x8*kf,lds_cptr kp,int j){ kf[2*j]=*(const __attribute__((address_space(3))) bf16x8*)(kp+j*2048); kf[2*j+1]=*(const __attribute__((address_space(3))) bf16x8*)(kp+j*2048+512); }
__device__ __forceinline__ s16x4 vtr(lds_cptr p){ return __builtin_bit_cast(s16x4,__builtin_amdgcn_ds_read_tr16_b64_v4i16((__attribute__((address_space(3))) v4i16_t*)p)); }
template<int DV> struct Lds2 { static constexpr int VSLOT=DV*128, K=0, V=NSLOT*SLOTB, WS=V+NSLOT*VSLOT, OST=WS+NW*64*4, BYTES=OST+NW*4096; };
template<int DV,bool ONES,int NT,int QP,int KP,int VP,int OP,int O8=0> __device__ __forceinline__ void attn_unit2(const bf16*Qu,const bf16*__restrict__ Kb,const bf16*__restrict__ Vb,bf16*Ou,char*shm){
  typedef Lds2<DV> L; constexpr int ND=DV/32, NV=DV/64, VSLOT=L::VSLOT;
  const int tid=threadIdx.x,lane=tid&63,r32=lane&31,hi=lane>>5; const int wid=__builtin_amdgcn_readfirstlane(tid>>6);
  const bf16*Qw=Qu+(long)(wid*QBLK)*QP;
  const unsigned lds0=(unsigned)(uintptr_t)shm;
  float*wsf=(float*)(shm+L::WS)+wid*64;
  const bf16*ksrc=Kb+(long)lane*KP+wid*8;
  const bf16*vsrc=Vb+(long)(16*(wid&3)+(lane>>2))*VP+(wid>>2)*32+(lane&3)*8;
  const unsigned kdst=lds0+L::K+wid*1024, vdst=lds0+L::V+wid*1024;
  #define DMA_K(t,slot) glds16(ksrc+(long)(t)*KVBLK*KP,(unsigned)__builtin_amdgcn_readfirstlane(kdst+(slot)*SLOTB))
  #define DMA_V(t,slot) do{ _Pragma("unroll") for(int q_=0;q_<NV;++q_) glds16(vsrc+(long)(t)*KVBLK*VP+q_*64,(unsigned)__builtin_amdgcn_readfirstlane(vdst+(slot)*VSLOT+q_*8192)); }while(0)
  #define WAITB_KV() do{ if constexpr(NV==1) asm volatile("s_waitcnt vmcnt(2) lgkmcnt(0)\n\ts_barrier":::"memory"); else asm volatile("s_waitcnt vmcnt(3) lgkmcnt(0)\n\ts_barrier":::"memory"); }while(0)
  #define WAITB_V()  do{ if constexpr(NV==1) asm volatile("s_waitcnt vmcnt(1) lgkmcnt(0)\n\ts_barrier":::"memory"); else asm volatile("s_waitcnt vmcnt(2) lgkmcnt(0)\n\ts_barrier":::"memory"); }while(0)
  #define WAITB_0()  asm volatile("s_waitcnt vmcnt(0) lgkmcnt(0)\n\ts_barrier":::"memory")
  const char*Kbase=shm+L::K; bf16x8 kf[8];
  const lds_cptr shm3=(lds_cptr)shm; const lds_cptr kp0=shm3+L::K+hi*1024+r32*16; const lds_cptr vp0=shm3+L::V+((lane>>4)&1)*32+(lane&3)*8+(4*hi+((lane&15)>>2))*64;
  DMA_K(0,0);DMA_V(0,0);DMA_K(1,1);
  bf16x8 qr[4];
  #pragma unroll
  for(int d0=0;d0<4;++d0)qr[d0]=*reinterpret_cast<const bf16x8*>(&Qw[(long)r32*QP+d0*16+hi*8]);
  float l_reg=0.f; f32x16 o[ND]; f32x16 os=f32x16{};
  #pragma unroll
  for(int d_=0;d_<ND;++d_)o[d_]=f32x16{};
  const f32x16 zero16=f32x16{};
  const bf16x8 ones={(short)0x3F80,(short)0x3F80,(short)0x3F80,(short)0x3F80,(short)0x3F80,(short)0x3F80,(short)0x3F80,(short)0x3F80};
  f32x16 pA0,pA1,pB0,pB1;
  int sp=0,sc=0,sn=1;
  #define ROT() do{sp=sc;sc=sn;sn=(sn==NSLOT-1)?0:sn+1;}while(0)
  DMA_K(2,2);
  asm volatile("s_waitcnt vmcnt(3) lgkmcnt(0)\n\ts_barrier":::"memory");
  qkt(pA0,pA1,Kbase,qr,zero16,r32,hi);asm volatile("s_nop 15\n\ts_nop 7":"+v"(pA0),"+v"(pA1));
  _Pragma("unroll") for(int r=0;r<16;++r){pA0[r]=__builtin_amdgcn_exp2f(pA0[r]);pA1[r]=__builtin_amdgcn_exp2f(pA1[r]);}
  WAITB_0();
  DMA_K(3,0);DMA_V(1,1);
  ROT();
  kload8(kf,kp0+sc*SLOTB);
  WAITB_KV();
  s16x4 vlo[4*ND],vhi[4*ND]; u32x4 pw0,pw1,pw2,pw3;
  #define PKW(P,B) cvtpk_s(P[B],P[B+1])
  #define PAF(k) __builtin_bit_cast(bf16x8,pw##k)
  #define VFR(i) (bf16x8){vlo[i][0],vlo[i][1],vlo[i][2],vlo[i][3],vhi[i][0],vhi[i][1],vhi[i][2],vhi[i][3]}
  #define PIN(x) asm volatile("":"+v"(x))
  #define MF(a,b,c) __builtin_amdgcn_mfma_f32_32x32x16_bf16(a,b,c,0,0,0)
  #define EX(v) __builtin_amdgcn_exp2f(v)
  #define EXQ(C0,C1,e) do{ if((e)<16) C0[(e)&15]=EX(C0[(e)&15]); else C1[(e)&15]=EX(C1[(e)&15]); }while(0)
  #define VRD(i) do{ vlo[i]=vtr(vp_+(((i)>>2)*4096+((i)&3)*1024)); vhi[i]=vtr(vp_+(((i)>>2)*4096+((i)&3)*1024+512)); }while(0)
  #define KRD(G,j) do{ if(G){ kload2(kf,kp0+sn*SLOTB,j); SBAR(); } }while(0)
  #define GAPA(DST,MFX,A0,A1,A2,A3,W0,W1,PW) do{ DST=MFX; PIN(DST); if constexpr(!ONES){ sacc+=A0; sacc+=A1; sacc+=A2; sacc+=A3; PIN(sacc); } W0; W1; PIN(PW); SBAR(); }while(0)
  #define GAPB(DST,MFX,C0,C1,e0,NE) do{ DST=MFX; PIN(DST); _Pragma("unroll") for(int e_=0;e_<(NE);++e_) EXQ(C0,C1,(e0)+e_); PIN(C0); PIN(C1); SBAR(); }while(0)
  #define STEP(C0,C1,P0,P1,t,GK,GV,GL) do{ SBAR(); \
    const lds_cptr vp_=vp0+sp*VSLOT; \
    VRD(0); SBAR(); float sacc=0.f; if constexpr(!ONES){ sacc=(P0[0]+P0[1]); } \
    GAPA(C0,MF(kf[0],qr[0],zero16), P0[2],P0[3],P0[4],P0[5],     pw0[0]=PKW(P0,0), pw0[1]=PKW(P0,2), pw0); \
    VRD(4); SBAR(); GAPA(C1,MF(kf[1],qr[0],zero16), P0[6],P0[7],P0[8],P0[9],     pw0[2]=PKW(P0,4), pw0[3]=PKW(P0,6), pw0); \
    VRD(1); SBAR(); GAPA(C0,MF(kf[2],qr[1],C0),   P0[10],P0[11],P0[12],P0[13], pw1[0]=PKW(P0,8), pw1[1]=PKW(P0,10), pw1); \
    VRD(5); SBAR(); GAPA(C1,MF(kf[3],qr[1],C1),   P0[14],P0[15],P1[0],P1[1],   pw1[2]=PKW(P0,12),pw1[3]=PKW(P0,14), pw1); \
    VRD(2); SBAR(); GAPA(C0,MF(kf[4],qr[2],C0),   P1[2],P1[3],P1[4],P1[5],     pw2[0]=PKW(P1,0), pw2[1]=PKW(P1,2), pw2); \
    VRD(6); SBAR(); GAPA(C1,MF(kf[5],qr[2],C1),   P1[6],P1[7],P1[8],P1[9],     pw2[2]=PKW(P1,4), pw2[3]=PKW(P1,6), pw2); \
    VRD(3); SBAR(); GAPA(C0,MF(kf[6],qr[3],C0),   P1[10],P1[11],P1[12],P1[13], pw3[0]=PKW(P1,8), pw3[1]=PKW(P1,10), pw3); \
    VRD(7); SBAR(); GAPA(C1,MF(kf[7],qr[3],C1),   P1[14],P1[15],0.f,0.f,       pw3[2]=PKW(P1,12),pw3[3]=PKW(P1,14), pw3); \
    if constexpr(!ONES){ l_reg+=sacc; } \
    if constexpr(ATT_DMAPOS==0){ if(GK){DMA_K((t)+3,sc);} if(GV){DMA_V((t)+1,sn);} } \
    SBAR(); \
    if constexpr(DV==64 && !ONES){ \
      GAPB(o[0],MF(PAF(0),VFR(0),o[0]), C0,C1,0,4); \
      GAPB(o[1],MF(PAF(0),VFR(4),o[1]), C0,C1,4,4); \
      KRD(GL,0); GAPB(o[0],MF(PAF(1),VFR(1),o[0]), C0,C1,8,4); \
      KRD(GL,1); GAPB(o[1],MF(PAF(1),VFR(5),o[1]), C0,C1,12,4); \
      KRD(GL,2); GAPB(o[0],MF(PAF(2),VFR(2),o[0]), C0,C1,16,4); \
      KRD(GL,3); GAPB(o[1],MF(PAF(2),VFR(6),o[1]), C0,C1,20,4); \
      GAPB(o[0],MF(PAF(3),VFR(3),o[0]), C0,C1,24,4); \
      GAPB(o[1],MF(PAF(3),VFR(7),o[1]), C0,C1,28,4); \
    } else if constexpr(DV==64){ \
      GAPB(o[0],MF(PAF(0),VFR(0),o[0]), C0,C1,0,3); \
      GAPB(o[1],MF(PAF(0),VFR(4),o[1]), C0,C1,3,3); \
      KRD(GL,0); GAPB(o[0],MF(PAF(1),VFR(1),o[0]), C0,C1,6,3); \
      KRD(GL,1); GAPB(o[1],MF(PAF(1),VFR(5),o[1]), C0,C1,9,3); \
      KRD(GL,2); GAPB(o[0],MF(PAF(2),VFR(2),o[0]), C0,C1,12,3); \
      KRD(GL,3); GAPB(o[1],MF(PAF(2),VFR(6),o[1]), C0,C1,15,3); \
      GAPB(o[0],MF(PAF(3),VFR(3),o[0]), C0,C1,18,3); \
      GAPB(o[1],MF(PAF(3),VFR(7),o[1]), C0,C1,21,3); \
      GAPB(os,MF(PAF(0),ones,os), C0,C1,24,2); \
      GAPB(os,MF(PAF(1),ones,os), C0,C1,26,2); \
      GAPB(os,MF(PAF(2),ones,os), C0,C1,28,2); \
      GAPB(os,MF(PAF(3),ones,os), C0,C1,30,2); \
    } else { \
      GAPB(o[0],MF(PAF(0),VFR(0),o[0]), C0,C1,0,2);  VRD(8);  SBAR(); \
      GAPB(o[1],MF(PAF(0),VFR(4),o[1]), C0,C1,2,2);  VRD(12); SBAR(); \
      KRD(GL,0); GAPB(o[0],MF(PAF(1),VFR(1),o[0]), C0,C1,4,2);  VRD(9);  SBAR(); \
      KRD(GL,1); GAPB(o[1],MF(PAF(1),VFR(5),o[1]), C0,C1,6,2);  VRD(13); SBAR(); \
      KRD(GL,2); GAPB(o[0],MF(PAF(2),VFR(2),o[0]), C0,C1,8,2);  VRD(10); SBAR(); \
      KRD(GL,3); GAPB(o[1],MF(PAF(2),VFR(6),o[1]), C0,C1,10,2); VRD(14); SBAR(); \
      GAPB(o[0],MF(PAF(3),VFR(3),o[0]), C0,C1,12,2); VRD(11); SBAR(); \
      GAPB(o[1],MF(PAF(3),VFR(7),o[1]), C0,C1,14,2); VRD(15); SBAR(); \
      if constexpr(!ONES){ \
      GAPB(o[ND-2],MF(PAF(0),VFR(8 %(4*ND)),o[ND-2]),  C0,C1,16,2); \
      GAPB(o[ND-1],MF(PAF(0),VFR(12%(4*ND)),o[ND-1]), C0,C1,18,2); \
      GAPB(o[ND-2],MF(PAF(1),VFR(9 %(4*ND)),o[ND-2]),  C0,C1,20,2); \
      GAPB(o[ND-1],MF(PAF(1),VFR(13%(4*ND)),o[ND-1]), C0,C1,22,2); \
      GAPB(o[ND-2],MF(PAF(2),VFR(10%(4*ND)),o[ND-2]), C0,C1,24,2); \
      GAPB(o[ND-1],MF(PAF(2),VFR(14%(4*ND)),o[ND-1]), C0,C1,26,2); \
      GAPB(o[ND-2],MF(PAF(3),VFR(11%(4*ND)),o[ND-2]), C0,C1,28,2); \
      GAPB(o[ND-1],MF(PAF(3),VFR(15%(4*ND)),o[ND-1]), C0,C1,30,2); \
      } else { \
      GAPB(o[ND-2],MF(PAF(0),VFR(8 %(4*ND)),o[ND-2]),  C0,C1,16,1); \
      GAPB(o[ND-1],MF(PAF(0),VFR(12%(4*ND)),o[ND-1]), C0,C1,17,1); \
      GAPB(o[ND-2],MF(PAF(1),VFR(9 %(4*ND)),o[ND-2]),  C0,C1,18,1); \
      GAPB(o[ND-1],MF(PAF(1),VFR(13%(4*ND)),o[ND-1]), C0,C1,19,1); \
      GAPB(o[ND-2],MF(PAF(2),VFR(10%(4*ND)),o[ND-2]), C0,C1,20,1); \
      GAPB(o[ND-1],MF(PAF(2),VFR(14%(4*ND)),o[ND-1]), C0,C1,21,1); \
      GAPB(o[ND-2],MF(PAF(3),VFR(11%(4*ND)),o[ND-2]), C0,C1,22,1); \
      GAPB(o[ND-1],MF(PAF(3),VFR(15%(4*ND)),o[ND-1]), C0,C1,23,1); \
      GAPB(os,MF(PAF(0),ones,os), C0,C1,24,2); \
      GAPB(os,MF(PAF(1),ones,os), C0,C1,26,2); \
      GAPB(os,MF(PAF(2),ones,os), C0,C1,28,2); \
      GAPB(os,MF(PAF(3),ones,os), C0,C1,30,2); \
      } \
    } \
    if constexpr(ATT_DMAPOS==1){ SBAR(); if(GK){DMA_K((t)+3,sc);} if(GV){DMA_V((t)+1,sn);} } \
    }while(0)
  if(ATT_PRIO && wid>=4) __builtin_amdgcn_s_setprio(1);
  int t=1;
  for(;t+5<NT;t+=2){
    STEP(pB0,pB1,pA0,pA1,t,true,true,true);     WAITB_KV(); ROT();
    STEP(pA0,pA1,pB0,pB1,t+1,true,true,true);   WAITB_KV(); ROT();
  }
  #define ENDW(tt) do{ if((tt)+3<NT){WAITB_KV();} else if((tt)+2<NT){WAITB_V();} else {WAITB_0();} }while(0)
  for(;t+1<NT;t+=2){
    STEP(pB0,pB1,pA0,pA1,t,(t+3<NT),(t+1<NT),(t+1<NT));       ENDW(t);   ROT();
    STEP(pA0,pA1,pB0,pB1,t+1,(t+4<NT),(t+2<NT),(t+2<NT));     ENDW(t+1); ROT();
  }
  STEP(pB0,pB1,pA0,pA1,NT-1,false,false,false);
  { if constexpr(!ONES){ float sacc=pB0[0]+pB0[1]; _Pragma("unroll") for(int r=2;r<16;++r)sacc+=pB0[r]; _Pragma("unroll") for(int r=0;r<16;++r)sacc+=pB1[r]; l_reg+=sacc; }
    pw0=(u32x4){PKW(pB0,0),PKW(pB0,2),PKW(pB0,4),PKW(pB0,6)};pw1=(u32x4){PKW(pB0,8),PKW(pB0,10),PKW(pB0,12),PKW(pB0,14)};pw2=(u32x4){PKW(pB1,0),PKW(pB1,2),PKW(pB1,4),PKW(pB1,6)};pw3=(u32x4){PKW(pB1,8),PKW(pB1,10),PKW(pB1,12),PKW(pB1,14)};
    SBAR();
    const lds_cptr vp_=vp0+sc*VSLOT;
    #pragma unroll
    for(int d0=0;d0<ND;++d0){
      #pragma unroll
      for(int ks=0;ks<4;++ks){ const int i=(d0&1)*4+ks; vlo[i]=vtr(vp_+(d0*4096+ks*1024)); vhi[i]=vtr(vp_+(d0*4096+ks*1024+512)); }
      o[d0]=MF(PAF(0),VFR((d0&1)*4+0),o[d0]); o[d0]=MF(PAF(1),VFR((d0&1)*4+1),o[d0]); o[d0]=MF(PAF(2),VFR((d0&1)*4+2),o[d0]); o[d0]=MF(PAF(3),VFR((d0&1)*4+3),o[d0]); }
    if constexpr(ONES){ os=MF(PAF(0),ones,os); os=MF(PAF(1),ones,os); os=MF(PAF(2),ones,os); os=MF(PAF(3),ones,os); } }
  #undef PKW
  #undef PAF
  #undef VFR
  #undef PIN
  #undef MF
  #undef EX
  #undef EXQ
  #undef GAPA
  #undef GAPB
  #undef VRD
  #undef KRD
  #undef STEP
  #undef ENDW
  if(ATT_PRIO && wid>=4) __builtin_amdgcn_s_setprio(0);
  float rli[16];
  if constexpr(ONES){
    #pragma unroll
    for(int r=0;r<16;++r)rli[r]=__builtin_amdgcn_rcpf(os[r]);
  } else {
    {auto rr=__builtin_amdgcn_permlane32_swap(__float_as_uint(l_reg),__float_as_uint(l_reg),false,false);l_reg=__uint_as_float(rr[0])+__uint_as_float(rr[1]);}
    if(hi==0)wsf[32+r32]=l_reg;asm volatile("s_waitcnt lgkmcnt(0)":::"memory");
    #pragma unroll
    for(int r=0;r<16;++r)rli[r]=__builtin_amdgcn_rcpf(wsf[32+crow(r,hi)]);
  }
  if constexpr(O8!=0){ unsigned char*Ow8=(unsigned char*)Ou+(long)(wid*QBLK)*OP; unsigned char*stg8=(unsigned char*)(shm+L::OST)+wid*4096;
    #pragma unroll
    for(int hf=0;hf<NV;++hf){
      #pragma unroll
      for(int r=0;r<16;++r){const int orow=crow(r,hi);
        #pragma unroll
        for(int d0=0;d0<2;++d0){ const float v=__builtin_amdgcn_fmed3f(o[2*hf+d0][r]*rli[r]*YA8_SCALE,-448.0f,448.0f); stg8[orow*64+d0*32+r32]=(unsigned char)__builtin_amdgcn_cvt_pk_fp8_f32(v,v,0,false); } }
      asm volatile("s_waitcnt lgkmcnt(0)":::"memory");
      #pragma unroll
      for(int i=0;i<2;++i){const int row=i*16+(lane>>2),ch=lane&3; const u32x4 v=*(const u32x4*)(stg8+row*64+ch*16); *(u32x4*)(Ow8+(long)row*OP+hf*64+ch*16)=v;}
      asm volatile("s_waitcnt lgkmcnt(0)":::"memory");
    } } else {
  bf16*Ow=Ou+(long)(wid*QBLK)*OP;
  { bf16*stg=(bf16*)(shm+L::OST)+wid*2048;
    #pragma unroll
    for(int hf=0;hf<NV;++hf){
      #pragma unroll
      for(int r=0;r<16;++r){const int orow=crow(r,hi);
        #pragma unroll
        for(int d0=0;d0<2;++d0)stg[orow*64+d0*32+r32]=__float2bfloat16(o[2*hf+d0][r]*rli[r]);}
      asm volatile("s_waitcnt lgkmcnt(0)":::"memory");
      #pragma unroll
      for(int i=0;i<4;++i){const int row=i*8+(lane>>3),ch=lane&7; const u32x4 v=*(const u32x4*)(stg+row*64+ch*8); *(u32x4*)(Ow+(long)row*OP+hf*64+ch*8)=v;}
      asm volatile("s_waitcnt lgkmcnt(0)":::"memory");
    } } }
  asm volatile("s_waitcnt lgkmcnt(0)\n\ts_barrier":::"memory");
  #undef DMA_K
  #undef DMA_V
  #undef WAITB_KV
  #undef WAITB_V
  #undef WAITB_0
  #undef ROT
}

template<int DV> struct Lds3 { static constexpr int NS=4, VSLOT=DV*128, K=0, V=NS*SLOTB, WS=V+NS*VSLOT, OST=WS+NW*64*4, BYTES=OST+NW*4096; };
template<int HALF_,int DV,bool ONES,int NT,int QP,int KP,int VP,int OP> __device__ __forceinline__ void attn_unit3h(const bf16*Qu,const bf16*__restrict__ Kb,const bf16*__restrict__ Vb,bf16*Ou,char*shm){
  typedef Lds3<DV> L; constexpr int ND=DV/32, NV=DV/64, VSLOT=L::VSLOT;
  const int tid=threadIdx.x,lane=tid&63,r32=lane&31,hi=lane>>5; const int wid=__builtin_amdgcn_readfirstlane(tid>>6);
  const bf16*Qw=Qu+(long)(wid*QBLK)*QP;
  const unsigned lds0=(unsigned)(uintptr_t)shm;
  float*wsf=(float*)(shm+L::WS)+wid*64;
  const bf16*ksrc=Kb+(long)lane*KP+wid*8;
  const bf16*vsrc=Vb+(long)(16*(wid&3)+(lane>>2))*VP+(wid>>2)*32+(lane&3)*8;
  const unsigned kdst=lds0+L::K+wid*1024, vdst=lds0+L::V+wid*1024;
  #define DMA_K(t,slot) glds16(ksrc+(long)(t)*KVBLK*KP,(unsigned)__builtin_amdgcn_readfirstlane(kdst+(slot)*SLOTB))
  #define DMA_V(t,slot) do{ _Pragma("unroll") for(int q_=0;q_<NV;++q_) glds16(vsrc+(long)(t)*KVBLK*VP+q_*64,(unsigned)__builtin_amdgcn_readfirstlane(vdst+(slot)*VSLOT+q_*8192)); }while(0)
  #define WAITB_KV() do{ if constexpr(NV==1) asm volatile("s_waitcnt vmcnt(2) lgkmcnt(0)\n\ts_barrier":::"memory"); else asm volatile("s_waitcnt vmcnt(3) lgkmcnt(0)\n\ts_barrier":::"memory"); }while(0)
  #define WAITB_V()  do{ if constexpr(NV==1) asm volatile("s_waitcnt vmcnt(1) lgkmcnt(0)\n\ts_barrier":::"memory"); else asm volatile("s_waitcnt vmcnt(2) lgkmcnt(0)\n\ts_barrier":::"memory"); }while(0)
  #define WAITB_0()  asm volatile("s_waitcnt vmcnt(0) lgkmcnt(0)\n\ts_barrier":::"memory")
  const char*Kbase=shm+L::K; bf16x8 kf[8];
  const lds_cptr shm3=(lds_cptr)shm; const lds_cptr kp0=shm3+L::K+hi*1024+r32*16; const lds_cptr vp0=shm3+L::V+((lane>>4)&1)*32+(lane&3)*8+(4*hi+((lane&15)>>2))*64;
  DMA_K(0,0);DMA_V(0,0);DMA_K(1,1);
  bf16x8 qr[4];
  #pragma unroll
  for(int d0=0;d0<4;++d0)qr[d0]=*reinterpret_cast<const bf16x8*>(&Qw[(long)r32*QP+d0*16+hi*8]);
  float l_reg=0.f; f32x16 o[ND]; f32x16 os=f32x16{};
  #pragma unroll
  for(int d_=0;d_<ND;++d_)o[d_]=f32x16{};
  const f32x16 zero16=f32x16{};
  const bf16x8 ones={(short)0x3F80,(short)0x3F80,(short)0x3F80,(short)0x3F80,(short)0x3F80,(short)0x3F80,(short)0x3F80,(short)0x3F80};
  f32x16 pA0,pA1,pB0,pB1;
  DMA_K(2,2);
  asm volatile("s_waitcnt vmcnt(3) lgkmcnt(0)\n\ts_barrier":::"memory");
  qkt(pA0,pA1,Kbase,qr,zero16,r32,hi);asm volatile("s_nop 15\n\ts_nop 7":"+v"(pA0),"+v"(pA1));
  _Pragma("unroll") for(int r=0;r<16;++r){pA0[r]=__builtin_amdgcn_exp2f(pA0[r]);pA1[r]=__builtin_amdgcn_exp2f(pA1[r]);}
  WAITB_0();
  DMA_K(3,3);DMA_V(1,1);
  kload8(kf,kp0+1*SLOTB);
  s16x4 vlo[4*ND],vhi[4*ND]; u32x4 pw0,pw1,pw2,pw3;
  #define PKW(P,B) cvtpk_s(P[B],P[B+1])
  #define PAF(k) __builtin_bit_cast(bf16x8,pw##k)
  #define VFR(i) (bf16x8){vlo[i][0],vlo[i][1],vlo[i][2],vlo[i][3],vhi[i][0],vhi[i][1],vhi[i][2],vhi[i][3]}
  #define PIN(x) asm volatile("":"+v"(x))
  #define MF(a,b,c) __builtin_amdgcn_mfma_f32_32x32x16_bf16(a,b,c,0,0,0)
  #define EX(v) __builtin_amdgcn_exp2f(v)
  #define EXQ(C0,C1,e) do{ if((e)<16) C0[(e)&15]=EX(C0[(e)&15]); else C1[(e)&15]=EX(C1[(e)&15]); }while(0)
  #define VRD(VP_,i) do{ vlo[i]=vtr(VP_+(((i)>>2)*4096+((i)&3)*1024)); vhi[i]=vtr(VP_+(((i)>>2)*4096+((i)&3)*1024+512)); }while(0)
  #define KRD(G,KP_,j) do{ if(G){ kload2(kf,KP_,j); SBAR(); } }while(0)
  #define GAPA(DST,MFX,A0,A1,A2,A3,W0,W1,PW) do{ DST=MFX; PIN(DST); if constexpr(!ONES){ sacc+=A0; sacc+=A1; sacc+=A2; sacc+=A3; PIN(sacc); } W0; W1; PIN(PW); SBAR(); }while(0)
  #define GAPB(DST,MFX,C0,C1,e0,NE) do{ DST=MFX; PIN(DST); _Pragma("unroll") for(int e_=0;e_<(NE);++e_) EXQ(C0,C1,(e0)+e_); PIN(C0); PIN(C1); SBAR(); }while(0)
  #define PH_A(C0,C1,P0,P1,VS) do{ SBAR(); \
    const lds_cptr vp_=vp0+(VS)*VSLOT; \
    VRD(vp_,0); SBAR(); float sacc=0.f; if constexpr(!ONES){ sacc=(P0[0]+P0[1]); } \
    GAPA(C0,MF(kf[0],qr[0],zero16), P0[2],P0[3],P0[4],P0[5],     pw0[0]=PKW(P0,0), pw0[1]=PKW(P0,2), pw0); \
    VRD(vp_,4); SBAR(); GAPA(C1,MF(kf[1],qr[0],zero16), P0[6],P0[7],P0[8],P0[9],     pw0[2]=PKW(P0,4), pw0[3]=PKW(P0,6), pw0); \
    VRD(vp_,1); SBAR(); GAPA(C0,MF(kf[2],qr[1],C0),   P0[10],P0[11],P0[12],P0[13], pw1[0]=PKW(P0,8), pw1[1]=PKW(P0,10), pw1); \
    VRD(vp_,5); SBAR(); GAPA(C1,MF(kf[3],qr[1],C1),   P0[14],P0[15],P1[0],P1[1],   pw1[2]=PKW(P0,12),pw1[3]=PKW(P0,14), pw1); \
    VRD(vp_,2); SBAR(); GAPA(C0,MF(kf[4],qr[2],C0),   P1[2],P1[3],P1[4],P1[5],     pw2[0]=PKW(P1,0), pw2[1]=PKW(P1,2), pw2); \
    VRD(vp_,6); SBAR(); GAPA(C1,MF(kf[5],qr[2],C1),   P1[6],P1[7],P1[8],P1[9],     pw2[2]=PKW(P1,4), pw2[3]=PKW(P1,6), pw2); \
    VRD(vp_,3); SBAR(); GAPA(C0,MF(kf[6],qr[3],C0),   P1[10],P1[11],P1[12],P1[13], pw3[0]=PKW(P1,8), pw3[1]=PKW(P1,10), pw3); \
    VRD(vp_,7); SBAR(); GAPA(C1,MF(kf[7],qr[3],C1),   P1[14],P1[15],0.f,0.f,       pw3[2]=PKW(P1,12),pw3[3]=PKW(P1,14), pw3); \
    if constexpr(!ONES){ l_reg+=sacc; } SBAR(); }while(0)
  #define PH_B(C0,C1,KS,VS2,GL) do{ SBAR(); \
    const lds_cptr kq_=kp0+(KS)*SLOTB; const lds_cptr vq_=vp0+(VS2)*VSLOT; (void)vq_; \
    if constexpr(DV==64 && !ONES){ \
      GAPB(o[0],MF(PAF(0),VFR(0),o[0]), C0,C1,0,4); \
      GAPB(o[1],MF(PAF(0),VFR(4),o[1]), C0,C1,4,4); \
      KRD(GL,kq_,0); GAPB(o[0],MF(PAF(1),VFR(1),o[0]), C0,C1,8,4); \
      KRD(GL,kq_,1); GAPB(o[1],MF(PAF(1),VFR(5),o[1]), C0,C1,12,4); \
      KRD(GL,kq_,2); GAPB(o[0],MF(PAF(2),VFR(2),o[0]), C0,C1,16,4); \
      KRD(GL,kq_,3); GAPB(o[1],MF(PAF(2),VFR(6),o[1]), C0,C1,20,4); \
      GAPB(o[0],MF(PAF(3),VFR(3),o[0]), C0,C1,24,4); \
      GAPB(o[1],MF(PAF(3),VFR(7),o[1]), C0,C1,28,4); \
    } else if constexpr(DV==64){ \
      GAPB(o[0],MF(PAF(0),VFR(0),o[0]), C0,C1,0,3); \
      GAPB(o[1],MF(PAF(0),VFR(4),o[1]), C0,C1,3,3); \
      KRD(GL,kq_,0); GAPB(o[0],MF(PAF(1),VFR(1),o[0]), C0,C1,6,3); \
      KRD(GL,kq_,1); GAPB(o[1],MF(PAF(1),VFR(5),o[1]), C0,C1,9,3); \
      KRD(GL,kq_,2); GAPB(o[0],MF(PAF(2),VFR(2),o[0]), C0,C1,12,3); \
      KRD(GL,kq_,3); GAPB(o[1],MF(PAF(2),VFR(6),o[1]), C0,C1,15,3); \
      GAPB(o[0],MF(PAF(3),VFR(3),o[0]), C0,C1,18,3); \
      GAPB(o[1],MF(PAF(3),VFR(7),o[1]), C0,C1,21,3); \
      GAPB(os,MF(PAF(0),ones,os), C0,C1,24,2); \
      GAPB(os,MF(PAF(1),ones,os), C0,C1,26,2); \
      GAPB(os,MF(PAF(2),ones,os), C0,C1,28,2); \
      GAPB(os,MF(PAF(3),ones,os), C0,C1,30,2); \
    } else { \
      GAPB(o[0],MF(PAF(0),VFR(0),o[0]), C0,C1,0,2);  VRD(vq_,8%(4*ND));  SBAR(); \
      GAPB(o[1],MF(PAF(0),VFR(4),o[1]), C0,C1,2,2);  VRD(vq_,12%(4*ND)); SBAR(); \
      KRD(GL,kq_,0); GAPB(o[0],MF(PAF(1),VFR(1),o[0]), C0,C1,4,2);  VRD(vq_,9%(4*ND));  SBAR(); \
      KRD(GL,kq_,1); GAPB(o[1],MF(PAF(1),VFR(5),o[1]), C0,C1,6,2);  VRD(vq_,13%(4*ND)); SBAR(); \
      KRD(GL,kq_,2); GAPB(o[0],MF(PAF(2),VFR(2),o[0]), C0,C1,8,2);  VRD(vq_,10%(4*ND)); SBAR(); \
      KRD(GL,kq_,3); GAPB(o[1],MF(PAF(2),VFR(6),o[1]), C0,C1,10,2); VRD(vq_,14%(4*ND)); SBAR(); \
      GAPB(o[0],MF(PAF(3),VFR(3),o[0]), C0,C1,12,2); VRD(vq_,11%(4*ND)); SBAR(); \
      GAPB(o[1],MF(PAF(3),VFR(7),o[1]), C0,C1,14,2); VRD(vq_,15%(4*ND)); SBAR(); \
      GAPB(o[ND-2],MF(PAF(0),VFR(8 %(4*ND)),o[ND-2]),  C0,C1,16,2); \
      GAPB(o[ND-1],MF(PAF(0),VFR(12%(4*ND)),o[ND-1]), C0,C1,18,2); \
      GAPB(o[ND-2],MF(PAF(1),VFR(9 %(4*ND)),o[ND-2]),  C0,C1,20,2); \
      GAPB(o[ND-1],MF(PAF(1),VFR(13%(4*ND)),o[ND-1]), C0,C1,22,2); \
      GAPB(o[ND-2],MF(PAF(2),VFR(10%(4*ND)),o[ND-2]), C0,C1,24,2); \
      GAPB(o[ND-1],MF(PAF(2),VFR(14%(4*ND)),o[ND-1]), C0,C1,26,2); \
      GAPB(o[ND-2],MF(PAF(3),VFR(11%(4*ND)),o[ND-2]), C0,C1,28,2); \
      GAPB(o[ND-1],MF(PAF(3),VFR(15%(4*ND)),o[ND-1]), C0,C1,30,2); \
    } }while(0)
  #define DMAS(t,GK,GV) do{ if(GK){DMA_K((t)+3,((t)+3)&3);} if(GV){DMA_V((t)+1,((t)+1)&3);} }while(0)
  #define ENDW(tt) do{ if((tt)+3<NT){WAITB_KV();} else if((tt)+2<NT){WAITB_V();} else {WAITB_0();} }while(0)
  #define S0_ODD(t,GK,GV,GL)  do{ PH_A(pB0,pB1,pA0,pA1,((t)-1)&3); DMAS(t,GK,GV); PH_B(pB0,pB1,((t)+1)&3,((t)-1)&3,GL); }while(0)
  #define S0_EVEN(t,GK,GV,GL) do{ PH_A(pA0,pA1,pB0,pB1,((t)-1)&3); DMAS(t,GK,GV); PH_B(pA0,pA1,((t)+1)&3,((t)-1)&3,GL); }while(0)
  #define S1_EVEN(t,GK,GV)    do{ PH_B(pB0,pB1,(t)&3,((t)-2)&3,true); DMAS(t,GK,GV); PH_A(pA0,pA1,pB0,pB1,((t)-1)&3); }while(0)
  #define S1_ODD(t,GK,GV)     do{ PH_B(pA0,pA1,(t)&3,((t)-2)&3,true); DMAS(t,GK,GV); PH_A(pB0,pB1,pA0,pA1,((t)-1)&3); }while(0)
  if constexpr(HALF_==0){
    int t=1;
    for(;t+5<NT;t+=2){ S0_ODD(t,true,true,true); WAITB_KV(); S0_EVEN(t+1,true,true,true); WAITB_KV(); }
    for(;t+1<NT;t+=2){ S0_ODD(t,(t+3<NT),(t+1<NT),(t+1<NT)); ENDW(t); S0_EVEN(t+1,(t+4<NT),(t+2<NT),(t+2<NT)); ENDW(t+1); }
    S0_ODD(NT-1,false,false,false);
  } else {
    DMAS(1,true,true); PH_A(pB0,pB1,pA0,pA1,0); WAITB_KV();
    int t=2;
    for(;t+4<NT;t+=2){ S1_EVEN(t,true,true); WAITB_KV(); S1_ODD(t+1,true,true); WAITB_KV(); }
    for(;t+2<NT;t+=2){ S1_EVEN(t,(t+3<NT),(t+1<NT)); ENDW(t); S1_ODD(t+1,(t+4<NT),(t+2<NT)); ENDW(t+1); }
    S1_EVEN(NT-2,false,true); ENDW(NT-2);
    S1_ODD(NT-1,false,false);
    PH_B(pB0,pB1,0,(NT-2)&3,false);
  }
  { if constexpr(!ONES){ float sacc=pB0[0]+pB0[1]; _Pragma("unroll") for(int r=2;r<16;++r)sacc+=pB0[r]; _Pragma("unroll") for(int r=0;r<16;++r)sacc+=pB1[r]; l_reg+=sacc; }
    pw0=(u32x4){PKW(pB0,0),PKW(pB0,2),PKW(pB0,4),PKW(pB0,6)};pw1=(u32x4){PKW(pB0,8),PKW(pB0,10),PKW(pB0,12),PKW(pB0,14)};pw2=(u32x4){PKW(pB1,0),PKW(pB1,2),PKW(pB1,4),PKW(pB1,6)};pw3=(u32x4){PKW(pB1,8),PKW(pB1,10),PKW(pB1,12),PKW(pB1,14)};
    SBAR();
    const lds_cptr vp_=vp0+((NT-1)&3)*VSLOT;
    #pragma unroll
    for(int d0=0;d0<ND;++d0){
      #pragma unroll
      for(int ks=0;ks<4;++ks){ const int i=(d0&1)*4+ks; vlo[i]=vtr(vp_+(d0*4096+ks*1024)); vhi[i]=vtr(vp_+(d0*4096+ks*1024+512)); }
      o[d0]=MF(PAF(0),VFR((d0&1)*4+0),o[d0]); o[d0]=MF(PAF(1),VFR((d0&1)*4+1),o[d0]); o[d0]=MF(PAF(2),VFR((d0&1)*4+2),o[d0]); o[d0]=MF(PAF(3),VFR((d0&1)*4+3),o[d0]); }
    if constexpr(ONES){ os=MF(PAF(0),ones,os); os=MF(PAF(1),ones,os); os=MF(PAF(2),ones,os); os=MF(PAF(3),ones,os); } }
  #undef PKW
  #undef PAF
  #undef VFR
  #undef PIN
  #undef MF
  #undef EX
  #undef EXQ
  #undef GAPA
  #undef GAPB
  #undef VRD
  #undef KRD
  #undef PH_A
  #undef PH_B
  #undef DMAS
  #undef ENDW
  #undef S0_ODD
  #undef S0_EVEN
  #undef S1_ODD
  #undef S1_EVEN
  float rli[16];
  if constexpr(ONES){
    #pragma unroll
    for(int r=0;r<16;++r)rli[r]=__builtin_amdgcn_rcpf(os[r]);
  } else {
    {auto rr=__builtin_amdgcn_permlane32_swap(__float_as_uint(l_reg),__float_as_uint(l_reg),false,false);l_reg=__uint_as_float(rr[0])+__uint_as_float(rr[1]);}
    if(hi==0)wsf[32+r32]=l_reg;asm volatile("s_waitcnt lgkmcnt(0)":::"memory");
    #pragma unroll
    for(int r=0;r<16;++r)rli[r]=__builtin_amdgcn_rcpf(wsf[32+crow(r,hi)]);
  }
  bf16*Ow=Ou+(long)(wid*QBLK)*OP;
  { bf16*stg=(bf16*)(shm+L::OST)+wid*2048;
    #pragma unroll
    for(int hf=0;hf<NV;++hf){
      #pragma unroll
      for(int r=0;r<16;++r){const int orow=crow(r,hi);
        #pragma unroll
        for(int d0=0;d0<2;++d0)stg[orow*64+d0*32+r32]=__float2bfloat16(o[2*hf+d0][r]*rli[r]);}
      asm volatile("s_waitcnt lgkmcnt(0)":::"memory");
      #pragma unroll
      for(int i=0;i<4;++i){const int row=i*8+(lane>>3),ch=lane&7; const u32x4 v=*(const u32x4*)(stg+row*64+ch*8); *(u32x4*)(Ow+(long)row*OP+hf*64+ch*8)=v;}
      asm volatile("s_waitcnt lgkmcnt(0)":::"memory");
    } }
  asm volatile("s_waitcnt lgkmcnt(0)\n\ts_barrier":::"memory");
  #undef DMA_K
  #undef DMA_V
  #undef WAITB_KV
  #undef WAITB_V
  #undef WAITB_0
}
template<int DV,bool ONES,int NT,int QP,int KP,int VP,int OP> __device__ __forceinline__ void attn_unit3(const bf16*Qu,const bf16*__restrict__ Kb,const bf16*__restrict__ Vb,bf16*Ou,char*shm){
  if(__builtin_amdgcn_readfirstlane(threadIdx.x>>6)<4) attn_unit3h<0,DV,ONES,NT,QP,KP,VP,OP>(Qu,Kb,Vb,Ou,shm); else attn_unit3h<1,DV,ONES,NT,QP,KP,VP,OP>(Qu,Kb,Vb,Ou,shm);
}

typedef int i32x4_t __attribute__((ext_vector_type(4)));
typedef int i32x8_t __attribute__((ext_vector_type(8)));
typedef __attribute__((address_space(3))) const i32x4_t* lds_i4p;
template<int DV> struct Lds8 { static constexpr int KSLOT=4096, VSLOT=DV*64, K=0, V=NSLOT*KSLOT, WS=V+NSLOT*VSLOT, OST=WS+NW*64*4, BYTES=OST+NW*4096; };
__device__ __forceinline__ void glds16s(const void*sbase,unsigned voff,unsigned lds_dst){unsigned keep;
  asm volatile("s_mov_b32 %0, m0\n\ts_mov_b32 m0, %3\n\ts_nop 0\n\tglobal_load_lds_dwordx4 %1, %2\n\ts_mov_b32 m0, %0":"=&s"(keep):"v"(voff),"s"(sbase),"s"(lds_dst):"memory");}
__device__ __forceinline__ void glds16s2(const void*sb0,unsigned vo0,unsigned ld0,const void*sb1,unsigned vo1,unsigned ld1){unsigned keep;
  asm volatile("s_mov_b32 %0, m0\n\ts_mov_b32 m0, %3\n\ts_nop 0\n\tglobal_load_lds_dwordx4 %1, %2\n\ts_mov_b32 m0, %6\n\ts_nop 0\n\tglobal_load_lds_dwordx4 %4, %5\n\ts_mov_b32 m0, %0"
    :"=&s"(keep):"v"(vo0),"s"(sb0),"s"(ld0),"v"(vo1),"s"(sb1),"s"(ld1):"memory");}
__device__ __forceinline__ unsigned pk4c(float a,float b,float c,float d,unsigned old){ int r=__builtin_amdgcn_cvt_pk_fp8_f32(a,b,(int)old,false); r=__builtin_amdgcn_cvt_pk_fp8_f32(c,d,r,true); return (unsigned)r; }
template<int DV,bool ONES,int NT,int QP,int KP,int OP,int O8,int ABL=0> __device__ __forceinline__ void attn_unit8(const unsigned char*Q8u,const unsigned char*__restrict__ K8b,const unsigned char*__restrict__ VTb,bf16*Ou,char*shm){
  typedef Lds8<DV> L; constexpr int ND=DV/32, NV=DV/64, VSLOT=L::VSLOT, KSLOT=L::KSLOT;
  const int tid=threadIdx.x,lane=tid&63,r32=lane&31,hi=lane>>5; const int wid=__builtin_amdgcn_readfirstlane(tid>>6);
  const unsigned lds0=(unsigned)(uintptr_t)shm;
  const unsigned koff=(unsigned)((32*(wid&1)+r32)*KP+16*(wid>>1));
  const int pv=(DV==64)?32*wid+r32:64*wid+lane;
  const unsigned voff=(unsigned)((pv&(DV-1))*64+16*(pv/DV));
  const unsigned kdst=(unsigned)__builtin_amdgcn_readfirstlane(lds0+L::K+wid*512), vdst=(unsigned)__builtin_amdgcn_readfirstlane(lds0+L::V+wid*(DV==64?512:1024));
  #define RFL(x) ((unsigned)__builtin_amdgcn_readfirstlane((int)(x)))
  #define DMA_K(t,slot) do{ const unsigned kd_=RFL(kdst+(slot)*KSLOT); if(hi==0){ glds16s(K8b+(long)(t)*KVBLK*KP,koff,kd_); } }while(0)
  #define DMA_V(t,slot) do{ const unsigned vd_=RFL(vdst+(slot)*VSLOT); if(DV==128||hi==0){ glds16s(VTb+(long)(t)*VSLOT,voff,vd_); } }while(0)
  #define DMA_KV(tk,ks,tv,vs) do{ if constexpr(DV==64){ const unsigned kd_=RFL(kdst+(ks)*KSLOT), vd_=RFL(vdst+(vs)*VSLOT); if(hi==0){ glds16s2(K8b+(long)(tk)*KVBLK*KP,koff,kd_,VTb+(long)(tv)*VSLOT,voff,vd_); } } else { DMA_K(tk,ks); DMA_V(tv,vs); } }while(0)
  #define WAITB_KV() do{ if constexpr(ABL&4) asm volatile("s_waitcnt lgkmcnt(0)":::"memory"); else asm volatile("s_waitcnt vmcnt(2) lgkmcnt(0)\n\ts_barrier":::"memory"); }while(0)
  #define WAITB_V()  asm volatile("s_waitcnt vmcnt(1) lgkmcnt(0)\n\ts_barrier":::"memory")
  #define WAITB_0()  asm volatile("s_waitcnt vmcnt(0) lgkmcnt(0)\n\ts_barrier":::"memory")
  const lds_cptr shm3=(lds_cptr)shm; const lds_cptr kp0=shm3+L::K+(2*hi)*1024+r32*16; const lds_cptr vp0=shm3+L::V+(2*hi)*(DV*16)+r32*16;
  i32x8_t kf[2], vf[ND], q8, pw8={0,0,0,0,0,0,0,0};
  #define KLD(slot) do{ const lds_cptr kp_=kp0+(slot)*KSLOT; _Pragma("unroll") for(int b_=0;b_<2;++b_){ kf[b_].lo=*(lds_i4p)(kp_+b_*512); kf[b_].hi=*(lds_i4p)(kp_+1024+b_*512); } }while(0)
  #define VLD(slot) do{ const lds_cptr vp_=vp0+(slot)*VSLOT; _Pragma("unroll") for(int d_=0;d_<ND;++d_){ vf[d_].lo=*(lds_i4p)(vp_+d_*512); vf[d_].hi=*(lds_i4p)(vp_+DV*16+d_*512); } }while(0)
  DMA_K(0,0);DMA_V(0,0);DMA_K(1,1);
  { const unsigned char*qp=Q8u+(long)(wid*QBLK+r32)*QP+32*hi; q8.lo=*(const i32x4_t*)qp; q8.hi=*(const i32x4_t*)(qp+16); }
  f32x16 o[ND]; f32x16 os=f32x16{}; float l_reg=0.f; float*wsf=(float*)(shm+L::WS)+wid*64;
  #pragma unroll
  for(int d_=0;d_<ND;++d_)o[d_]=f32x16{};
  i32x8_t ones8={0x38383838,0x38383838,0x38383838,0x38383838,0x38383838,0x38383838,0x38383838,0x38383838};
  if constexpr(DV==64||ONES8_PIN_B){ int one_=0x38383838; asm volatile("":"+s"(one_)); ones8=(i32x8_t){one_,one_,one_,one_,one_,one_,one_,one_}; asm volatile("":"+v"(ones8)); }
  f32x16 c0,c1;
  i32x8_t pwB={0,0,0,0,0,0,0,0};
  int sp=0,sc=0,sn=1;
  #define ROT() do{sp=sc;sc=sn;sn=(sn==NSLOT-1)?0:sn+1;}while(0)
  #define MFZ(D,A_,B_) do{ if constexpr(ABL&2){ asm volatile("":"=v"(D):"v"(A_),"v"(B_)); } else asm volatile("v_mfma_f32_32x32x64_f8f6f4 %0, %1, %2, -4.0":"=&v"(D):"v"(A_),"v"(B_)); }while(0)
  #define MFA(D,A_,B_) do{ if constexpr(ABL&2){ asm volatile("":"+v"(D):"v"(A_),"v"(B_)); } else asm volatile("v_mfma_f32_32x32x64_f8f6f4 %0, %1, %2, %0":"+v"(D):"v"(A_),"v"(B_)); }while(0)
  #define MFAO(D,A_,B_) do{ if constexpr(ABL&2){ asm volatile("":"+v"(D):"v"(A_),"v"(B_)); } else asm volatile("s_nop 1\n\tv_mfma_f32_32x32x64_f8f6f4 %0, %1, %2, %0":"+v"(D):"v"(A_),"v"(B_)); }while(0)
  #define EXR(C,lo_,n_) do{ if constexpr(!(ABL&1)){ _Pragma("unroll") for(int e_=(lo_);e_<(lo_)+(n_);++e_) C[e_]=__builtin_amdgcn_exp2f(C[e_]); } asm volatile("":"+v"(C)); }while(0)
  #define PACK(P,W,base) do{ if constexpr(!(ABL&8)){ _Pragma("unroll") for(int j_=0;j_<4;++j_) W[(base)+j_]=(int)pk4c(P[4*j_],P[4*j_+1],P[4*j_+2],P[4*j_+3],(unsigned)W[(base)+j_]); } asm volatile("":"+v"(W)); \
    if constexpr(!ONES){ float s_=(P[0]+P[1])+(P[2]+P[3]); _Pragma("unroll") for(int j_=1;j_<4;++j_) s_+=(P[4*j_]+P[4*j_+1])+(P[4*j_+2]+P[4*j_+3]); l_reg+=s_; asm volatile("":"+v"(l_reg)); } }while(0)
  DMA_K(2,2);
  asm volatile("s_waitcnt vmcnt(3) lgkmcnt(0)\n\ts_barrier":::"memory");
  KLD(0);
  MFZ(c0,kf[0],q8); MFZ(c1,kf[1],q8);
  asm volatile("s_nop 15\n\ts_nop 15":"+v"(c0),"+v"(c1));
  EXR(c0,0,16); EXR(c1,0,16); PACK(c0,pw8,0); PACK(c1,pw8,4);
  WAITB_0();
  DMA_K(3,0);DMA_V(1,1);
  ROT();
  KLD(sc);
  WAITB_KV();
  #define STEP9(WP,WN,t,GK,GV,GL) do{ SBAR(); \
    VLD(sp); SBAR(); \
    MFZ(c0,kf[0],q8); SBAR(); \
    if((GK)&&(GV)){ DMA_KV((t)+3,sc,(t)+1,sn); } else { if(GK){DMA_K((t)+3,sc);} if(GV){DMA_V((t)+1,sn);} } SBAR(); \
    MFZ(c1,kf[1],q8); SBAR(); \
    if(GL){KLD(sn);} SBAR(); \
    MFA(o[0],WP,vf[0]); SBAR(); \
    if constexpr(ND==2){ \
      EXR(c0,0,16); PACK(c0,WN,0); SBAR(); \
      MFA(o[1],WP,vf[1]); SBAR(); EXR(c1,0,8); SBAR(); \
      if constexpr(ONES){ MFAO(os,WP,ones8); SBAR(); } EXR(c1,8,8); PACK(c1,WN,4); SBAR(); \
    } else { \
      EXR(c0,0,10); SBAR(); \
      MFA(o[1],WP,vf[1]); SBAR(); EXR(c0,10,6); PACK(c0,WN,0); SBAR(); \
      MFA(o[ND-2],WP,vf[ND-2]); SBAR(); EXR(c1,0,8); SBAR(); \
      MFA(o[ND-1],WP,vf[ND-1]); SBAR(); EXR(c1,8,4); SBAR(); \
      if constexpr(ONES){ MFAO(os,WP,ones8); SBAR(); } EXR(c1,12,4); PACK(c1,WN,4); SBAR(); \
    } }while(0)
  if(ATT_PRIO && wid>=4) __builtin_amdgcn_s_setprio(1);
  int t=1;
  for(;t+5<NT;t+=2){
    STEP9(pw8,pwB,t,true,true,true);     WAITB_KV(); ROT();
    STEP9(pwB,pw8,t+1,true,true,true);   WAITB_KV(); ROT();
  }
  #define ENDW(tt) do{ if((tt)+3<NT){WAITB_KV();} else if((tt)+2<NT){WAITB_V();} else {WAITB_0();} }while(0)
  for(;t+1<NT;t+=2){
    STEP9(pw8,pwB,t,(t+3<NT),(t+1<NT),(t+1<NT));       ENDW(t);   ROT();
    STEP9(pwB,pw8,t+1,(t+4<NT),(t+2<NT),(t+2<NT));     ENDW(t+1); ROT();
  }
  STEP9(pw8,pwB,NT-1,false,false,false);
  if(ATT_PRIO && wid>=4) __builtin_amdgcn_s_setprio(0);
  { VLD(sc); SBAR();
    #pragma unroll
    for(int d_=0;d_<ND;++d_) MFA(o[d_],pwB,vf[d_]);
    if constexpr(ONES){ MFAO(os,pwB,ones8); asm volatile("s_nop 15\n\ts_nop 15":"+v"(os)); }
    else { asm volatile("s_nop 15\n\ts_nop 15":"+v"(o[ND-1])); } }
  #undef STEP9
  #undef ENDW
  #undef MFZ
  #undef MFA
  #undef MFAO
  #undef EXR
  #undef PACK
  #undef KLD
  #undef VLD
  float rli[16];
  if constexpr(ONES){
    #pragma unroll
    for(int r=0;r<16;++r)rli[r]=__builtin_amdgcn_rcpf(os[r]);
  } else {
    {auto rr=__builtin_amdgcn_permlane32_swap(__float_as_uint(l_reg),__float_as_uint(l_reg),false,false);l_reg=__uint_as_float(rr[0])+__uint_as_float(rr[1]);}
    if(hi==0)wsf[32+r32]=l_reg;asm volatile("s_waitcnt lgkmcnt(0)":::"memory");
    #pragma unroll
    for(int r=0;r<16;++r)rli[r]=__builtin_amdgcn_rcpf(wsf[32+crow(r,hi)]);
  }
  if constexpr(O8!=0){ unsigned char*Ow8=(unsigned char*)Ou+(long)(wid*QBLK)*OP; unsigned char*stg8=(unsigned char*)(shm+L::OST)+wid*4096;
    #pragma unroll
    for(int hf=0;hf<NV;++hf){
      #pragma unroll
      for(int r=0;r<16;++r){const int orow=crow(r,hi);
        #pragma unroll
        for(int d0=0;d0<2;++d0){ const float v=__builtin_amdgcn_fmed3f(o[2*hf+d0][r]*rli[r]*YA8_SCALE,-448.0f,448.0f); stg8[orow*64+d0*32+r32]=(unsigned char)__builtin_amdgcn_cvt_pk_fp8_f32(v,v,0,false); } }
      asm volatile("s_waitcnt lgkmcnt(0)":::"memory");
      #pragma unroll
      for(int i=0;i<2;++i){const int row=i*16+(lane>>2),ch=lane&3; const u32x4 v=*(const u32x4*)(stg8+row*64+ch*16); *(u32x4*)(Ow8+(long)row*OP+hf*64+ch*16)=v;}
      asm volatile("s_waitcnt lgkmcnt(0)":::"memory");
    } } else {
  bf16*Ow=Ou+(long)(wid*QBLK)*OP;
  { bf16*stg=(bf16*)(shm+L::OST)+wid*2048;
    #pragma unroll
    for(int hf=0;hf<NV;++hf){
      #pragma unroll
      for(int r=0;r<16;++r){const int orow=crow(r,hi);
        #pragma unroll
        for(int d0=0;d0<2;++d0)stg[orow*64+d0*32+r32]=__float2bfloat16(o[2*hf+d0][r]*rli[r]);}
      asm volatile("s_waitcnt lgkmcnt(0)":::"memory");
      #pragma unroll
      for(int i=0;i<4;++i){const int row=i*8+(lane>>3),ch=lane&7; const u32x4 v=*(const u32x4*)(stg+row*64+ch*8); *(u32x4*)(Ow+(long)row*OP+hf*64+ch*8)=v;}
      asm volatile("s_waitcnt lgkmcnt(0)":::"memory");
    } } }
  asm volatile("s_waitcnt lgkmcnt(0)\n\ts_barrier":::"memory");
  #undef DMA_K
  #undef DMA_KV
  #undef RFL
  #undef DMA_V
  #undef WAITB_KV
  #undef WAITB_V
  #undef WAITB_0
  #undef ROT
}

struct Lds8w { static constexpr int KSLOT=8192, VSLOT=8192, K=0, V=NSLOT*KSLOT, WS=V+NSLOT*VSLOT, OST=WS+NW*64*4, BYTES=OST+NW*4096; };
template<int NT,int QP,int KP,int OP,int O8> __device__ __forceinline__ void attn_unit8w(const unsigned char*Q8u,const unsigned char*__restrict__ K8b,const unsigned char*__restrict__ VTb,bf16*Ou,char*shm){
  typedef Lds8w L; constexpr int ND=2, NV=1, VSLOT=L::VSLOT, KSLOT=L::KSLOT, NS=NT/2;
  static_assert((NT&3)==0 && NS>8,"attn_unit8w");
  const int tid=threadIdx.x,lane=tid&63,r32=lane&31,hi=lane>>5; const int wid=__builtin_amdgcn_readfirstlane(tid>>6);
  const unsigned lds0=(unsigned)(uintptr_t)shm;
  const unsigned koff=(unsigned)((64*(wid&1)+lane)*KP+16*(wid>>1));
  const unsigned voff=(unsigned)((wid>>2)*4096+lane*64+16*(wid&3));
  const unsigned kdst=(unsigned)__builtin_amdgcn_readfirstlane(lds0+L::K+wid*1024), vdst=(unsigned)__builtin_amdgcn_readfirstlane(lds0+L::V+wid*1024);
  #define RFL(x) ((unsigned)__builtin_amdgcn_readfirstlane((int)(x)))
  #define DMA_K(t,slot) do{ glds16s(K8b+(long)(t)*128*KP,koff,RFL(kdst+(slot)*KSLOT)); }while(0)
  #define DMA_V(t,slot) do{ glds16s(VTb+(long)(t)*VSLOT,voff,RFL(vdst+(slot)*VSLOT)); }while(0)
  #define DMA_KV(tk,ks,tv,vs) do{ glds16s2(K8b+(long)(tk)*128*KP,koff,RFL(kdst+(ks)*KSLOT),VTb+(long)(tv)*VSLOT,voff,RFL(vdst+(vs)*VSLOT)); }while(0)
  #define WAITB_KV() asm volatile("s_waitcnt vmcnt(2) lgkmcnt(0)\n\ts_barrier":::"memory")
  #define WAITB_V()  asm volatile("s_waitcnt vmcnt(1) lgkmcnt(0)\n\ts_barrier":::"memory")
  #define WAITB_0()  asm volatile("s_waitcnt vmcnt(0) lgkmcnt(0)\n\ts_barrier":::"memory")
  const lds_cptr shm3=(lds_cptr)shm; const lds_cptr kp0=shm3+L::K+(2*hi)*2048+r32*16; const lds_cptr vp0=shm3+L::V+(2*hi)*1024+r32*16;
  i32x8_t kf[4], vf[2][2], q8, wA[2]={{0,0,0,0,0,0,0,0},{0,0,0,0,0,0,0,0}}, wB[2]={{0,0,0,0,0,0,0,0},{0,0,0,0,0,0,0,0}};
  #define KLD(slot) do{ const lds_cptr kp_=kp0+(slot)*KSLOT; _Pragma("unroll") for(int b_=0;b_<4;++b_){ kf[b_].lo=*(lds_i4p)(kp_+b_*512); kf[b_].hi=*(lds_i4p)(kp_+2048+b_*512); } }while(0)
  #define VLD(slot) do{ const lds_cptr vp_=vp0+(slot)*VSLOT; _Pragma("unroll") for(int h_=0;h_<2;++h_) _Pragma("unroll") for(int d_=0;d_<2;++d_){ vf[h_][d_].lo=*(lds_i4p)(vp_+h_*4096+d_*512); vf[h_][d_].hi=*(lds_i4p)(vp_+h_*4096+1024+d_*512); } }while(0)
  DMA_K(0,0);DMA_V(0,0);DMA_K(1,1);
  { const unsigned char*qp=Q8u+(long)(wid*QBLK+r32)*QP+32*hi; q8.lo=*(const i32x4_t*)qp; q8.hi=*(const i32x4_t*)(qp+16); }
  f32x16 o[ND]; f32x16 os=f32x16{};
  #pragma unroll
  for(int d_=0;d_<ND;++d_)o[d_]=f32x16{};
  i32x8_t ones8; { int one_=0x38383838; asm volatile("":"+s"(one_)); ones8=(i32x8_t){one_,one_,one_,one_,one_,one_,one_,one_}; asm volatile("":"+v"(ones8)); }
  f32x16 c0,c1,c2,c3;
  int sp=0,sc=0,sn=1;
  #define ROT() do{sp=sc;sc=sn;sn=(sn==NSLOT-1)?0:sn+1;}while(0)
  #define MFZ(D,A_,B_) asm volatile("v_mfma_f32_32x32x64_f8f6f4 %0, %1, %2, -4.0":"=&v"(D):"v"(A_),"v"(B_))
  #define MFA(D,A_,B_) asm volatile("v_mfma_f32_32x32x64_f8f6f4 %0, %1, %2, %0":"+v"(D):"v"(A_),"v"(B_))
  #define EXR(C,lo_,n_) do{ _Pragma("unroll") for(int e_=(lo_);e_<(lo_)+(n_);++e_) C[e_]=__builtin_amdgcn_exp2f(C[e_]); asm volatile("":"+v"(C)); }while(0)
  #define PACK(P,W,base) do{ _Pragma("unroll") for(int j_=0;j_<4;++j_) W[(base)+j_]=(int)pk4c(P[4*j_],P[4*j_+1],P[4*j_+2],P[4*j_+3],(unsigned)W[(base)+j_]); asm volatile("":"+v"(W)); }while(0)
  DMA_K(2,2);
  asm volatile("s_waitcnt vmcnt(3) lgkmcnt(0)\n\ts_barrier":::"memory");
  KLD(0);
  MFZ(c0,kf[0],q8); MFZ(c1,kf[1],q8); MFZ(c2,kf[2],q8); MFZ(c3,kf[3],q8);
  asm volatile("s_nop 15\n\ts_nop 15":"+v"(c0),"+v"(c1),"+v"(c2),"+v"(c3));
  EXR(c0,0,16); PACK(c0,wA[0],0); EXR(c1,0,16); PACK(c1,wA[0],4); EXR(c2,0,16); PACK(c2,wA[1],0); EXR(c3,0,16); PACK(c3,wA[1],4);
  WAITB_0();
  DMA_K(3,0);DMA_V(1,1);
  ROT();
  KLD(sc);
  WAITB_KV();
  #define STEP9W(WP,WN,t,GK,GV,GL) do{ SBAR(); \
    VLD(sp); SBAR(); \
    MFZ(c0,kf[0],q8); SBAR(); \
    if((GK)&&(GV)){ DMA_KV((t)+3,sc,(t)+1,sn); } else { if(GK){DMA_K((t)+3,sc);} if(GV){DMA_V((t)+1,sn);} } SBAR(); \
    MFZ(c1,kf[1],q8); MFZ(c2,kf[2],q8); MFZ(c3,kf[3],q8); SBAR(); \
    if(GL){KLD(sn);} SBAR(); \
    MFA(o[0],WP[0],vf[0][0]); SBAR(); EXR(c0,0,16); PACK(c0,WN[0],0); SBAR(); \
    MFA(o[1],WP[0],vf[0][1]); SBAR(); EXR(c1,0,8); SBAR(); \
    asm volatile("s_nop 1":::); MFA(os,WP[0],ones8); SBAR(); EXR(c1,8,8); PACK(c1,WN[0],4); SBAR(); \
    MFA(o[0],WP[1],vf[1][0]); SBAR(); EXR(c2,0,16); PACK(c2,WN[1],0); SBAR(); \
    MFA(o[1],WP[1],vf[1][1]); SBAR(); EXR(c3,0,8); SBAR(); \
    asm volatile("s_nop 1":::); MFA(os,WP[1],ones8); SBAR(); EXR(c3,8,8); PACK(c3,WN[1],4); SBAR(); \
    }while(0)
  if(ATT_PRIO && wid>=4) __builtin_amdgcn_s_setprio(1);
  int t=1;
  for(;t+5<NS;t+=2){
    STEP9W(wA,wB,t,true,true,true);     WAITB_KV(); ROT();
    STEP9W(wB,wA,t+1,true,true,true);   WAITB_KV(); ROT();
  }
  #define ENDW(tt) do{ if((tt)+3<NS){WAITB_KV();} else if((tt)+2<NS){WAITB_V();} else {WAITB_0();} }while(0)
  for(;t+1<NS;t+=2){
    STEP9W(wA,wB,t,(t+3<NS),(t+1<NS),(t+1<NS));       ENDW(t);   ROT();
    STEP9W(wB,wA,t+1,(t+4<NS),(t+2<NS),(t+2<NS));     ENDW(t+1); ROT();
  }
  STEP9W(wA,wB,NS-1,false,false,false);
  if(ATT_PRIO && wid>=4) __builtin_amdgcn_s_setprio(0);
  { VLD(sc); SBAR();
    MFA(o[0],wB[0],vf[0][0]); MFA(o[1],wB[0],vf[0][1]); MFA(o[0],wB[1],vf[1][0]); MFA(o[1],wB[1],vf[1][1]);
    asm volatile("s_nop 1":::); MFA(os,wB[0],ones8); MFA(os,wB[1],ones8); asm volatile("s_nop 15\n\ts_nop 15":"+v"(os)); }
  #undef STEP9W
  #undef ENDW
  #undef MFZ
  #undef MFA
  #undef EXR
  #undef PACK
  #undef KLD
  #undef VLD
  #undef RFL
  float rli[16];
  #pragma unroll
  for(int r=0;r<16;++r)rli[r]=__builtin_amdgcn_rcpf(os[r]);
  if constexpr(O8!=0){ unsigned char*Ow8=(unsigned char*)Ou+(long)(wid*QBLK)*OP; unsigned char*stg8=(unsigned char*)(shm+L::OST)+wid*4096;
      #pragma unroll
      for(int r=0;r<16;++r){const int orow=crow(r,hi);
        #pragma unroll
        for(int d0=0;d0<2;++d0){ const float v=__builtin_amdgcn_fmed3f(o[d0][r]*rli[r]*YA8_SCALE,-448.0f,448.0f); stg8[orow*64+d0*32+r32]=(unsigned char)__builtin_amdgcn_cvt_pk_fp8_f32(v,v,0,false); } }
      asm volatile("s_waitcnt lgkmcnt(0)":::"memory");
      #pragma unroll
      for(int i=0;i<2;++i){const int row=i*16+(lane>>2),ch=lane&3; const u32x4 v=*(const u32x4*)(stg8+row*64+ch*16); *(u32x4*)(Ow8+(long)row*OP+ch*16)=v;}
      asm volatile("s_waitcnt lgkmcnt(0)":::"memory");
  } else {
  bf16*Ow=Ou+(long)(wid*QBLK)*OP;
  { bf16*stg=(bf16*)(shm+L::OST)+wid*2048;
      #pragma unroll
      for(int r=0;r<16;++r){const int orow=crow(r,hi);
        #pragma unroll
        for(int d0=0;d0<2;++d0)stg[orow*64+d0*32+r32]=__float2bfloat16(o[d0][r]*rli[r]);}
      asm volatile("s_waitcnt lgkmcnt(0)":::"memory");
      #pragma unroll
      for(int i=0;i<4;++i){const int row=i*8+(lane>>3),ch=lane&7; const u32x4 v=*(const u32x4*)(stg+row*64+ch*8); *(u32x4*)(Ow+(long)row*OP+ch*8)=v;}
      asm volatile("s_waitcnt lgkmcnt(0)":::"memory");
  } }
  asm volatile("s_waitcnt lgkmcnt(0)\n\ts_barrier":::"memory");
  #undef DMA_K
  #undef DMA_V
  #undef DMA_KV
  #undef WAITB_KV
  #undef WAITB_V
  #undef WAITB_0
  #undef ROT
}
constexpr int ATTN_LDS_BYTES=LDS_BYTES;
#undef SBAR
#undef WAIT_BAR
}
constexpr int NWAVES = 8;
constexpr int RING_OFF = 0, RING_BYTES = 135168;
constexpr int LDSCTL_OFF = RING_BYTES, MISC_OFF = LDSCTL_OFF + 320;
constexpr int TB_OFF = LDSCTL_OFF + 512;
constexpr int LDS_BYTES = 151552;
constexpr int CW_BAR = 4096;
constexpr int N_PHASES = 11;
static_assert(attn_body::Lds8<128>::BYTES <= RING_BYTES && attn_body::Lds8<64>::BYTES <= RING_BYTES, "attention LDS");
static_assert(RING_OFF == 0 && LDSCTL_OFF + 6144 == pg8::PF_OFF && TB_OFF + 4 * (128 + 4 * 320) <= LDSCTL_OFF + 6144 && pg8::PF_OFF + 3072 <= LDS_BYTES, "LDS map");
#ifndef ABL_PROBE
#define ABL_PROBE 0
#endif
#ifndef ATT8_ONES_B
#define ATT8_ONES_B true
#endif
#ifndef ATT8_WIDE_A
#define ATT8_WIDE_A 1
#endif
#if ATT8_WIDE_A
#define ATT8_UNIT_A attn_unit8w<SK / 64, 512, 128, 1024, MERGE_FP8>
#else
#define ATT8_UNIT_A attn_unit8<64, true, SK / 64, 512, 128, 1024, MERGE_FP8>
#endif
#ifndef ATT_XCD_ROWS
#define ATT_XCD_ROWS 1
#endif
#ifndef W8_TALL
#define W8_TALL 1
#endif
#ifndef TOPO_SYNC
#define TOPO_SYNC 1
#endif
constexpr int CW_TOPO = 3072;
#ifndef CENSUS_PAR
#define CENSUS_PAR 1
#endif
#ifndef FUSE_DIFFOUT
#define FUSE_DIFFOUT 1
#endif
#ifndef WSTAGGER
#define WSTAGGER 1
#endif
#ifndef ATT_UNIT_A
#define ATT_UNIT_A attn_unit2
#endif
#ifndef ATT_UNIT_B
#define ATT_UNIT_B attn_unit2
#endif
#ifndef ATT_ONES_A
#define ATT_ONES_A true
#endif
#ifndef ATT_ONES_B
#define ATT_ONES_B false
#endif

typedef GAS unsigned gu32;
#define XB_TMO      128
#define XB_XCNT(j)  (256  + 64 * (j))
#define XB_XSUB(j)  (1280 + 64 * (j))
#define XB_XGEN(j)  (2304 + 64 * (j))
#define XB_TOP      3328
#define XB_TOPGEN   3392
#define XCD_BAR_WORDS 3456
#define XB_SPIN_CAP (1u << 18)

__device__ __forceinline__ unsigned xb_ld(unsigned* p)              { return __hip_atomic_load(p, __ATOMIC_RELAXED, __HIP_MEMORY_SCOPE_AGENT); }
__device__ __forceinline__ unsigned xb_add(unsigned* p, unsigned v) { return __hip_atomic_fetch_add(p, v, __ATOMIC_RELAXED, __HIP_MEMORY_SCOPE_AGENT); }
__device__ __forceinline__ unsigned xb_xcc_id() { return (unsigned)__builtin_amdgcn_s_getreg((3 << 11) | 20) & 0xFu; }
#define XB_SPIN(cond, bar) do { unsigned _sp = 0; while (cond) { __builtin_amdgcn_s_sleep(1); \
    if ((++_sp & 255u) == 0u) { if (xb_ld(&(bar)[XB_TMO])) break; if (_sp > XB_SPIN_CAP) { atomicAdd(&(bar)[XB_TMO], 1u); break; } } } } while (0)

struct XcdBarrier {
    unsigned* bar; unsigned x;
    volatile LAS unsigned* st;
};

__device__ __forceinline__ XcdBarrier xcd_barrier_post(unsigned* bar, volatile LAS unsigned* st) {
    XcdBarrier b; b.bar = bar; b.x = xb_xcc_id(); b.st = st;
    if (threadIdx.x == 0) (void)xb_add(&bar[XB_XCNT(b.x)], 1u);
    return b;
}
__device__ __forceinline__ void xcd_barrier_complete(unsigned* bar, unsigned x, unsigned& nloc, unsigned& nx) {
    const unsigned G = gridDim.x * gridDim.y * gridDim.z;
    unsigned sum, cnt, mine, sp = 0u;
    for (;;) {
        sum = 0u; cnt = 0u; mine = 0u;
#pragma unroll
        for (unsigned j = 0; j < 16; ++j) { const unsigned c = xb_ld(&bar[XB_XCNT(j)]); sum += c; cnt += (c > 0u) ? 1u : 0u; mine = (j == x) ? c : mine; }
        if (sum == G) break;
        __builtin_amdgcn_s_sleep(1);
        if ((++sp & 255u) == 0u) { if (xb_ld(&bar[XB_TMO])) break; if (sp > XB_SPIN_CAP) { atomicAdd(&bar[XB_TMO], 1u); break; } }
    }
    nloc = mine > 0u ? mine : 1u; nx = cnt > 0u ? cnt : 1u;
}

__device__ __forceinline__ void xcd_barrier(const XcdBarrier& b) {
    asm volatile("s_waitcnt vmcnt(0)" ::: "memory");
    __syncthreads();
    if (threadIdx.x == 0) {
        unsigned* bar = b.bar;
        __builtin_amdgcn_s_waitcnt(0);
        unsigned nloc = b.st[0], nx = b.st[1];
        if (nloc == 0u) { xcd_barrier_complete(bar, b.x, nloc, nx); b.st[0] = nloc; b.st[1] = nx; }
        const unsigned old = xb_add(&bar[XB_XSUB(b.x)], 1u);
        const unsigned gen = old / nloc;
        if (old + 1u == (gen + 1u) * nloc) {
            __builtin_amdgcn_fence(__ATOMIC_RELEASE, "agent");
            asm volatile("s_waitcnt vmcnt(0)" ::: "memory");
            const unsigned og = xb_add(&bar[XB_TOP], 1u);
            const unsigned tg = og / nx;
            if (og + 1u == (tg + 1u) * nx) xb_add(&bar[XB_TOPGEN], 1u);
            else XB_SPIN(xb_ld(&bar[XB_TOPGEN]) == tg, bar);
            __builtin_amdgcn_fence(__ATOMIC_ACQUIRE, "agent");
            xb_add(&bar[XB_XGEN(b.x)], 1u);
            asm volatile("s_waitcnt vmcnt(0)" ::: "memory");
        } else {
            XB_SPIN(xb_ld(&bar[XB_XGEN(b.x)]) == gen, bar);
            __builtin_amdgcn_fence(__ATOMIC_ACQUIRE, "agent");
            asm volatile("s_waitcnt vmcnt(0)" ::: "memory");
        }
    }
    __syncthreads();
}


struct TItem { const float* src; bf16* dst; int K, N, k0, n0, kind; };
__device__ __forceinline__ int titem_drow(int kind, int c) {
    return kind == 0 ? c : kind == 1 ? (c & ~255) + 128 * ((c >> 5) & 1) + 32 * ((c >> 6) & 3) + (c & 31) : kind == 2 ? 256 * (c >> 7) + (c & 127) : 256 * (c >> 7) + 128 + (c & 127);
}
__device__ __forceinline__ void titem_load(const TItem& t, int lane, f32x4 (&va)[8], f32x4 (&vb)[8]) {
    const float* src = t.src + (size_t)(t.k0 + 2 * (lane >> 4)) * t.N + t.n0 + 4 * (lane & 15);
#pragma unroll
    for (int i = 0; i < 8; ++i) { va[i] = __builtin_nontemporal_load((const f32x4*)(src + (size_t)(8 * i) * t.N)); vb[i] = __builtin_nontemporal_load((const f32x4*)(src + (size_t)(8 * i + 1) * t.N)); }
}
__device__ __forceinline__ void titem_finish(const TItem& t, int lane, LAS unsigned* scr, const f32x4 (&va)[8], const f32x4 (&vb)[8]) {
    const int kp = lane >> 4, n4 = lane & 15;
#pragma unroll
    for (int i = 0; i < 8; ++i) { pg8::u32x4 w; w.x = pg8::cvt_pk_bf16(va[i].x, vb[i].x); w.y = pg8::cvt_pk_bf16(va[i].y, vb[i].y); w.z = pg8::cvt_pk_bf16(va[i].z, vb[i].z); w.w = pg8::cvt_pk_bf16(va[i].w, vb[i].w);
        *(LAS pg8::u32x4*)(scr + (4 * i + kp) * 68 + 4 * n4) = w; }
    asm volatile("s_waitcnt lgkmcnt(0)" ::: "memory");
    const int c = lane & 7;
#pragma unroll
    for (int j = 0; j < 8; ++j) { const int n = (lane >> 3) + 8 * j; const LAS unsigned* s = scr + (4 * c) * 68 + n;
        pg8::u32x4 o; o.x = s[0]; o.y = s[68]; o.z = s[136]; o.w = s[204];
        __builtin_nontemporal_store(o, (pg8::u32x4*)(t.dst + (size_t)titem_drow(t.kind, t.n0 + n) * t.K + t.k0 + 8 * c)); }
    asm volatile("s_waitcnt lgkmcnt(0)" ::: "memory");
}
__device__ __forceinline__ void titem8_load(const TItem& t, int lane, f32x4 (&v)[16]) {
    const float* src = t.src + (size_t)(t.k0 + 4 * (lane >> 4)) * t.N + t.n0 + 4 * (lane & 15);
#pragma unroll
    for (int i = 0; i < 4; ++i)
#pragma unroll
        for (int j = 0; j < 4; ++j) v[4 * i + j] = __builtin_nontemporal_load((const f32x4*)(src + (size_t)(16 * i + j) * t.N));
}
__device__ __forceinline__ void titem8_finish(const TItem& t, int lane, LAS unsigned* scr, const f32x4 (&v)[16]) {
    const int kq = lane >> 4, n4 = lane & 15;
#pragma unroll
    for (int i = 0; i < 4; ++i) { pg8::u32x4 w;
        w.x = pk4_fp8(v[4 * i][0] * W8_SCALE, v[4 * i + 1][0] * W8_SCALE, v[4 * i + 2][0] * W8_SCALE, v[4 * i + 3][0] * W8_SCALE);
        w.y = pk4_fp8(v[4 * i][1] * W8_SCALE, v[4 * i + 1][1] * W8_SCALE, v[4 * i + 2][1] * W8_SCALE, v[4 * i + 3][1] * W8_SCALE);
        w.z = pk4_fp8(v[4 * i][2] * W8_SCALE, v[4 * i + 1][2] * W8_SCALE, v[4 * i + 2][2] * W8_SCALE, v[4 * i + 3][2] * W8_SCALE);
        w.w = pk4_fp8(v[4 * i][3] * W8_SCALE, v[4 * i + 1][3] * W8_SCALE, v[4 * i + 2][3] * W8_SCALE, v[4 * i + 3][3] * W8_SCALE);
        *(LAS pg8::u32x4*)(scr + (4 * i + kq) * 68 + 4 * n4) = w; }
    asm volatile("s_waitcnt lgkmcnt(0)" ::: "memory");
    const int c = lane & 3;
#pragma unroll
    for (int j = 0; j < 4; ++j) { const int n = (lane >> 2) + 16 * j; const LAS unsigned* s = scr + (4 * c) * 68 + n;
        pg8::u32x4 o; o.x = s[0]; o.y = s[68]; o.z = s[136]; o.w = s[204];
        __builtin_nontemporal_store(o, (pg8::u32x4*)((unsigned char*)t.dst + (size_t)titem_drow(t.kind, t.n0 + n) * t.K + t.k0 + 16 * c)); }
    asm volatile("s_waitcnt lgkmcnt(0)" ::: "memory");
}
__device__ __forceinline__ void titem8t_load(const TItem& t, int lane, f32x4 (&v)[16]) {
    const float* src = t.src + (size_t)(t.k0 + 4 * (lane >> 3)) * t.N + t.n0 + 4 * (lane & 7);
#pragma unroll
    for (int i = 0; i < 4; ++i)
#pragma unroll
        for (int j = 0; j < 4; ++j) v[4 * i + j] = __builtin_nontemporal_load((const f32x4*)(src + (size_t)(32 * i + j) * t.N));
}
__device__ __forceinline__ void titem8t_finish(const TItem& t, int lane, LAS unsigned* scr, const f32x4 (&v)[16]) {
    const int kq = lane >> 3, n4 = lane & 7;
#pragma unroll
    for (int i = 0; i < 4; ++i) { pg8::u32x4 w;
        w.x = pk4_fp8(v[4 * i][0] * W8_SCALE, v[4 * i + 1][0] * W8_SCALE, v[4 * i + 2][0] * W8_SCALE, v[4 * i + 3][0] * W8_SCALE);
        w.y = pk4_fp8(v[4 * i][1] * W8_SCALE, v[4 * i + 1][1] * W8_SCALE, v[4 * i + 2][1] * W8_SCALE, v[4 * i + 3][1] * W8_SCALE);
        w.z = pk4_fp8(v[4 * i][2] * W8_SCALE, v[4 * i + 1][2] * W8_SCALE, v[4 * i + 2][2] * W8_SCALE, v[4 * i + 3][2] * W8_SCALE);
        w.w = pk4_fp8(v[4 * i][3] * W8_SCALE, v[4 * i + 1][3] * W8_SCALE, v[4 * i + 2][3] * W8_SCALE, v[4 * i + 3][3] * W8_SCALE);
        *(LAS pg8::u32x4*)(scr + (8 * i + kq) * 36 + 4 * n4) = w; }
    asm volatile("s_waitcnt lgkmcnt(0)" ::: "memory");
    const int c = lane & 7;
#pragma unroll
    for (int j = 0; j < 4; ++j) { const int n = (lane >> 3) + 8 * j; const LAS unsigned* s = scr + (4 * c) * 36 + n;
        pg8::u32x4 o; o.x = s[0]; o.y = s[36]; o.z = s[72]; o.w = s[108];
        __builtin_nontemporal_store(o, (pg8::u32x4*)((unsigned char*)t.dst + (size_t)titem_drow(t.kind, t.n0 + n) * t.K + t.k0 + 16 * c)); }
    asm volatile("s_waitcnt lgkmcnt(0)" ::: "memory");
}
constexpr int I_INA = 16 * (INPROJ_FP8_ALL ? 0 : INPROJ_GATE_FP8 ? 36 : 68), I_ING = 16 * (INPROJ_FP8_ALL ? 68 : INPROJ_GATE_FP8 ? 32 : 0), I_OA = 8 * 16, I_OUT = 16 * 16, I_EX = 16 * 16;
constexpr int I_B16 = I_INA + (MERGE_FP8 ? 0 : 2 * I_OA + I_OUT), I_SMALL = I_INA + 2 * I_OA + I_OUT + I_ING, NIT = I_SMALL + NE * 3 * I_EX;
constexpr size_t WS_WOB8 = WS_WOA + (size_t)1024 * 512;
constexpr size_t WS_WIN8 = WS_WIN + (size_t)2304 * 2048;
__device__ __forceinline__ TItem weight_titem(const P& p, int it) {
    TItem t; int r = it; int item;
    if (r < I_INA) { t.src = p.w_in; t.dst = (bf16*)(p.ws + WS_WIN); t.K = D; t.N = INC; t.kind = 1; const int nb = I_INA / 16; t.k0 = 64 * (r / nb); t.n0 = 64 * (r % nb); return t; }
    else if ((r -= I_INA) < I_OA) { t.src = p.w_oa; t.dst = (bf16*)(p.ws + WS_WOA); t.K = 512; t.N = D; t.kind = 0; item = r; }
    else if ((r -= I_OA) < I_OA) { t.src = p.w_ob; t.dst = (bf16*)(p.ws + (MERGE_FP8 ? WS_WOB8 : WS_WOB)); t.K = 512; t.N = D; t.kind = 0; item = r; }
    else if ((r -= I_OA) < I_OUT) { t.src = p.w_out; t.dst = (bf16*)(p.ws + WS_WOUT); t.K = D; t.N = D; t.kind = 0; item = r; }
    else if ((r -= I_OUT) < I_ING) { t.src = p.w_in; t.K = D; t.N = INC; t.kind = 1;
        if (INPROJ_FP8_ALL) { t.dst = (bf16*)(p.ws + WS_WIN); t.k0 = 64 * (r / 68); t.n0 = 64 * (r % 68); }
        else { t.dst = (bf16*)(p.ws + WS_WIN8 - (size_t)2304 * D); t.k0 = 64 * (r / 32); t.n0 = 2304 + 64 * (r % 32); }
        return t; }
    else { r -= I_ING; const int e = r / (3 * I_EX), q = (r / I_EX) % 3; item = r % I_EX; t.K = D; t.N = D;
        constexpr size_t EBW = MOE_FP8 ? 1 : 2;
        if (q == 0) { t.src = p.w_gate + (size_t)e * D * D; t.dst = (bf16*)(p.ws + WS_WGU + (size_t)e * 2048 * D * EBW); t.kind = 2; }
        else if (q == 1) { t.src = p.w_up + (size_t)e * D * D; t.dst = (bf16*)(p.ws + WS_WGU + (size_t)e * 2048 * D * EBW); t.kind = 3; }
        else { t.src = p.w_down + (size_t)e * D * D; t.dst = (bf16*)(p.ws + WS_WD + (size_t)e * D * D * EBW); t.kind = 0; } }
    if (W8_TALL && MOE_FP8 && it >= I_SMALL) { t.k0 = 128 * (item / 32); t.n0 = 32 * (item % 32); return t; }
    const int nblk = t.N / 64; t.k0 = 64 * (item / nblk); t.n0 = 64 * (item % nblk); return t;
}
template <bool F8, bool TALL = false>
__device__ __forceinline__ void weight_items(const P& p, int first, int step, int hi, LAS unsigned* scr, int lane) {
    for (int it = first; it < hi; it += 2 * step) {
        const bool two = it + step < hi;
        const TItem t0 = weight_titem(p, it), t1 = weight_titem(p, two ? it + step : it);
        if constexpr (F8) {
            f32x4 v0[16], v1[16];
            if constexpr (TALL) { titem8t_load(t0, lane, v0); if (two) titem8t_load(t1, lane, v1);
                titem8t_finish(t0, lane, scr, v0); if (two) titem8t_finish(t1, lane, scr, v1); }
            else { titem8_load(t0, lane, v0); if (two) titem8_load(t1, lane, v1);
            titem8_finish(t0, lane, scr, v0); if (two) titem8_finish(t1, lane, scr, v1); }
        } else {
            f32x4 a0[8], b0[8], a1[8], b1[8];
            titem_load(t0, lane, a0, b0); if (two) titem_load(t1, lane, a1, b1);
            titem_finish(t0, lane, scr, a0, b0); if (two) titem_finish(t1, lane, scr, a1, b1);
        }
    }
}
__device__ __forceinline__ void ph_weights(const P& p, int vb, int nvb, LAS unsigned char* lds, int lo, int hi) {
    const int lane = threadIdx.x & 63, wave = threadIdx.x >> 6;
    const int mid = hi < I_B16 ? hi : I_B16;
    if (lo < mid) weight_items<false>(p, lo + vb * NWAVES + wave, nvb * NWAVES, mid, (LAS unsigned*)(lds + wave * 8704), lane);
    if (hi > I_B16 && I_ING > 0) { const int l2 = lo > I_B16 ? lo : I_B16, h2 = hi < I_SMALL ? hi : I_SMALL; weight_items<true>(p, l2 + vb * NWAVES + wave, nvb * NWAVES, h2, (LAS unsigned*)(lds + wave * 8704), lane); }
    if (hi > I_SMALL) { const int l2 = lo > I_SMALL ? lo : I_SMALL; weight_items<MOE_FP8 != 0, (W8_TALL && MOE_FP8)>(p, l2 + vb * NWAVES + wave, nvb * NWAVES, hi, (LAS unsigned*)(lds + wave * 8704), lane); }
}
__device__ __forceinline__ void ph_weights_share(const P& p, int vb, int nvb, LAS unsigned char* lds) {
    int lane = threadIdx.x & 63; const int wave = threadIdx.x >> 6;
    asm volatile("" : "+v"(lane));
    const int per = (NIT - I_SMALL + nvb - 1) / nvb, lo = I_SMALL + vb * per, hi = (lo + per < NIT) ? lo + per : NIT;
    weight_items<MOE_FP8 != 0, (W8_TALL && MOE_FP8)>(p, lo + wave, NWAVES, hi, (LAS unsigned*)(lds + wave * 8704), lane);
}

__device__ __forceinline__ void expert_tables(const P& p, LAS int* tb) {
    if (threadIdx.x < 64) { const int lane = threadIdx.x; const gu32* CNT = (const gu32*)((const unsigned*)(p.ws + WS_CTL) + CW_CNT);
        const int c = (int)__hip_atomic_load(CNT + 64 * (lane & 31), __ATOMIC_RELAXED, __HIP_MEMORY_SCOPE_AGENT);
        int pb = (c + 255) & ~255, pt = (c + 255) >> 8;
#pragma unroll
        for (int o = 1; o < 32; o <<= 1) { const int ub = __shfl_up(pb, o), ut = __shfl_up(pt, o); if ((lane & 31) >= o) { pb += ub; pt += ut; } }
        if (lane < 32) { tb[lane] = c; tb[32 + lane] = pb - ((c + 255) & ~255); tb[64 + lane] = pt - ((c + 255) >> 8); if (lane == 31) tb[64 + NE] = pt; } }
    __syncthreads();
    { const int rt = threadIdx.x; const int ntile = tb[64 + NE];
      if (rt < ntile && rt < 320) { int e = 0;
#pragma unroll 1
          while (tb[64 + e + 1] <= rt) ++e;
          tb[128 + 4 * rt] = e; tb[128 + 4 * rt + 1] = (rt - tb[64 + e]) * 256; tb[128 + 4 * rt + 2] = tb[e]; tb[128 + 4 * rt + 3] = tb[32 + e]; } }
    __syncthreads();
}

struct Args { P p; int ph_lo, ph_hi, li, pad; };
__global__ void __launch_bounds__(NWAVES * 64, 2) mk_fwd(Args a) {
    extern __shared__ __attribute__((aligned(16))) unsigned char lds_raw[];
    LAS unsigned char* lds = (LAS unsigned char*)lds_raw;
    volatile LAS unsigned* MISC = (volatile LAS unsigned*)(lds + MISC_OFF);
    const P& p = a.p;
    const int tid = threadIdx.x, G = gridDim.x, bx = blockIdx.x;
    for (int u = tid; u < (LDS_BYTES - LDSCTL_OFF) / 4; u += NWAVES * 64) ((LAS unsigned*)(lds + LDSCTL_OFF))[u] = 0u;
    __syncthreads();
    unsigned* barw = (unsigned*)(p.ws + WS_CTL) + CW_BAR + a.li * XCD_BAR_WORDS;
    XcdBarrier bar = xcd_barrier_post(barw, MISC + 8);
    unsigned* topo = (unsigned*)(p.ws + WS_CTL) + CW_TOPO + a.li * 768;
    bool topo_ok = false; int vcu = (G % 8 == 0) ? (bx % 8) * (G / 8) + bx / 8 : bx;
    if (TOPO_SYNC && a.li == 0) {
        if (tid == 0) MISC[10] = xb_add(&topo[16 * bar.x], 1u);
        if (tid < 64) { unsigned sp_ = 0u;
            for (;;) { const unsigned c_ = tid < 16 ? xb_ld(&topo[16 * tid]) : 0u; unsigned sum_ = c_;
#pragma unroll
                for (int o_ = 1; o_ < 16; o_ <<= 1) sum_ += __shfl_xor(sum_, o_);
                if (__builtin_amdgcn_readfirstlane(sum_) == (unsigned)G) {
                    const unsigned long long nz = __ballot(c_ > 0u), bad = __ballot(c_ != 0u && c_ != 32u);
                    const bool ok_ = G == 256 && __builtin_popcountll(nz) == 8 && bad == 0ull;
                    if (tid == 0) MISC[11] = ok_ ? 1u + (unsigned)__builtin_popcountll(nz & ((1ull << bar.x) - 1ull)) : 0u;
                    break; }
                __builtin_amdgcn_s_sleep(1); if (++sp_ > (1u << 22)) break; } }
        __syncthreads();
        const unsigned tr_ = MISC[11]; topo_ok = tr_ != 0u;
        if (topo_ok) vcu = (int)((tr_ - 1u) * 32u + MISC[10]);
    }
    unsigned* const lbw = topo + 256 + 16 * bar.x;
#define LOCAL_BAR() do { asm volatile("s_waitcnt vmcnt(0)" ::: "memory"); __syncthreads(); \
        if (tid == 0) { const unsigned old_ = xb_add(&lbw[0], 1u), gen_ = old_ / 32u; \
            if (old_ + 1u == (gen_ + 1u) * 32u) (void)xb_add(&lbw[256], 1u); else XB_SPIN(xb_ld(&lbw[256]) == gen_, barw); } \
        asm volatile("" ::: "memory"); __syncthreads(); } while (0)
    const int lo = a.ph_lo, hi = a.ph_hi;
#ifndef PH_COMPILED
#define PH_COMPILED 0x7ff
#endif
#define IN(k) ((((PH_COMPILED) >> (k)) & 1) && lo <= (k) && (k) < hi)
#define CENSUS() do { if (CENSUS_PAR && tid < 64 && MISC[8] == 0u) { unsigned sp_ = 0u; \
        for (;;) { const unsigned c_ = tid < 16 ? xb_ld(&barw[XB_XCNT(tid)]) : 0u; unsigned sum_ = c_, cnt_ = c_ > 0u ? 1u : 0u; \
            _Pragma("unroll") for (int o_ = 1; o_ < 16; o_ <<= 1) { sum_ += __shfl_xor(sum_, o_); cnt_ += __shfl_xor(cnt_, o_); } \
            const unsigned mine_ = __shfl(c_, (int)bar.x); \
            if (__builtin_amdgcn_readfirstlane(sum_) == (unsigned)G) { if (tid == 0) { MISC[8] = __builtin_amdgcn_readfirstlane(mine_); MISC[9] = __builtin_amdgcn_readfirstlane(cnt_); } break; } \
            __builtin_amdgcn_s_sleep(1); if (++sp_ > 20000u) break; } } } while (0)
#define SEAM(k) do { if (IN(k) && IN((k) + 1)) { CENSUS(); xcd_barrier(bar); } } while (0)
#define SEAM_L(k) do { if (IN(k) && IN((k) + 1)) { if (topo_ok) LOCAL_BAR(); else { CENSUS(); xcd_barrier(bar); } } } while (0)
#ifndef DUP_MASK
#define DUP_MASK 0
#endif
#if ((DUP_MASK) >> 0) & 1
#define REP0 _Pragma("unroll 1") for (int rep_ = 0; rep_ < 2; ++rep_)
#else
#define REP0
#endif
#if ((DUP_MASK) >> 1) & 1
#define REP1 _Pragma("unroll 1") for (int rep_ = 0; rep_ < 2; ++rep_)
#else
#define REP1
#endif
#if ((DUP_MASK) >> 2) & 1
#define REP2 _Pragma("unroll 1") for (int rep_ = 0; rep_ < 2; ++rep_)
#else
#define REP2
#endif
#if ((DUP_MASK) >> 3) & 1
#define REP3 _Pragma("unroll 1") for (int rep_ = 0; rep_ < 2; ++rep_)
#else
#define REP3
#endif
#if ((DUP_MASK) >> 4) & 1
#define REP4 _Pragma("unroll 1") for (int rep_ = 0; rep_ < 2; ++rep_)
#else
#define REP4
#endif
#if ((DUP_MASK) >> 5) & 1
#define REP5 _Pragma("unroll 1") for (int rep_ = 0; rep_ < 2; ++rep_)
#else
#define REP5
#endif
#if ((DUP_MASK) >> 6) & 1
#define REP6 _Pragma("unroll 1") for (int rep_ = 0; rep_ < 2; ++rep_)
#else
#define REP6
#endif
#if ((DUP_MASK) >> 7) & 1
#define REP7 _Pragma("unroll 1") for (int rep_ = 0; rep_ < 2; ++rep_)
#else
#define REP7
#endif
#if ((DUP_MASK) >> 8) & 1
#define REP8 _Pragma("unroll 1") for (int rep_ = 0; rep_ < 2; ++rep_)
#else
#define REP8
#endif
#if ((DUP_MASK) >> 9) & 1
#define REP9 _Pragma("unroll 1") for (int rep_ = 0; rep_ < 2; ++rep_)
#else
#define REP9
#endif
    LAS int* tb = (LAS int*)(lds + TB_OFF);

    if (IN(0)) { ph_mod(p, bx, G, (float*)lds_raw); __syncthreads(); ph_weights(p, bx, G, lds, 0, WSTAGGER ? I_SMALL : NIT);
#if ((DUP_MASK) >> 0) & 1
        __syncthreads(); ph_weights(p, bx, G, lds, 0, WSTAGGER ? I_SMALL : NIT);
#endif
#if ((DUP_MASK) >> 13) & 1
        __syncthreads(); ph_mod(p, bx, G, (float*)lds_raw);
#endif
    }
    SEAM(0);
    if (IN(1)) { ph_norm1(p, INPROJ_XCD_BLOCKS ? vcu : bx, G); ph_router_prep(p, bx, G);
#if ((DUP_MASK) >> 1) & 1
        ph_norm1(p, INPROJ_XCD_BLOCKS ? vcu : bx, G);
#endif
    }
    if (INPROJ_XCD_BLOCKS && INPROJ_FP8_ALL) SEAM_L(1); else SEAM(1);
    if (IN(2)) {
        pg8::Gemm g{(const bf16*)(p.ws + WS_HX), (const bf16*)(p.ws + WS_WIN), D, D};
        EpiInProj E{p.ws, p.q_norm_a, p.k_norm_a, p.q_norm_b, p.k_norm_b};
#if INPROJ_FP8_ALL
        { pg8::Gemm g8{(const bf16*)(p.ws + WS_HX8), (const bf16*)(p.ws + WS_WIN), D, D}; SchedInProj S; S.G = G; S.v = vcu;
          pg8::gemm_phase<EpiInProj, SchedInProj, true>(lds + RING_OFF, g8, S, E);
#if ((DUP_MASK) >> 2) & 1
          pg8::gemm_phase<EpiInProj, SchedInProj, true>(lds + RING_OFF, g8, S, E);
#endif
          }
#elif INPROJ_GATE_FP8
        { SchedInProjA S; S.G = G; S.v = vcu; pg8::gemm_phase<EpiInProj, SchedInProjA, true>(lds + RING_OFF, g, S, E); }
        { pg8::Gemm g8{(const bf16*)(p.ws + WS_HX8), (const bf16*)(p.ws + WS_WIN8), D, D}; SchedInProjG S; S.G = G; S.v = vcu; EpiInProjG E8{p.ws};
          pg8::gemm_phase<EpiInProjG, SchedInProjG, true>(lds + RING_OFF, g8, S, E8); }
#else
        SchedInProj S; S.G = G; S.v = vcu;
        pg8::gemm_phase<EpiInProj, SchedInProj, true>(lds + RING_OFF, g, S, E);
#endif
#if (((DUP_MASK) >> 2) & 1) && !INPROJ_GATE_FP8
        pg8::gemm_phase<EpiInProj, SchedInProj, true>(lds + RING_OFF, g, S, E);
#endif
    }
    SEAM(2);
    REP3 if (IN(3) && G == 256) {
        using attn_body::attn_unit2; using attn_body::attn_unit3; typedef attn_body::bf16 abf;
        const int x = vcu >> 5, j = vcu & 31;
        char* shm = (char*)lds_raw + RING_OFF;
        const int wslot = WSTAGGER ? (j % 5) : -1;
#define WSLOT(s) do { if (wslot == (s)) { ph_weights_share(p, vcu, G, lds); __syncthreads(); } } while (0)
#if ATT_FP8
        { const int b = x >> 2;
#pragma unroll 1
          for (int i = 0; i < 2 * (1 + (((DUP_MASK) >> 11) & 1)); ++i) {
            const int kvh = ATT_XCD_ROWS ? (i & 1) : (x >> 1) & 1, u = j + 32 * (i & 1), h = ATT_XCD_ROWS ? kvh * 4 + (j >> 3) : kvh * 4 + (x & 1) * 2 + (u >> 5), qb = ATT_XCD_ROWS ? (x & 3) * 8 + (j & 7) : u & 31;
            const size_t qrow = (size_t)b * SEQ + qb * 256;
            if (i < 2) { WSLOT(i);
            attn_body::ATT8_UNIT_A(p.ws + WS_QA + qrow * 512 + h * 64, p.ws + WS_KA + (size_t)b * SK * 128 + kvh * 64,
                p.ws + WS_VA + (size_t)((b * 2 + kvh) * (SK / 64)) * 4096, MERGE_FP8 ? (abf*)(p.ws + WS_AY + qrow * 1024 + h * 64) : (abf*)(p.ws + WS_AY) + qrow * 1024 + h * 64, shm); }
#if ((DUP_MASK) >> 11) & 1
            else attn_body::attn_unit8<64, true, SK / 64, 512, 128, 1024, 0, ABL_PROBE>(p.ws + WS_QA + qrow * 512 + h * 64, p.ws + WS_KA + (size_t)b * SK * 128 + kvh * 64,
                p.ws + WS_VA + (size_t)((b * 2 + kvh) * (SK / 64)) * 4096, (abf*)(p.ws + WS_HX8 + (size_t)(vcu >> 4) * 256 * 2048 + (size_t)(vcu & 15) * 128), shm);
#endif
            } }
        { const int b = x >> 2, h = ATT_XCD_ROWS ? (j >> 3) : (x & 3);
#pragma unroll 1
          for (int i = 0; i < 2 * (1 + (((DUP_MASK) >> 12) & 1)); ++i) { const int u = j + 32 * (i & 1), m = ATT_XCD_ROWS ? (i & 1) : u >> 5, qb = ATT_XCD_ROWS ? (x & 3) * 8 + (j & 7) : u & 31; const size_t qrow = (size_t)b * SEQ + qb * 256;
            if (i < 2) WSLOT(2 + i);
            attn_body::attn_unit8<128, ATT8_ONES_B, SK / 64, 512, 512, 512, 0>(p.ws + WS_QB + qrow * 512 + h * 128 + m * 64, p.ws + WS_KB + (size_t)b * SK * 512 + h * 128 + m * 64,
                p.ws + WS_VB + (size_t)((b * 4 + h) * (SK / 64)) * 8192, (abf*)(p.ws + WS_OB) + (size_t)m * T * 512 + qrow * 512 + h * 128, shm); } }
#else
        { const int b = x >> 2, kvh = (x >> 1) & 1;
#pragma unroll 1
          for (int i = 0; i < 2 * (1 + (((DUP_MASK) >> 11) & 1)); ++i) { const int u = j + 32 * (i & 1), h = kvh * 4 + (x & 1) * 2 + (u >> 5), qb = u & 31; const size_t qrow = (size_t)b * SEQ + qb * 256;
            WSLOT(i);
#if MERGE_FP8
            attn_unit2<64, ATT_ONES_A, SK / 64, 512, 128, 128, 1024, 1>((const abf*)(p.ws + WS_QA) + qrow * 512 + h * 64, (const abf*)(p.ws + WS_KA) + (size_t)b * SK * 128 + kvh * 64,
                (const abf*)(p.ws + WS_VA) + (size_t)b * SK * 128 + kvh * 64, (abf*)(p.ws + WS_AY + qrow * 1024 + h * 64), shm); } }
#else
            ATT_UNIT_A<64, ATT_ONES_A, SK / 64, 512, 128, 128, 1024>((const abf*)(p.ws + WS_QA) + qrow * 512 + h * 64, (const abf*)(p.ws + WS_KA) + (size_t)b * SK * 128 + kvh * 64,
                (const abf*)(p.ws + WS_VA) + (size_t)b * SK * 128 + kvh * 64, (abf*)(p.ws + WS_AY) + qrow * 1024 + h * 64, shm); } }
#endif
        { const int b = x >> 2, h = x & 3;
#pragma unroll 1
          for (int i = 0; i < 2 * (1 + (((DUP_MASK) >> 12) & 1)); ++i) { const int u = j + 32 * (i & 1), m = u >> 5, qb = u & 31; const size_t qrow = (size_t)b * SEQ + qb * 256;
            WSLOT(2 + i);
            ATT_UNIT_B<128, ATT_ONES_B, SK / 64, 512, 512, 512, 512>((const abf*)(p.ws + WS_QB) + qrow * 512 + h * 128 + m * 64, (const abf*)(p.ws + WS_KB) + (size_t)b * SK * 512 + h * 128 + m * 64,
                (const abf*)(p.ws + WS_VB) + (size_t)b * SK * 512 + h * 128, (abf*)(p.ws + WS_OB) + (size_t)m * T * 512 + qrow * 512 + h * 128, shm); } }
#endif
        if (FUSE_DIFFOUT) {
            asm volatile("s_waitcnt vmcnt(0)" ::: "memory"); __syncthreads();
            diffout_tile(p, (size_t)(x >> 2) * SEQ + (size_t)(ATT_XCD_ROWS ? (x & 3) * 8 + (j & 7) : j) * 256, ATT_XCD_ROWS ? (j >> 3) : (x & 3)); }
        WSLOT(4);
#undef WSLOT
    }
    if (!FUSE_DIFFOUT) SEAM(3);
    if (IN(4) && !FUSE_DIFFOUT) { ph_diffout(p, bx, G);
#if ((DUP_MASK) >> 4) & 1
        ph_diffout(p, bx, G);
#endif
    }
    if (ATT_XCD_ROWS && ATT_FP8 && FUSE_DIFFOUT) SEAM_L(4); else SEAM(4);
    if (IN(5)) {
        pg8::Gemm g{(const bf16*)(p.ws + WS_AY), (const bf16*)(p.ws + WS_WOA), 1024, 512}; SchedTile<2> S; S.G = G; S.v = vcu;
        EpiMerge E{(const bf16*)(p.ws + WS_G), (bf16*)(p.ws + WS_MERGED)};
        pg8::gemm_phase<EpiMerge, SchedTile<2>, true>(lds + RING_OFF, g, S, E);
#if ((DUP_MASK) >> 5) & 1
        pg8::gemm_phase<EpiMerge, SchedTile<2>, true>(lds + RING_OFF, g, S, E);
#endif
    }
    SEAM_L(5);
    if (IN(6)) {
        pg8::Gemm g{(const bf16*)(p.ws + WS_MERGED), (const bf16*)(p.ws + WS_WOUT), D, D}; SchedTile<1> S; S.G = G; S.v = vcu;
        EpiOut E{p.x, (const float*)(p.ws + WS_MOD), X1_BF16 ? (float*)(p.ws + WS_X1) : p.out};
        pg8::gemm_phase<EpiOut, SchedTile<1>, true>(lds + RING_OFF, g, S, E);
#if ((DUP_MASK) >> 6) & 1
        pg8::gemm_phase<EpiOut, SchedTile<1>, true>(lds + RING_OFF, g, S, E);
#endif
    }
    SEAM_L(6);
    if (IN(7)) ph_router2(p, vcu, G, lds_raw + RING_OFF, lds_raw + LDSCTL_OFF + 1024);
    SEAM(7);
    REP8 if (IN(8)) {
        expert_tables(p, tb);
        pg8::Gemm g{(const bf16*)(p.ws + WS_HM), (const bf16*)(p.ws + WS_WGU), D, D}; SchedMoe<8, true> S; S.G = G; S.v = vcu; S.tb = tb; S.tok = (const int*)(p.ws + WS_TOK);
        EpiMoe1 E{p.b_gate, p.b_up, (bf16*)(p.ws + WS_ACT), (const LAS unsigned char*)(lds + pg8::PF_OFF)};
        pg8::gemm_phase<EpiMoe1, SchedMoe<8, true>, true>(lds + RING_OFF, g, S, E);
    }
    if (MOE_XCD_BLOCKS) SEAM_L(8); else SEAM(8);
    REP9 if (IN(9)) {
        if (!IN(8)) expert_tables(p, tb);
        pg8::Gemm g{(const bf16*)(p.ws + WS_ACT), (const bf16*)(p.ws + WS_WD), D, D}; SchedMoe<4, false> S; S.G = G; S.v = vcu; S.tb = tb; S.tok = nullptr;
        EpiMoe2 E{p.b_down, (const float*)(p.ws + WS_SW), (const int*)(p.ws + WS_SDST), (bf16*)(p.ws + WS_Y), (const LAS unsigned char*)(lds + pg8::PF_OFF)};
        pg8::gemm_phase<EpiMoe2, SchedMoe<4, false>, true>(lds + RING_OFF, g, S, E);
    }
    SEAM(9);
    if (IN(10)) ph_combine(p, bx, G);
#undef IN
#undef SEAM
}

#ifndef FAST_MASK
#define FAST_MASK 0x7ff
#endif
extern "C" void kernel_launch(void* const* d_in, const int* in_sizes, int n_in, void* d_out, int out_size, void* d_ws, size_t ws_size, hipStream_t stream) {
    static int grid = 0;
    if (grid == 0) {
        if (n_in != 29 || out_size != T * D || ws_size < WS_END) { fprintf(stderr, "kernel_launch: unexpected shapes n_in %d out %d ws %zu\n", n_in, out_size, ws_size); grid = -1; return; }
        int dev = 0, cus = 0, per_cu = 0;
        if (hipGetDevice(&dev) != hipSuccess || hipDeviceGetAttribute(&cus, hipDeviceAttributeMultiprocessorCount, dev) != hipSuccess) { grid = -1; return; }
        if (hipFuncSetAttribute((const void*)mk_fwd, hipFuncAttributeMaxDynamicSharedMemorySize, LDS_BYTES) != hipSuccess) { fprintf(stderr, "kernel_launch: hipFuncSetAttribute failed\n"); grid = -1; return; }
        if (hipOccupancyMaxActiveBlocksPerMultiprocessor(&per_cu, (const void*)mk_fwd, NWAVES * 64, LDS_BYTES) != hipSuccess || per_cu < 1) fprintf(stderr, "kernel_launch: occupancy query reports %d\n", per_cu);
        (void)hipGetLastError();
        grid = cus;
        if (grid != 256) fprintf(stderr, "kernel_launch: %d CUs; the unit deals are built for 256\n", grid);
    }
    if (grid < 0) return;
    (void)hipMemsetAsync((char*)d_ws + WS_CTL, 0, CTL_BYTES, stream);
    Args a{};
    const float** f = (const float**)&a.p;
    for (int i = 0; i < 29; ++i) f[i] = (const float*)d_in[i];
    a.p.out = (float*)d_out; a.p.ws = (unsigned char*)d_ws;
    const P& p = a.p;
    const unsigned mask = (unsigned)(FAST_MASK) | 0x493u;
    int li = 0;
    for (int k = 0; k < N_PHASES;) {
        if (mask & (1u << k)) { int e = k; while (e < N_PHASES && (mask & (1u << e))) ++e;
            a.ph_lo = k; a.ph_hi = e; a.li = li++;
            hipLaunchKernelGGL(mk_fwd, dim3(grid), dim3(NWAVES * 64), LDS_BYTES, stream, a);
            k = e; continue; }
        switch (k) {
            case 2: nk_inproj<<<dim3(TK / 64, INC / 64), 256, 0, stream>>>(p); break;
            case 3: nk_attn<0><<<dim3(32, 16), 256, 0, stream>>>(p); nk_attn<1><<<dim3(32, 16), 256, 0, stream>>>(p); break;
            case 5: nk_merge<<<dim3(T / 64, D / 64), 256, 0, stream>>>(p); break;
            case 6: nk_outproj<<<dim3(T / 64, D / 64), 256, 0, stream>>>(p); break;
            case 8: nk_moe1<<<4096, 256, 0, stream>>>(p); break;
            case 9: nk_moe2<<<4096, 256, 0, stream>>>(p); break;
            default: break;
        }
        ++k;
    }
}
```

```cpp
#include <hip/hip_runtime.h>
#include <cstdio>
#include <cstdint>

constexpr int D = 1024, NB = 2, SEQ = 8192, CL = 256, T = NB * SEQ  , SK = SEQ + CL  , TK = NB * SK  ;
constexpr int INC = 4352, NE = 32, NMOD = 6 * D;
constexpr float C2 = 0.125f * 1.4426950408889634f;
constexpr int ECAP = 16384;
#ifndef MOE_FP8
#define MOE_FP8 1
#endif
#ifndef INPROJ_FP8_ALL
#define INPROJ_FP8_ALL 1
#endif
#ifndef INPROJ_GATE_FP8
#define INPROJ_GATE_FP8 1
#endif
#ifndef Y_FP8
#define Y_FP8 1
#endif
#ifndef ATT_FP8
#define ATT_FP8 1
#endif
#ifndef MOE_XCD_BLOCKS
#define MOE_XCD_BLOCKS 1
#endif
#ifndef INPROJ_XCD_BLOCKS
#define INPROJ_XCD_BLOCKS 1
#endif
#ifndef EPI_PREFETCH
#define EPI_PREFETCH 1
#endif
#ifndef MERGE_FP8
#define MERGE_FP8 1
#endif
constexpr float W8_SCALE = 256.0f, ACT8_SCALE = 4.0f, Y8_SCALE = 16.0f, YA8_SCALE = 64.0f, MG8_SCALE = 16.0f;
__device__ __forceinline__ unsigned pk4_fp8(float a, float b, float c, float d) {
    a = __builtin_amdgcn_fmed3f(a, -448.0f, 448.0f); b = __builtin_amdgcn_fmed3f(b, -448.0f, 448.0f); c = __builtin_amdgcn_fmed3f(c, -448.0f, 448.0f); d = __builtin_amdgcn_fmed3f(d, -448.0f, 448.0f);
    int r = __builtin_amdgcn_cvt_pk_fp8_f32(a, b, 0, false); r = __builtin_amdgcn_cvt_pk_fp8_f32(c, d, r, true); return (unsigned)r;
}

typedef unsigned short bf16;
typedef float f32x4 __attribute__((ext_vector_type(4)));
#define GAS __attribute__((address_space(1)))
#define LAS __attribute__((address_space(3)))

constexpr size_t MiB = 1u << 20;
constexpr size_t WS_CTL = 0, CTL_BYTES = 1 * MiB;
constexpr size_t WS_MOD = 1 * MiB;
constexpr size_t WS_LAM = 1 * MiB + 128 * 1024;
constexpr size_t WS_WP = 1 * MiB + 256 * 1024;
constexpr size_t WS_CST = 1 * MiB + 768 * 1024;
constexpr size_t WS_WIN = 2 * MiB;
constexpr size_t WS_WOA = 11 * MiB, WS_WOB = 12 * MiB, WS_WOUT = 13 * MiB;
constexpr size_t WS_WD = 16 * MiB;
constexpr size_t WS_WGU = 80 * MiB;
constexpr size_t WS_Y = 80 * MiB;
constexpr size_t WS_HX8 = 144 * MiB;
constexpr size_t WS_HX = 208 * MiB;
constexpr size_t WS_MERGED = 208 * MiB;
constexpr size_t WS_QA = 241 * MiB, WS_QB = 257 * MiB, WS_KA = 273 * MiB, WS_VA = 278 * MiB, WS_KB = 283 * MiB, WS_VB = 300 * MiB;
constexpr size_t WS_G = 317 * MiB;
constexpr size_t WS_ACT = 208 * MiB;
constexpr size_t WS_AY = 381 * MiB;
constexpr size_t WS_OB = 413 * MiB, WS_HM = 445 * MiB;
constexpr size_t WS_TMP = 241 * MiB;
constexpr size_t WS_TOK = 477 * MiB, WS_SW = 479 * MiB, WS_SDST = 481 * MiB;
#ifndef G_U8
#define G_U8 1
#endif
#ifndef X1_BF16
#define X1_BF16 1
#endif
constexpr size_t WS_X1 = 168 * MiB;
constexpr size_t WS_TRASH = 484 * MiB;
constexpr size_t WS_END = 485 * MiB;
constexpr int CW_CNT = 1024;

struct P {
    const float *x, *c, *ctx, *c_ctx, *w_ada, *b_ada, *norm_attn, *w_in, *q_norm_a, *k_norm_a, *q_norm_b, *k_norm_b, *lq1, *lk1, *lq2, *lk2, *subln,
        *w_oa, *w_ob, *w_out, *norm_mlp, *router_w, *router_b, *w_gate, *b_gate, *w_up, *b_up, *w_down, *b_down;
    float* out; unsigned char* ws;
};

__device__ __forceinline__ float bf2f(bf16 h) { return __uint_as_float((unsigned)h << 16); }
__device__ __forceinline__ unsigned f2bf(float f) { unsigned u = __float_as_uint(f); return (u + 0x7fffu + ((u >> 16) & 1u)) >> 16; }
__device__ __forceinline__ unsigned pk2(float lo, float hi) { return f2bf(lo) | (f2bf(hi) << 16); }
__device__ __forceinline__ float wave_sum(float v) {
#pragma unroll
    for (int o = 1; o < 64; o <<= 1) v += __shfl_xor(v, o);
    return v;
}
__device__ __forceinline__ float sigmoidf_(float v) { return 1.0f / (1.0f + __expf(-v)); }
__device__ __forceinline__ void rope_cs(float pos, int j, float& c, float& s) {
    const float inv_rev = exp2f(-(float)j * (13.287712379549449f / 16.0f)) * 0.15915494309189535f;
    float rev = pos * inv_rev; rev = rev - floorf(rev);
    c = __builtin_amdgcn_cosf(rev); s = __builtin_amdgcn_sinf(rev);
}

__device__ __forceinline__ void ph_mod(const P& p, int vb, int nvb, float* lds) {
    const int t = threadIdx.x, c4 = t & 7, rg = t >> 3;
    float* MOD = (float*)(p.ws + WS_MOD);
    for (int it = vb; it < NMOD / 32; it += nvb) {
        const int n0 = it * 32 + c4 * 4;
        f32x4 a0 = {0, 0, 0, 0}, a1 = a0, a2 = a0;
        for (int k = rg; k < D; k += 64) {
            const f32x4 w = *(const f32x4*)(p.w_ada + (size_t)k * NMOD + n0);
            const float c0 = p.c[k], c1 = p.c[D + k], cc = p.c_ctx[k];
            a0 += w * (c0 * sigmoidf_(c0)); a1 += w * (c1 * sigmoidf_(c1)); a2 += w * (cc * sigmoidf_(cc));
        }
        __syncthreads();
#pragma unroll
        for (int j = 0; j < 4; ++j) { lds[(rg * 3 + 0) * 32 + c4 * 4 + j] = a0[j]; lds[(rg * 3 + 1) * 32 + c4 * 4 + j] = a1[j]; lds[(rg * 3 + 2) * 32 + c4 * 4 + j] = a2[j]; }
        __syncthreads();
        if (t < 96) { const int v = t >> 5, cI = t & 31; float s = 0.f; for (int r = 0; r < 64; ++r) s += lds[(r * 3 + v) * 32 + cI]; MOD[v * NMOD + it * 32 + cI] = s + p.b_ada[it * 32 + cI]; }
    }
    if (vb == 0 && t < 64) {
        float a = p.lq1[t] * p.lk1[t], b = p.lq2[t] * p.lk2[t];
        a = wave_sum(a); b = wave_sum(b);
        if (t == 0) *(float*)(p.ws + WS_LAM) = expf(a) - expf(b) + 0.2f;
    }
}

__device__ __forceinline__ void ph_norm1_row(const P& p, int r, int lane, const f32x4 (&v)[4], const f32x4 (&gq)[4], const f32x4 (&shq)[4]) {
    bf16* HX = (bf16*)(p.ws + WS_HX);
    float ss = 0.f;
#pragma unroll
    for (int j = 0; j < 4; ++j) ss += (v[j].x * v[j].x + v[j].y * v[j].y) + (v[j].z * v[j].z + v[j].w * v[j].w);
    const float rstd = 1.0f / sqrtf(wave_sum(ss) * (1.0f / D) + 1e-6f);
#pragma unroll
    for (int j = 0; j < 4; ++j) { const int n = 4 * (64 * j + lane);
        const f32x4 h = (v[j] * rstd) * gq[j] + shq[j];
        if (!INPROJ_FP8_ALL) { uint2 o; o.x = pk2(h.x, h.y); o.y = pk2(h.z, h.w); *(uint2*)(HX + (size_t)r * D + n) = o; }
        if (INPROJ_GATE_FP8) *(unsigned*)(p.ws + WS_HX8 + (size_t)r * D + n) = pk4_fp8(h.x, h.y, h.z, h.w); }
}
__device__ __forceinline__ void ph_norm1_load(const P& p, int vb, f32x4 (&vq)[8][4]) {
    int lane = threadIdx.x & 63; asm volatile("" : "+v"(lane));
    const int x = vb >> 5, w = (vb & 31) * 8 + (threadIdx.x >> 6), b = x >> 2;
    const int rb = (8 * x + (x >= 4 ? 1 : 0)) * 256;
#pragma unroll
    for (int k = 0; k < 8; ++k) { const int r = rb + w + 256 * k, t = r % SK; const float* src = p.x + ((size_t)b * SEQ + t) * D;
#pragma unroll
        for (int j = 0; j < 4; ++j) vq[k][j] = *(const f32x4*)(src + 4 * (64 * j + lane)); }
}
__device__ __forceinline__ void ph_norm1_finish(const P& p, int vb, const f32x4 (&vq)[8][4]) {
    int lane = threadIdx.x & 63; asm volatile("" : "+v"(lane));
    const int x = vb >> 5, w = (vb & 31) * 8 + (threadIdx.x >> 6), b = x >> 2;
    const float* MOD = (const float*)(p.ws + WS_MOD);
    const int rb = (8 * x + (x >= 4 ? 1 : 0)) * 256, cb = ((x & 3) == 3) ? (x == 3 ? 32 : 65) * 256 : -1;
    const float* mv = MOD + b * NMOD; f32x4 gq[4], shq[4];
#pragma unroll
    for (int j = 0; j < 4; ++j) { const int n = 4 * (64 * j + lane); gq[j] = *(const f32x4*)(p.norm_attn + n) * (*(const f32x4*)(mv + D + n) + 1.0f); shq[j] = *(const f32x4*)(mv + n); }
#pragma unroll
    for (int k = 0; k < 8; ++k) ph_norm1_row(p, rb + w + 256 * k, lane, vq[k], gq, shq);
    if (cb >= 0) { const int r = cb + w, t = r % SK; const float* src = p.ctx + ((size_t)b * CL + (t - SEQ)) * D; const float* mc = MOD + 2 * NMOD; f32x4 v[4];
#pragma unroll
        for (int j = 0; j < 4; ++j) { const int n = 4 * (64 * j + lane); v[j] = *(const f32x4*)(src + n); gq[j] = *(const f32x4*)(p.norm_attn + n) * (*(const f32x4*)(mc + D + n) + 1.0f); shq[j] = *(const f32x4*)(mc + n); }
        ph_norm1_row(p, r, lane, v, gq, shq); }
}
__device__ __forceinline__ void ph_norm1(const P& p, int vb, int nvb) {
    const int lane = threadIdx.x & 63, gw = vb * 8 + (threadIdx.x >> 6), ngw = nvb * 8;
    const float* MOD = (const float*)(p.ws + WS_MOD);
    const bool blk = INPROJ_XCD_BLOCKS && nvb == 256; const int x = vb >> 5, w = (vb & 31) * 8 + (threadIdx.x >> 6);
    const int rb = (8 * x + (x >= 4 ? 1 : 0)) * 256, cb = ((x & 3) == 3) ? (x == 3 ? 32 : 65) * 256 : -1;
    if (blk) {
        const int b = x >> 2; const float* mv = MOD + b * NMOD; f32x4 gq[4], shq[4];
#pragma unroll
        for (int j = 0; j < 4; ++j) { const int n = 4 * (64 * j + lane); gq[j] = *(const f32x4*)(p.norm_attn + n) * (*(const f32x4*)(mv + D + n) + 1.0f); shq[j] = *(const f32x4*)(mv + n); }
#pragma unroll
        for (int k0 = 0; k0 < 8; k0 += 4) { f32x4 vq[4][4];
#pragma unroll
            for (int k = 0; k < 4; ++k) { const int r = rb + w + 256 * (k0 + k), t = r % SK; const float* src = p.x + ((size_t)b * SEQ + t) * D;
#pragma unroll
                for (int j = 0; j < 4; ++j) vq[k][j] = *(const f32x4*)(src + 4 * (64 * j + lane)); }
#pragma unroll
            for (int k = 0; k < 4; ++k) ph_norm1_row(p, rb + w + 256 * (k0 + k), lane, vq[k], gq, shq); }
        if (cb >= 0) { const int r = cb + w, t = r % SK; const float* src = p.ctx + ((size_t)b * CL + (t - SEQ)) * D; const float* mc = MOD + 2 * NMOD; f32x4 v[4];
#pragma unroll
            for (int j = 0; j < 4; ++j) { const int n = 4 * (64 * j + lane); v[j] = *(const f32x4*)(src + n); gq[j] = *(const f32x4*)(p.norm_attn + n) * (*(const f32x4*)(mc + D + n) + 1.0f); shq[j] = *(const f32x4*)(mc + n); }
            ph_norm1_row(p, r, lane, v, gq, shq); }
        return;
    }
    for (int r = gw; r < TK; r += ngw) {
        const int b = r / SK, t = r % SK; const bool isctx = t >= SEQ;
        const float* src = isctx ? p.ctx + ((size_t)b * CL + (t - SEQ)) * D : p.x + ((size_t)b * SEQ + t) * D;
        const float* mv = MOD + (isctx ? 2 : b) * NMOD;
        f32x4 v[4], gq[4], shq[4];
#pragma unroll
        for (int j = 0; j < 4; ++j) { const int n = 4 * (64 * j + lane); v[j] = *(const f32x4*)(src + n); gq[j] = *(const f32x4*)(p.norm_attn + n) * (*(const f32x4*)(mv + D + n) + 1.0f); shq[j] = *(const f32x4*)(mv + n); }
        ph_norm1_row(p, r, lane, v, gq, shq);
    }
}

__device__ __forceinline__ void diffout_tile(const P& p, size_t qrow0, int hh) {
    const int lane = threadIdx.x & 63, wave = threadIdx.x >> 6;
    const bf16* OB = (const bf16*)(p.ws + WS_OB); bf16* YB = (bf16*)(p.ws + WS_AY) + 512;
    const float lam = *(const float*)(p.ws + WS_LAM);
    const int e0 = (lane & 15) * 8;
    float sg[8];
#pragma unroll
    for (int j = 0; j < 8; ++j) sg[j] = p.subln[e0 + j];
#pragma unroll 2
    for (int it = 0; it < 8; ++it) {
        const size_t r = qrow0 + wave * 32 + it * 4 + (lane >> 4); const size_t off = r * 512 + hh * 128 + e0;
        const uint4 a = *(const uint4*)(OB + off), b = *(const uint4*)(OB + (size_t)T * 512 + off);
        const unsigned aw[4] = {a.x, a.y, a.z, a.w}, bw[4] = {b.x, b.y, b.z, b.w};
        float d[8]; float ss = 0.f;
#pragma unroll
        for (int j = 0; j < 4; ++j) { d[2 * j] = __uint_as_float(aw[j] << 16) - lam * __uint_as_float(bw[j] << 16); d[2 * j + 1] = __uint_as_float(aw[j] & 0xffff0000u) - lam * __uint_as_float(bw[j] & 0xffff0000u);
            ss += d[2 * j] * d[2 * j] + d[2 * j + 1] * d[2 * j + 1]; }
        ss += __shfl_xor(ss, 1); ss += __shfl_xor(ss, 2); ss += __shfl_xor(ss, 4); ss += __shfl_xor(ss, 8);
        const float rstd = 1.0f / sqrtf(ss * (1.0f / 128.0f) + 1e-5f) * 0.8f;
        if (MERGE_FP8) { uint2 w; w.x = pk4_fp8(d[0] * rstd * sg[0], d[1] * rstd * sg[1], d[2] * rstd * sg[2], d[3] * rstd * sg[3]); w.y = pk4_fp8(d[4] * rstd * sg[4], d[5] * rstd * sg[5], d[6] * rstd * sg[6], d[7] * rstd * sg[7]);
            *(uint2*)(p.ws + WS_AY + r * 1024 + 512 + hh * 128 + e0) = w; }
        else { uint4 w; w.x = pk2(d[0] * rstd * sg[0], d[1] * rstd * sg[1]); w.y = pk2(d[2] * rstd * sg[2], d[3] * rstd * sg[3]); w.z = pk2(d[4] * rstd * sg[4], d[5] * rstd * sg[5]); w.w = pk2(d[6] * rstd * sg[6], d[7] * rstd * sg[7]);
        *(uint4*)(YB + r * 1024 + hh * 128 + e0) = w; }
    }
}

__device__ __forceinline__ void ph_router_prep(const P& p, int vb, int nvb) {
    const float* MOD = (const float*)(p.ws + WS_MOD); float* WP = (float*)(p.ws + WS_WP); float* CST = (float*)(p.ws + WS_CST);
    for (int idx = vb * 512 + threadIdx.x; idx < 2 * 8192; idx += nvb * 512) {
        const int b = idx >> 13, q = idx & 8191, j = q & 31, kb = 8 * (q >> 6) + 4 * ((q >> 5) & 1); f32x4 o;
#pragma unroll
        for (int s = 0; s < 4; ++s) { const int k = kb + s; o[s] = p.norm_mlp[k] * (1.0f + MOD[b * NMOD + 4 * D + k]) * p.router_w[k * NE + j]; }
        *(f32x4*)(WP + (size_t)b * 32768 + q * 4) = o;
    }
    if (vb == 0) { const int lane = threadIdx.x & 63, wave = threadIdx.x >> 6;
        for (int q = wave; q < 64; q += 8) { const int b = q >> 5, e = q & 31; float s = 0.f;
            for (int k = lane; k < D; k += 64) s += MOD[b * NMOD + 3 * D + k] * p.router_w[k * NE + e];
            s = wave_sum(s); if (lane == 0) CST[b * 32 + e] = s + p.router_b[e]; } }
}

__device__ __forceinline__ void ph_diffout(const P& p, int vb, int nvb) {
    const int lane = threadIdx.x & 63, gw = vb * 8 + (threadIdx.x >> 6), ngw = nvb * 8;
    const bf16* OB = (const bf16*)(p.ws + WS_OB); bf16* YB = (bf16*)(p.ws + WS_AY) + 512;
    const float lam = *(const float*)(p.ws + WS_LAM);
    for (int r = gw; r < T; r += ngw) {
        const uint4 a = *(const uint4*)(OB + (size_t)r * 512 + lane * 8), b = *(const uint4*)(OB + (size_t)T * 512 + (size_t)r * 512 + lane * 8);
        const unsigned aw[4] = {a.x, a.y, a.z, a.w}, bw[4] = {b.x, b.y, b.z, b.w};
        float d[8]; float ss = 0.f;
#pragma unroll
        for (int j = 0; j < 4; ++j) { d[2 * j] = __uint_as_float(aw[j] << 16) - lam * __uint_as_float(bw[j] << 16); d[2 * j + 1] = __uint_as_float(aw[j] & 0xffff0000u) - lam * __uint_as_float(bw[j] & 0xffff0000u);
            ss += d[2 * j] * d[2 * j] + d[2 * j + 1] * d[2 * j + 1]; }
        ss += __shfl_xor(ss, 1); ss += __shfl_xor(ss, 2); ss += __shfl_xor(ss, 4); ss += __shfl_xor(ss, 8);
        const float rstd = 1.0f / sqrtf(ss * (1.0f / 128.0f) + 1e-5f) * 0.8f;
        const int e0 = (lane & 15) * 8; float o[8];
#pragma unroll
        for (int j = 0; j < 8; ++j) o[j] = d[j] * rstd * p.subln[e0 + j];
        if (MERGE_FP8) { uint2 w; w.x = pk4_fp8(o[0], o[1], o[2], o[3]); w.y = pk4_fp8(o[4], o[5], o[6], o[7]); *(uint2*)(p.ws + WS_AY + (size_t)r * 1024 + 512 + lane * 8) = w; }
        else { uint4 w; w.x = pk2(o[0], o[1]); w.y = pk2(o[2], o[3]); w.z = pk2(o[4], o[5]); w.w = pk2(o[6], o[7]);
        *(uint4*)(YB + (size_t)r * 1024 + lane * 8) = w; }
    }
}

__device__ __forceinline__ f32x4 x1_ld4(const P& p, size_t e) {
    if (X1_BF16) { const uint2 w = *(const uint2*)((const bf16*)(p.ws + WS_X1) + e);
        return (f32x4){__uint_as_float(w.x << 16), __uint_as_float(w.x & 0xffff0000u), __uint_as_float(w.y << 16), __uint_as_float(w.y & 0xffff0000u)}; }
    return *(const f32x4*)(p.out + e);
}
__device__ __forceinline__ void ph_router2(const P& p, int vb, int nvb, unsigned char* ldsb, unsigned char* smb) {
    typedef float f32x16_ __attribute__((ext_vector_type(16)));
    const int t = threadIdx.x, lane = t & 63, wave = t >> 6;
    float* wl = (float*)ldsb;
    float* part = (float*)ldsb;
    float* lgt = (float*)ldsb + 8192;
    float* rstd_s = (float*)smb; int* sel_e = (int*)(smb + 256); float* sel_w = (float*)(smb + 1280); int* hist = (int*)(smb + 2304); int* gbase = hist + 32; int* lpos = hist + 64;
    const float* MOD = (const float*)(p.ws + WS_MOD); bf16* HM = (bf16*)(p.ws + WS_HM);
    unsigned* CNT = (unsigned*)(p.ws + WS_CTL) + CW_CNT;
    int* TOK = (int*)(p.ws + WS_TOK); float* SW = (float*)(p.ws + WS_SW); int* SDST = (int*)(p.ws + WS_SDST);
    for (int it = vb; it < T / 64; it += nvb) {
        const int b = it / (SEQ / 64);
        __syncthreads();
        { const f32x4* src = (const f32x4*)((const float*)(p.ws + WS_WP) + (size_t)b * 32768);
#pragma unroll
          for (int i = 0; i < 16; ++i) ((f32x4*)wl)[t + 512 * i] = src[t + 512 * i]; }
        if (t < 32) hist[t] = 0;
        f32x4 gq[4], shq[4];
        { const float* mv = MOD + b * NMOD;
#pragma unroll
          for (int j = 0; j < 4; ++j) { const int n = 4 * (64 * j + lane); gq[j] = *(const f32x4*)(p.norm_mlp + n) * (*(const f32x4*)(mv + 4 * D + n) + 1.0f); shq[j] = *(const f32x4*)(mv + 3 * D + n); } }
        f32x4 vq[8][4];
#pragma unroll
        for (int rr = 0; rr < 8; ++rr) { const size_t src = (size_t)(it * 64 + wave * 8 + rr) * D;
#pragma unroll
            for (int j = 0; j < 4; ++j) vq[rr][j] = x1_ld4(p, src + 4 * (64 * j + lane)); }
#pragma unroll
        for (int rr = 0; rr < 8; ++rr) {
            const int rl = wave * 8 + rr, r = it * 64 + rl;
            f32x4 v[4]; float ss = 0.f;
#pragma unroll
            for (int j = 0; j < 4; ++j) { v[j] = vq[rr][j]; ss += (v[j].x * v[j].x + v[j].y * v[j].y) + (v[j].z * v[j].z + v[j].w * v[j].w); }
            const float rstd = 1.0f / sqrtf(wave_sum(ss) * (1.0f / D) + 1e-6f);
#pragma unroll
            for (int j = 0; j < 4; ++j) { const int n = 4 * (64 * j + lane);
                const f32x4 h = (v[j] * rstd) * gq[j] + shq[j];
                if (MOE_FP8) *(unsigned*)((unsigned char*)HM + (size_t)r * D + n) = pk4_fp8(h.x, h.y, h.z, h.w);
                else { uint2 o; o.x = pk2(h.x, h.y); o.y = pk2(h.z, h.w); *(uint2*)(HM + (size_t)r * D + n) = o; } }
            if (lane == 0) rstd_s[rl] = rstd;
        }
        __syncthreads();
        { const int r32 = lane & 31, hh = lane >> 5, rt = wave & 1, kq = wave >> 1;
          const size_t arow = (size_t)(it * 64 + rt * 32 + r32) * D + kq * 256 + 4 * hh;
          const float* bl = wl + ((size_t)(kq * 32) * 64 + hh * 32 + r32) * 4;
          f32x16_ acc = {0.f, 0.f, 0.f, 0.f, 0.f, 0.f, 0.f, 0.f, 0.f, 0.f, 0.f, 0.f, 0.f, 0.f, 0.f, 0.f};
#pragma unroll 1
          for (int c8 = 0; c8 < 32; c8 += 8) {
              f32x4 av[8];
#pragma unroll
              for (int i = 0; i < 8; ++i) av[i] = x1_ld4(p, arow + (c8 + i) * 8);
#pragma unroll
              for (int i = 0; i < 8; ++i) { const f32x4 bv = *(const f32x4*)(bl + (size_t)(c8 + i) * 256);
#pragma unroll
                  for (int s = 0; s < 4; ++s) acc = __builtin_amdgcn_mfma_f32_32x32x2f32(av[i][s], bv[s], acc, 0, 0, 0); }
          }
          __syncthreads();
#pragma unroll
          for (int r = 0; r < 16; ++r) part[wave * 1024 + ((r & 3) + 8 * (r >> 2) + 4 * hh) * 32 + r32] = acc[r];
        }
        __syncthreads();
        for (int i = t; i < 2048; i += 512) { const int row = i >> 5, e = i & 31, rt = row >> 5, rw = row & 31;
            lgt[row * 33 + e] = (part[(0 + rt) * 1024 + rw * 32 + e] + part[(2 + rt) * 1024 + rw * 32 + e]) + (part[(4 + rt) * 1024 + rw * 32 + e] + part[(6 + rt) * 1024 + rw * 32 + e]); }
        __syncthreads();
        if (t < 64) {
            const float rs = rstd_s[t]; const float* cst = (const float*)(p.ws + WS_CST) + b * 32;
            float lg[32];
#pragma unroll
            for (int e = 0; e < 32; ++e) lg[e] = lgt[t * 33 + e] * rs + cst[e];
            unsigned used = 0u; float tv[4]; int ti[4];
#pragma unroll
            for (int q = 0; q < 4; ++q) { float best = -INFINITY; int bi = 0;
#pragma unroll
                for (int e = 0; e < 32; ++e) { const float c = ((used >> e) & 1u) ? -INFINITY : lg[e]; if (c > best) { best = c; bi = e; } }
                tv[q] = best; ti[q] = bi; used |= 1u << bi; }
            const float e1 = __expf(tv[1] - tv[0]), e2 = __expf(tv[2] - tv[0]), e3 = __expf(tv[3] - tv[0]); const float inv = 1.0f / (1.0f + e1 + e2 + e3);
            sel_e[t * 4 + 0] = ti[0]; sel_e[t * 4 + 1] = ti[1]; sel_e[t * 4 + 2] = ti[2]; sel_e[t * 4 + 3] = ti[3];
            sel_w[t * 4 + 0] = inv; sel_w[t * 4 + 1] = e1 * inv; sel_w[t * 4 + 2] = e2 * inv; sel_w[t * 4 + 3] = e3 * inv;
        }
        __syncthreads();
        if (t < 256) lpos[t] = atomicAdd(&hist[sel_e[t]], 1);
        __syncthreads();
        if (t < 32) gbase[t] = (int)__hip_atomic_fetch_add(CNT + 64 * t, (unsigned)hist[t], __ATOMIC_RELAXED, __HIP_MEMORY_SCOPE_AGENT);
        __syncthreads();
        if (t < 256) { const int e = sel_e[t], pos = gbase[e] + lpos[t], tok = it * 64 + (t >> 2);
            TOK[e * ECAP + pos] = tok; SW[e * ECAP + pos] = sel_w[t]; SDST[e * ECAP + pos] = tok * 4 + (t & 3); }
    }
}

__device__ __forceinline__ void ph_combine_xload(const P& p, int vb, int nvb, uint4 (&xw)[16]) {
    const bf16* X1 = (const bf16*)(p.ws + WS_X1);
#pragma unroll
    for (int k = 0; k < 16; ++k) { const size_t i = (size_t)vb * 512 + threadIdx.x + (size_t)k * nvb * 512; xw[k] = *(const uint4*)(X1 + i * 8); }
}
__device__ __forceinline__ void ph_combine_pre(const P& p, int vb, int nvb, const uint4 (&xw)[16]) {
    typedef float f32x2_ __attribute__((ext_vector_type(2)));
    const float* MOD = (const float*)(p.ws + WS_MOD); const unsigned char* Y = p.ws + WS_Y;
#pragma unroll
    for (int k = 0; k < 16; ++k) { const size_t i = (size_t)vb * 512 + threadIdx.x + (size_t)k * nvb * 512;
        const size_t tok = i / (D / 8); const int n = (int)(i % (D / 8)) * 8; const int b = (int)(tok / SEQ);
        float s[8] = {0, 0, 0, 0, 0, 0, 0, 0};
#pragma unroll
        for (int q = 0; q < 4; ++q) { const uint2 y = *(const uint2*)(Y + (tok * 4 + q) * D + n);
            const f32x2_ a0 = __builtin_amdgcn_cvt_pk_f32_fp8((int)y.x, false), a1 = __builtin_amdgcn_cvt_pk_f32_fp8((int)y.x, true), a2 = __builtin_amdgcn_cvt_pk_f32_fp8((int)y.y, false), a3 = __builtin_amdgcn_cvt_pk_f32_fp8((int)y.y, true);
            s[0] += a0.x; s[1] += a0.y; s[2] += a1.x; s[3] += a1.y; s[4] += a2.x; s[5] += a2.y; s[6] += a3.x; s[7] += a3.y; }
#pragma unroll
        for (int j = 0; j < 8; ++j) s[j] *= 1.0f / Y8_SCALE;
        float* o = p.out + tok * D + n; const float* gm = MOD + b * NMOD + 5 * D + n; const uint4 w = xw[k];
        f32x4 o0 = (f32x4){__uint_as_float(w.x << 16), __uint_as_float(w.x & 0xffff0000u), __uint_as_float(w.y << 16), __uint_as_float(w.y & 0xffff0000u)};
        f32x4 o1 = (f32x4){__uint_as_float(w.z << 16), __uint_as_float(w.z & 0xffff0000u), __uint_as_float(w.w << 16), __uint_as_float(w.w & 0xffff0000u)};
        const f32x4 g0 = *(const f32x4*)gm, g1 = *(const f32x4*)(gm + 4);
        o0 += g0 * (f32x4){s[0], s[1], s[2], s[3]}; o1 += g1 * (f32x4){s[4], s[5], s[6], s[7]};
        *(f32x4*)o = o0; *(f32x4*)(o + 4) = o1; }
}
__device__ __forceinline__ void ph_combine(const P& p, int vb, int nvb) {
    const float* MOD = (const float*)(p.ws + WS_MOD); const bf16* Y = (const bf16*)(p.ws + WS_Y);
    const size_t n8 = (size_t)T * D / 8;
    for (size_t i = (size_t)vb * 512 + threadIdx.x; i < n8; i += (size_t)nvb * 512) {
        const size_t tok = i / (D / 8); const int n = (int)(i % (D / 8)) * 8; const int b = (int)(tok / SEQ);
        float s[8] = {0, 0, 0, 0, 0, 0, 0, 0};
#pragma unroll
        for (int k = 0; k < 4; ++k) {
            if (Y_FP8) { typedef float f32x2_ __attribute__((ext_vector_type(2)));
                const uint2 y = *(const uint2*)((const unsigned char*)Y + (tok * 4 + k) * D + n);
                const f32x2_ a0 = __builtin_amdgcn_cvt_pk_f32_fp8((int)y.x, false), a1 = __builtin_amdgcn_cvt_pk_f32_fp8((int)y.x, true), a2 = __builtin_amdgcn_cvt_pk_f32_fp8((int)y.y, false), a3 = __builtin_amdgcn_cvt_pk_f32_fp8((int)y.y, true);
                s[0] += a0.x; s[1] += a0.y; s[2] += a1.x; s[3] += a1.y; s[4] += a2.x; s[5] += a2.y; s[6] += a3.x; s[7] += a3.y;
            } else { const uint4 y = *(const uint4*)(Y + (tok * 4 + k) * D + n); const unsigned w[4] = {y.x, y.y, y.z, y.w};
#pragma unroll
            for (int j = 0; j < 4; ++j) { s[2 * j] += __uint_as_float(w[j] << 16); s[2 * j + 1] += __uint_as_float(w[j] & 0xffff0000u); } } }
        if (Y_FP8) {
#pragma unroll
            for (int j = 0; j < 8; ++j) s[j] *= 1.0f / Y8_SCALE; }
        float* o = p.out + tok * D + n; const float* gm = MOD + b * NMOD + 5 * D + n;
        f32x4 o0, o1;
        if (X1_BF16) { const uint4 w = *(const uint4*)((const bf16*)(p.ws + WS_X1) + tok * D + n);
            o0 = (f32x4){__uint_as_float(w.x << 16), __uint_as_float(w.x & 0xffff0000u), __uint_as_float(w.y << 16), __uint_as_float(w.y & 0xffff0000u)};
            o1 = (f32x4){__uint_as_float(w.z << 16), __uint_as_float(w.z & 0xffff0000u), __uint_as_float(w.w << 16), __uint_as_float(w.w & 0xffff0000u)}; }
        else { o0 = *(f32x4*)o; o1 = *(f32x4*)(o + 4); }
        const f32x4 g0 = *(const f32x4*)gm, g1 = *(const f32x4*)(gm + 4);
        o0 += g0 * (f32x4){s[0], s[1], s[2], s[3]}; o1 += g1 * (f32x4){s[4], s[5], s[6], s[7]};
        *(f32x4*)o = o0; *(f32x4*)(o + 4) = o1;
    }
}

template <class FA, class FB>
__device__ __forceinline__ void ngemm_acc(float (&acc)[4][4], float* sA, float* sB, int K, FA fa, FB fb) {
    const int t = threadIdx.x, tx = t & 15, ty = t >> 4;
    for (int k0 = 0; k0 < K; k0 += 16) {
#pragma unroll
        for (int i = 0; i < 4; ++i) { const int idx = t + 256 * i; sA[(idx & 15) * 68 + (idx >> 4)] = fa(idx >> 4, k0 + (idx & 15)); }
#pragma unroll
        for (int i = 0; i < 4; ++i) { const int idx = t + 256 * i; sB[(idx >> 6) * 68 + (idx & 63)] = fb(k0 + (idx >> 6), idx & 63); }
        __syncthreads();
#pragma unroll
        for (int kk = 0; kk < 16; ++kk) { const f32x4 a = *(const f32x4*)(sA + kk * 68 + ty * 4), b = *(const f32x4*)(sB + kk * 68 + tx * 4);
#pragma unroll
            for (int i = 0; i < 4; ++i)
#pragma unroll
                for (int j = 0; j < 4; ++j) acc[i][j] += a[i] * b[j]; }
        __syncthreads();
    }
}
#define ZERO_ACC(acc) _Pragma("unroll") for (int i_ = 0; i_ < 4; ++i_) _Pragma("unroll") for (int j_ = 0; j_ < 4; ++j_) acc[i_][j_] = 0.f

__global__ void __launch_bounds__(256) nk_inproj(P p) {
    __shared__ __attribute__((aligned(16))) float sA[16 * 68]; __shared__ __attribute__((aligned(16))) float sB[16 * 68]; __shared__ float Cs[64 * 65];
    const int rt = blockIdx.x, cb = blockIdx.y, t = threadIdx.x, tx = t & 15, ty = t >> 4;
    const int row0 = rt * 64, bb = row0 / SK, t0 = row0 % SK; const bool isctx = t0 >= SEQ;
    int type, hc;
    if (cb < 8) { type = 0; hc = cb; } else if (cb < 10) { type = 1; hc = cb - 8; } else if (cb < 12) { type = 2; hc = cb - 10; } else if (cb < 20) { type = 3; hc = cb - 12; }
    else if (cb < 28) { type = 4; hc = cb - 20; } else if (cb < 36) { type = 5; hc = cb - 28; } else if (cb < 52) { type = 6; hc = cb - 36; } else { type = 7; hc = cb - 52; }
    if (isctx && !(type == 1 || type == 2 || type == 4 || type == 5)) return;
    const bf16* HX = (const bf16*)(p.ws + WS_HX);
    float acc[4][4]; ZERO_ACC(acc);
    ngemm_acc(acc, sA, sB, D, [&](int r, int k) { return bf2f(HX[(size_t)(row0 + r) * D + k]); }, [&](int k, int c) { return p.w_in[(size_t)k * INC + cb * 64 + c]; });
#pragma unroll
    for (int i = 0; i < 4; ++i)
#pragma unroll
        for (int j = 0; j < 4; ++j) Cs[(ty * 4 + i) * 65 + tx * 4 + j] = acc[i][j];
    __syncthreads();
    if (t < 64) {
        const int r = t, tt = t0 + r, hr = row0 + r, qrow = bb * SEQ + tt;
        float v[64];
#pragma unroll
        for (int d = 0; d < 64; ++d) v[d] = Cs[r * 65 + d];
        if (type == 0 || type == 1 || type == 3 || type == 4) {
            float ss = 0.f;
#pragma unroll
            for (int d = 0; d < 64; ++d) ss += v[d] * v[d];
            const float rstd = 1.0f / sqrtf(ss * (1.0f / 64.0f) + 1e-6f);
            const float* gn = type == 0 ? p.q_norm_a : type == 1 ? p.k_norm_a : type == 3 ? p.q_norm_b : p.k_norm_b;
#pragma unroll
            for (int d = 0; d < 64; ++d) v[d] = v[d] * rstd * gn[d];
            if (!isctx) {
#pragma unroll
                for (int i = 0; i < 32; ++i) { const float pos = (float)(i < 16 ? (tt >> 6) : (tt & 63)); float c, s; rope_cs(pos, i & 15, c, s);
                    const float x0 = v[2 * i], x1 = v[2 * i + 1]; v[2 * i] = x0 * c - x1 * s; v[2 * i + 1] = x0 * s + x1 * c; }
            }
            if (type == 0 || type == 3) {
#pragma unroll
                for (int d = 0; d < 64; ++d) v[d] *= C2;
            }
        } else if (type >= 6) {
#pragma unroll
            for (int d = 0; d < 64; ++d) v[d] = sigmoidf_(v[d]);
        }
        bf16* dst;
        switch (type) {
            case 0: dst = (bf16*)(p.ws + WS_QA) + (size_t)qrow * 512 + hc * 64; break;
            case 1: dst = (bf16*)(p.ws + WS_KA) + (size_t)hr * 128 + hc * 64; break;
            case 2: dst = (bf16*)(p.ws + WS_VA) + (size_t)hr * 128 + hc * 64; break;
            case 3: dst = (bf16*)(p.ws + WS_QB) + (size_t)qrow * 512 + hc * 64; break;
            case 4: dst = (bf16*)(p.ws + WS_KB) + (size_t)hr * 512 + hc * 64; break;
            case 5: dst = (bf16*)(p.ws + WS_VB) + (size_t)hr * 512 + hc * 64; break;
            case 6: dst = (bf16*)(p.ws + WS_G) + (size_t)qrow * 2048 + hc * 64; break;
            default: dst = (bf16*)(p.ws + WS_G) + (size_t)qrow * 2048 + 1024 + hc * 64; break;
        }
#pragma unroll
        for (int d = 0; d < 64; d += 8) { uint4 w; w.x = pk2(v[d], v[d + 1]); w.y = pk2(v[d + 2], v[d + 3]); w.z = pk2(v[d + 4], v[d + 5]); w.w = pk2(v[d + 6], v[d + 7]); *(uint4*)(dst + d) = w; }
    }
}

template <int MODE>
__global__ void __launch_bounds__(256) nk_attn(P p) {
    constexpr int VD = MODE == 0 ? 64 : 128;
    __shared__ __attribute__((aligned(16))) float Ks[64 * 64]; __shared__ __attribute__((aligned(16))) float Vs[64 * VD];
    const int qb = blockIdx.x, y = blockIdx.y, t = threadIdx.x, b = y >> 3;
    const bf16 *Q, *K, *V; bf16* O; int kp, op;
    if (MODE == 0) { const int h = y & 7; Q = (const bf16*)(p.ws + WS_QA) + h * 64; K = (const bf16*)(p.ws + WS_KA) + (h >> 2) * 64; V = (const bf16*)(p.ws + WS_VA) + (h >> 2) * 64; O = (bf16*)(p.ws + WS_AY) + h * 64; kp = 128; op = 1024; }
    else { const int h = (y & 7) >> 1, m = y & 1; Q = (const bf16*)(p.ws + WS_QB) + h * 128 + m * 64; K = (const bf16*)(p.ws + WS_KB) + h * 128 + m * 64; V = (const bf16*)(p.ws + WS_VB) + h * 128;
        O = (bf16*)(p.ws + WS_OB) + (size_t)m * T * 512 + h * 128; kp = 512; op = 512; }
    const size_t qrow = (size_t)b * SEQ + qb * 256 + t;
    float q[64], o[VD]; float mx = -INFINITY, l = 0.f;
#pragma unroll
    for (int d = 0; d < 64; ++d) q[d] = bf2f(Q[qrow * 512 + d]);
#pragma unroll
    for (int e = 0; e < VD; ++e) o[e] = 0.f;
    for (int kt = 0; kt < SK / 64; ++kt) {
        const size_t kr0 = (size_t)b * SK + kt * 64;
        __syncthreads();
        { const int key = t >> 2, d0 = (t & 3) * 16;
#pragma unroll
          for (int d = 0; d < 16; ++d) Ks[key * 64 + d0 + d] = bf2f(K[(kr0 + key) * kp + d0 + d]);
          constexpr int VC = VD / 4; const int e0 = (t & 3) * VC;
#pragma unroll
          for (int e = 0; e < VC; ++e) Vs[key * VD + e0 + e] = bf2f(V[(kr0 + key) * kp + e0 + e]); }
        __syncthreads();
        for (int kk = 0; kk < 64; ++kk) {
            float s = 0.f;
#pragma unroll
            for (int d = 0; d < 64; d += 4) { const f32x4 k4 = *(const f32x4*)(Ks + kk * 64 + d); s += q[d] * k4.x + q[d + 1] * k4.y + q[d + 2] * k4.z + q[d + 3] * k4.w; }
            if (s > mx) { const float f = exp2f(mx - s); l *= f;
#pragma unroll
                for (int e = 0; e < VD; ++e) o[e] *= f;
                mx = s; }
            const float pr = exp2f(s - mx); l += pr;
#pragma unroll
            for (int e = 0; e < VD; e += 4) { const f32x4 v4 = *(const f32x4*)(Vs + kk * VD + e); o[e] += pr * v4.x; o[e + 1] += pr * v4.y; o[e + 2] += pr * v4.z; o[e + 3] += pr * v4.w; }
        }
    }
    const float il = 1.0f / l;
#pragma unroll
    for (int e = 0; e < VD; e += 8) { uint4 w; w.x = pk2(o[e] * il, o[e + 1] * il); w.y = pk2(o[e + 2] * il, o[e + 3] * il); w.z = pk2(o[e + 4] * il, o[e + 5] * il); w.w = pk2(o[e + 6] * il, o[e + 7] * il);
        *(uint4*)(O + qrow * op + e) = w; }
}

__global__ void __launch_bounds__(256) nk_merge(P p) {
    __shared__ __attribute__((aligned(16))) float sA[16 * 68]; __shared__ __attribute__((aligned(16))) float sB[16 * 68];
    const int row0 = blockIdx.x * 64, col0 = blockIdx.y * 64, t = threadIdx.x, tx = t & 15, ty = t >> 4;
    const bf16 *AY = (const bf16*)(p.ws + WS_AY), *G = (const bf16*)(p.ws + WS_G); bf16* MG = (bf16*)(p.ws + WS_MERGED);
    float a1[4][4], a2[4][4]; ZERO_ACC(a1); ZERO_ACC(a2);
    ngemm_acc(a1, sA, sB, 512, [&](int r, int k) { return bf2f(AY[(size_t)(row0 + r) * 1024 + k]); }, [&](int k, int c) { return p.w_oa[(size_t)k * D + col0 + c]; });
    ngemm_acc(a2, sA, sB, 512, [&](int r, int k) { return bf2f(AY[(size_t)(row0 + r) * 1024 + 512 + k]); }, [&](int k, int c) { return p.w_ob[(size_t)k * D + col0 + c]; });
#pragma unroll
    for (int i = 0; i < 4; ++i)
#pragma unroll
        for (int j = 0; j < 4; ++j) { const size_t r = row0 + ty * 4 + i; const int c = col0 + tx * 4 + j;
            MG[r * D + c] = (bf16)f2bf(bf2f(G[r * 2048 + c]) * a1[i][j] + bf2f(G[r * 2048 + 1024 + c]) * a2[i][j]); }
}

__global__ void __launch_bounds__(256) nk_outproj(P p) {
    __shared__ __attribute__((aligned(16))) float sA[16 * 68]; __shared__ __attribute__((aligned(16))) float sB[16 * 68];
    const int row0 = blockIdx.x * 64, col0 = blockIdx.y * 64, t = threadIdx.x, tx = t & 15, ty = t >> 4;
    const bf16* MG = (const bf16*)(p.ws + WS_MERGED); const float* MOD = (const float*)(p.ws + WS_MOD);
    float a1[4][4]; ZERO_ACC(a1);
    ngemm_acc(a1, sA, sB, D, [&](int r, int k) { return bf2f(MG[(size_t)(row0 + r) * D + k]); }, [&](int k, int c) { return p.w_out[(size_t)k * D + col0 + c]; });
#pragma unroll
    for (int i = 0; i < 4; ++i)
#pragma unroll
        for (int j = 0; j < 4; ++j) { const size_t r = row0 + ty * 4 + i; const int c = col0 + tx * 4 + j; const int b = (int)(r / SEQ);
            p.out[r * D + c] = p.x[r * D + c] + MOD[b * NMOD + 2 * D + c] * a1[i][j]; }
}

__device__ __forceinline__ void expert_prefix(const P& p, int* s_cnt, int* s_base, int* s_tile0) {
    const unsigned* CNT = (const unsigned*)(p.ws + WS_CTL) + CW_CNT;
    if (threadIdx.x == 0) { int base = 0, tl = 0; for (int e = 0; e < NE; ++e) { const int c = (int)CNT[64 * e]; s_cnt[e] = c; s_base[e] = base; s_tile0[e] = tl; base += (c + 255) / 256 * 256; tl += (c + 63) / 64; } s_tile0[NE] = tl; }
    __syncthreads();
}

__global__ void __launch_bounds__(256) nk_moe1(P p) {
    __shared__ __attribute__((aligned(16))) float sA[16 * 68]; __shared__ __attribute__((aligned(16))) float sB[16 * 68];
    __shared__ int s_cnt[NE], s_base[NE], s_tile0[NE + 1], s_tok[64];
    const int t = threadIdx.x, tx = t & 15, ty = t >> 4;
    expert_prefix(p, s_cnt, s_base, s_tile0);
    const bf16* HM = (const bf16*)(p.ws + WS_HM); const int* TOK = (const int*)(p.ws + WS_TOK); bf16* ACT = (bf16*)(p.ws + WS_ACT);
    const int ntiles = s_tile0[NE] * 16;
    for (int i = blockIdx.x; i < ntiles; i += gridDim.x) {
        const int rtile = i >> 4, ct = i & 15; int e = 0; while (s_tile0[e + 1] <= rtile) ++e;
        const int pos0 = (rtile - s_tile0[e]) * 64, cnt = s_cnt[e], col0 = ct * 64;
        __syncthreads();
        if (t < 64) s_tok[t] = (pos0 + t < cnt) ? TOK[e * ECAP + pos0 + t] : -1;
        __syncthreads();
        float ag[4][4], au[4][4]; ZERO_ACC(ag); ZERO_ACC(au);
        auto fa = [&](int r, int k) { const int tk = s_tok[r]; return tk >= 0 ? bf2f(HM[(size_t)tk * D + k]) : 0.f; };
        ngemm_acc(ag, sA, sB, D, fa, [&](int k, int c) { return p.w_gate[((size_t)e * D + k) * D + col0 + c]; });
        ngemm_acc(au, sA, sB, D, fa, [&](int k, int c) { return p.w_up[((size_t)e * D + k) * D + col0 + c]; });
#pragma unroll
        for (int ii = 0; ii < 4; ++ii)
#pragma unroll
            for (int j = 0; j < 4; ++j) { const int pos = pos0 + ty * 4 + ii, c = col0 + tx * 4 + j;
                if (pos < cnt) { const float g = fminf(ag[ii][j] + p.b_gate[e * D + c], 7.0f); const float u = fminf(fmaxf(au[ii][j] + p.b_up[e * D + c], -7.0f), 7.0f);
                    ACT[(size_t)(s_base[e] + pos) * D + c] = (bf16)f2bf((u + 1.0f) * (g * sigmoidf_(1.702f * g))); } }
    }
}

__global__ void __launch_bounds__(256) nk_moe2(P p) {
    __shared__ __attribute__((aligned(16))) float sA[16 * 68]; __shared__ __attribute__((aligned(16))) float sB[16 * 68];
    __shared__ int s_cnt[NE], s_base[NE], s_tile0[NE + 1];
    const int t = threadIdx.x, tx = t & 15, ty = t >> 4;
    expert_prefix(p, s_cnt, s_base, s_tile0);
    const bf16* ACT = (const bf16*)(p.ws + WS_ACT); const float* SW = (const float*)(p.ws + WS_SW); const int* SDST = (const int*)(p.ws + WS_SDST); bf16* Y = (bf16*)(p.ws + WS_Y);
    const int ntiles = s_tile0[NE] * 16;
    for (int i = blockIdx.x; i < ntiles; i += gridDim.x) {
        const int rtile = i >> 4, ct = i & 15; int e = 0; while (s_tile0[e + 1] <= rtile) ++e;
        const int pos0 = (rtile - s_tile0[e]) * 64, cnt = s_cnt[e], col0 = ct * 64, base = s_base[e];
        float a1[4][4]; ZERO_ACC(a1);
        ngemm_acc(a1, sA, sB, D, [&](int r, int k) { return (pos0 + r < cnt) ? bf2f(ACT[(size_t)(base + pos0 + r) * D + k]) : 0.f; }, [&](int k, int c) { return p.w_down[((size_t)e * D + k) * D + col0 + c]; });
#pragma unroll
        for (int ii = 0; ii < 4; ++ii)
#pragma unroll
            for (int j = 0; j < 4; ++j) { const int pos = pos0 + ty * 4 + ii, c = col0 + tx * 4 + j;
                if (pos < cnt) { const float w = SW[e * ECAP + pos]; const size_t dst = (size_t)SDST[e * ECAP + pos];
                    Y[dst * D + c] = (bf16)f2bf(w * (a1[ii][j] + p.b_down[e * D + c])); } }
    }
}

namespace pg8 {
#define PG8_LAS __attribute__((address_space(3)))
typedef unsigned short bf16_t;
typedef short bf16x8 __attribute__((ext_vector_type(8)));
typedef float f32x4 __attribute__((ext_vector_type(4)));
typedef unsigned u32x4 __attribute__((ext_vector_type(4)));
typedef int i32x4 __attribute__((ext_vector_type(4)));
typedef int i32x8 __attribute__((ext_vector_type(8)));
__device__ __forceinline__ i32x8 cat8(bf16x8 lo, bf16x8 hi) { const i32x4 a = (i32x4)lo, b = (i32x4)hi; return __builtin_shufflevector(a, b, 0, 1, 2, 3, 4, 5, 6, 7); }
constexpr int BM = 256, BK = 64, HALF = 128, HTB = HALF * BK * 2  , STAGE_BYTES = 8 * HTB;
constexpr int PF_OFF = 135168 + 6144;

__host__ __device__ __forceinline__ int lds_byte(int r, int c) { const int st = (r >> 4) * 2 + (c >> 5), rr = r & 15, cc = c & 31, ob = rr * 64 + cc * 2; return st * 1024 + (ob ^ (((ob >> 9) & 1) << 5)); }
__host__ __device__ __forceinline__ void stage_rc(int b, int& R, int& C) { const int st = b / 1024, sb = b % 1024, swz = sb ^ (((sb >> 9) & 1) << 5); R = (st >> 1) * 16 + swz / 64; C = (st & 1) * 32 + (swz % 64) / 2; }
__host__ __device__ __forceinline__ int perm32(int rho) { const int n = rho >> 4, i = rho & 15; return 8 * (i >> 2) + 4 * n + (i & 3); }

struct Unit { int pm, pn, pb, acol, e, pos0, cnt, base, rt; };
struct Gemm { const bf16_t* A; const bf16_t* Bt; int lda, K; };

__device__ __forceinline__ unsigned cvt_pk_bf16(float lo, float hi) { unsigned r; asm volatile("v_cvt_pk_bf16_f32 %0, %1, %2" : "=v"(r) : "v"(lo), "v"(hi)); return r; }

template <class Epi, class Sched, bool ALIGN_EPI>
__device__ __forceinline__ void gemm_phase(PG8_LAS unsigned char* lds, const Gemm g, const Sched& S, const Epi& E) {
    const int tid = threadIdx.x, wid = __builtin_amdgcn_readfirstlane(tid >> 6), lane = tid & 63, wr = wid >> 2, wc = wid & 3, fr = lane & 15, fq = lane >> 4;
    constexpr bool F8 = Epi::F8;
    constexpr int EB = F8 ? 1 : 2;
    const int K = g.K, nt = K / (F8 ? 2 * BK : BK);
    int RA[2], CA[2]; unsigned voffB[2];
#pragma unroll
    for (int i = 0; i < 2; ++i) { int R, C; stage_rc(tid * 16 + i * 8192, R, C); const int Rb = Epi::PERM ? ((R & ~31) + perm32(R & 31)) : R;
        const int c16 = C >> 3, cb = F8 ? 16 * (2 * (c16 & 3) + (c16 >> 2)) : 2 * C;
        RA[i] = R; CA[i] = cb; voffB[i] = (unsigned)(Rb * K * EB + cb); }
    const size_t kstep = (size_t)(BK * 2);
    const size_t hstep = (size_t)HALF * K * EB;
    const size_t tstep = 2 * hstep;
    const unsigned ldsw = (unsigned)wid * 1024u;
    const int aoff = lds_byte(wr * 64 + fr, fq * 8), boff = lds_byte(wc * 32 + fr, fq * 8);
    const char* const gA = (const char*)g.A;
#define PG8_SA(b, h) (((b) * 2 + (h)) * HTB)
#define PG8_SB(b, h) ((4 + (b) * 2 + (h)) * HTB)
#define PG8_STAGE(bufoff, gbase, voff) do { _Pragma("unroll") for (int _i = 0; _i < 2; ++_i) \
        __builtin_amdgcn_global_load_lds((const unsigned*)((const char*)(gbase) + (voff)[_i]), (PG8_LAS unsigned*)(lds + (bufoff) + ldsw + _i * 8192), 16, 0, 0); } while (0)
#define PG8_STAGE_A(bufoff, kbyte, v, h) do { _Pragma("unroll") for (int _i = 0; _i < 2; ++_i) \
        __builtin_amdgcn_global_load_lds((const unsigned*)(gA + (kbyte) + (v)[(h) * 2 + _i]), (PG8_LAS unsigned*)(lds + (bufoff) + ldsw + _i * 8192), 16, 0, 0); } while (0)
#define PG8_AOFF(dst, u) do { _Pragma("unroll") for (int _h = 0; _h < 2; ++_h) _Pragma("unroll") for (int _i = 0; _i < 2; ++_i) \
        dst[_h * 2 + _i] = (unsigned)(((size_t)S.arow(u, _h * HALF + RA[_i]) * (size_t)g.lda + (size_t)(u).acol) * (size_t)EB + (size_t)CA[_i]); } while (0)
#define PG8_LDA(dst, b, h) do { _Pragma("unroll") for (int m = 0; m < 4; ++m) { if constexpr (F8) { dst##8[m].lo = *(const PG8_LAS i32x4*)(lds + PG8_SA(b, h) + aoff + m * 2048); dst##8[m].hi = *(const PG8_LAS i32x4*)(lds + PG8_SA(b, h) + aoff + m * 2048 + 1024); } \
        else { _Pragma("unroll") for (int k = 0; k < 2; ++k) dst[m][k] = *(const PG8_LAS bf16x8*)(lds + PG8_SA(b, h) + aoff + m * 2048 + k * 1024); } } } while (0)
#define PG8_LDB(dst, b, h) do { _Pragma("unroll") for (int n = 0; n < 2; ++n) { if constexpr (F8) { dst##8[n].lo = *(const PG8_LAS i32x4*)(lds + PG8_SB(b, h) + boff + n * 2048); dst##8[n].hi = *(const PG8_LAS i32x4*)(lds + PG8_SB(b, h) + boff + n * 2048 + 1024); } \
        else { _Pragma("unroll") for (int k = 0; k < 2; ++k) dst[n][k] = *(const PG8_LAS bf16x8*)(lds + PG8_SB(b, h) + boff + n * 2048 + k * 1024); } } } while (0)
#define PG8_MMA(ai, bj, At, Bt) do { __builtin_amdgcn_s_setprio(1); if constexpr (F8) { _Pragma("unroll") for (int m = 0; m < 4; ++m) _Pragma("unroll") for (int n = 0; n < 2; ++n) \
        asm volatile("v_mfma_f32_16x16x128_f8f6f4 %0, %1, %2, %0" : "+v"(acc[ai][bj][m][n]) : "v"(Bt##8[n]), "v"(At##8[m])); } else { \
        _Pragma("unroll") for (int m = 0; m < 4; ++m) _Pragma("unroll") for (int n = 0; n < 2; ++n) _Pragma("unroll") for (int k = 0; k < 2; ++k) \
        acc[ai][bj][m][n] = __builtin_amdgcn_mfma_f32_16x16x32_bf16(Bt[n][k], At[m][k], acc[ai][bj][m][n], 0, 0, 0); } __builtin_amdgcn_s_setprio(0); } while (0)
#define PG8_WAIT_V(n) asm volatile("s_waitcnt vmcnt(" #n ")" ::: "memory")
#define PG8_WAIT_L(n) asm volatile("s_waitcnt lgkmcnt(" #n ")" ::: "memory")
#define PG8_BAR __builtin_amdgcn_s_barrier()
#define PG8_SCHED __builtin_amdgcn_sched_barrier(0)
    Unit cur, nxt; int ui = 0;
    if (!S.next(0, cur)) return;
    f32x4 acc[2][2][4][2];
#pragma unroll
    for (int a = 0; a < 2; ++a)
#pragma unroll
        for (int b = 0; b < 2; ++b)
#pragma unroll
            for (int m = 0; m < 4; ++m)
#pragma unroll
                for (int n = 0; n < 2; ++n) acc[a][b][m][n] = (f32x4){0.f, 0.f, 0.f, 0.f};
    bf16x8 At[4][2], B0[2][2], B1[2][2]; i32x8 At8[4], B08[2], B18[2];
    unsigned vo[4], vn[4];
    PG8_AOFF(vo, cur);
    const char* cB = (const char*)g.Bt + (size_t)cur.pb * tstep;
    S.a_ready(cur);
    PG8_STAGE(PG8_SB(0, 0), cB, voffB); PG8_STAGE(PG8_SB(0, 1), cB + hstep, voffB); PG8_STAGE_A(PG8_SA(0, 0), 0, vo, 0); PG8_STAGE_A(PG8_SA(0, 1), 0, vo, 1);
    if (wr == 1) PG8_BAR;
    PG8_WAIT_V(2); PG8_BAR;
    PG8_STAGE(PG8_SB(1, 0), cB + kstep, voffB); PG8_STAGE_A(PG8_SA(1, 0), kstep, vo, 0); PG8_STAGE(PG8_SB(1, 1), cB + hstep + kstep, voffB);
    PG8_WAIT_V(6); PG8_BAR;
    for (;;) {
        const bool has_next = S.next(ui + 1, nxt);
        if (has_next) { PG8_AOFF(vn, nxt); } else {
#pragma unroll
            for (int q = 0; q < 4; ++q) vn[q] = vo[q]; }
        const char* nB = has_next ? (const char*)g.Bt + (size_t)nxt.pb * tstep : cB;
#pragma unroll 1
        for (int t = 0; t < nt; t += 2) {
            const bool last = (t == nt - 2);
            const size_t k1 = (size_t)(t + 1) * kstep;
            const size_t k2 = last ? (size_t)0 : (size_t)(t + 2) * kstep, k3 = k2 + kstep;
            const char* b2 = last ? nB : cB + (size_t)(t + 2) * kstep; const char* b3 = b2 + kstep;
            unsigned v2[4];
#pragma unroll
            for (int q = 0; q < 4; ++q) v2[q] = last ? vn[q] : vo[q];
            if (last && has_next) S.a_ready(nxt);
            if constexpr (Epi::PREFETCH) { if (last) E.prefetch(cur, lds + PF_OFF, wid, lane); }
            PG8_LDB(B0, 0, 0); PG8_LDB(B1, 0, 1); PG8_SCHED; PG8_LDA(At, 0, 0); PG8_STAGE_A(PG8_SA(1, 1), k1, vo, 1);
            PG8_WAIT_V(8); PG8_WAIT_L(0); PG8_BAR; PG8_MMA(0, 0, At, B0); PG8_MMA(0, 1, At, B1); PG8_BAR; PG8_SCHED;
            PG8_LDA(At, 0, 1); PG8_STAGE(PG8_SB(0, 0), b2, voffB); PG8_STAGE(PG8_SB(0, 1), b2 + hstep, voffB); PG8_STAGE_A(PG8_SA(0, 0), k2, v2, 0);
            PG8_WAIT_V(8); PG8_WAIT_L(0); PG8_BAR; PG8_MMA(1, 0, At, B0); PG8_MMA(1, 1, At, B1); PG8_BAR; PG8_SCHED;
            PG8_LDB(B0, 1, 0); PG8_LDB(B1, 1, 1); PG8_SCHED; PG8_LDA(At, 1, 0); PG8_STAGE_A(PG8_SA(0, 1), k2, v2, 1);
            PG8_WAIT_V(8); PG8_WAIT_L(0); PG8_BAR; PG8_MMA(0, 0, At, B0); PG8_MMA(0, 1, At, B1); PG8_BAR; PG8_SCHED;
            PG8_LDA(At, 1, 1); PG8_STAGE(PG8_SB(1, 0), b3, voffB); PG8_STAGE(PG8_SB(1, 1), b3 + hstep, voffB); PG8_STAGE_A(PG8_SA(1, 0), k3, v2, 0);
            PG8_WAIT_V(8); PG8_WAIT_L(0); PG8_BAR; PG8_MMA(1, 0, At, B0); PG8_MMA(1, 1, At, B1); PG8_BAR; PG8_SCHED;
        }
        if constexpr (ALIGN_EPI) { if (wr == 0) PG8_BAR; }
        if constexpr (F8) asm volatile("s_nop 15\n\ts_nop 15" ::: "memory");
        E(acc, cur, wr, wc, fr, fq); S.done(cur);
        if (!has_next) break;
        if (!E.keep_acc(cur))
#pragma unroll
        for (int a = 0; a < 2; ++a)
#pragma unroll
            for (int b = 0; b < 2; ++b)
#pragma unroll
                for (int m = 0; m < 4; ++m)
#pragma unroll
                    for (int n = 0; n < 2; ++n) acc[a][b][m][n] = (f32x4){0.f, 0.f, 0.f, 0.f};
        cur = nxt; cB = nB; ++ui;
#pragma unroll
        for (int q = 0; q < 4; ++q) vo[q] = vn[q];
        if constexpr (ALIGN_EPI) { if (wr == 1) PG8_BAR; }
    }
    PG8_WAIT_V(0);
    if constexpr (!ALIGN_EPI) { if (wr == 0) PG8_BAR; }
    PG8_BAR;
#undef PG8_SA
#undef PG8_SB
#undef PG8_STAGE
#undef PG8_STAGE_A
#undef PG8_AOFF
#undef PG8_LDA
#undef PG8_LDB
#undef PG8_MMA
#undef PG8_WAIT_V
#undef PG8_WAIT_L
#undef PG8_BAR
#undef PG8_SCHED
}
}

struct SchedBase {
    __device__ __forceinline__ void a_ready(const pg8::Unit&) const {}
    __device__ __forceinline__ void done(const pg8::Unit&) const {}
};
struct SchedInProj : SchedBase {
    int G, v;
    __device__ __forceinline__ bool next(int i, pg8::Unit& u) const {
        if (INPROJ_XCD_BLOCKS && G == 256) {
            const int x = v >> 5, q_ = i * 32 + (v & 31);
            if (q_ < 136) { const int lt = 8 * x + (q_ & 7); u.pn = q_ >> 3; u.pm = lt + (lt >> 5); }
            else if ((x & 3) == 3 && q_ < 141) { const int r = q_ - 136; u.pm = x == 3 ? 32 : 65; u.pn = r == 0 ? 2 : 4 + r; }
            else return false;
            u.pb = u.pn; u.acol = 0; u.e = 0; u.pos0 = 0; u.cnt = 0; u.base = 0; return true;
        }
        const int L = i * G + v; if (L >= 1098) return false;
        if (L < 1088) { const int gI = L / 136, r = L % 136, lt = 8 * gI + (r & 7); u.pn = r >> 3; u.pm = lt + (lt >> 5); }
        else { const int r = L - 1088, q = r % 5; u.pm = r < 5 ? 32 : 65; u.pn = q == 0 ? 2 : 4 + q; }
        u.pb = u.pn; u.acol = 0; u.e = 0; u.pos0 = 0; u.cnt = 0; u.base = 0; return true;
    }
    __device__ __forceinline__ int arow(const pg8::Unit& u, int rloc) const { return u.pm * 256 + rloc; }
};
struct SchedInProjA : SchedBase {
    int G, v;
    __device__ __forceinline__ bool next(int i, pg8::Unit& u) const {
        const int L = i * G + v; if (L >= 586) return false;
        if (L < 576) { const int gI = L / 72, r = L % 72, lt = 8 * gI + (r & 7); u.pn = r >> 3; u.pm = lt + (lt >> 5); }
        else { const int r = L - 576, q = r % 5; u.pm = r < 5 ? 32 : 65; u.pn = q == 0 ? 2 : 4 + q; }
        u.pb = u.pn; u.acol = 0; u.e = 0; u.pos0 = 0; u.cnt = 0; u.base = 0; return true;
    }
    __device__ __forceinline__ int arow(const pg8::Unit& u, int rloc) const { return u.pm * 256 + rloc; }
};
struct SchedInProjG : SchedBase {
    int G, v;
    __device__ __forceinline__ bool next(int i, pg8::Unit& u) const {
        int L;
        if (G != 256) { L = i * G + v; if (L >= 512) return false; }
        else if (i == 0) L = v; else if (i == 1 && v >= 74) L = 256 + v - 74; else if (i == 2 && v >= 74 && v < 148) L = 438 + v - 74; else return false;
        const int gI = L / 64, r = L % 64, lt = 8 * gI + (r & 7); u.pn = 9 + (r >> 3); u.pm = lt + (lt >> 5);
        u.pb = u.pn - 9; u.acol = 0; u.e = 0; u.pos0 = 0; u.cnt = 0; u.base = 0; return true;
    }
    __device__ __forceinline__ int arow(const pg8::Unit& u, int rloc) const { return u.pm * 256 + rloc; }
};
template <int NPART>
struct SchedTile : SchedBase {
    int G, v;
    __device__ __forceinline__ bool next(int i, pg8::Unit& u) const {
        if (i >= NPART || v >= 256) return false;
        u.pm = 8 * (v >> 5) + (v & 7); u.pn = (v & 31) >> 3; u.pb = i * 4 + u.pn; u.acol = i * 512; u.e = i; u.pos0 = 0; u.cnt = 0; u.base = 0; return true;
    }
    __device__ __forceinline__ int arow(const pg8::Unit& u, int rloc) const { return u.pm * 256 + rloc; }
};
template <int NN, bool GATHER>
struct SchedMoe : SchedBase {
    int G, v; const LAS int* tb; const int* tok;
    int ilo = 0, ihi = 0x7fffffff; bool rev = false; int late_rt0 = 0x7fffffff; unsigned* late_cnt = nullptr; unsigned late_n = 0u;
    __device__ __forceinline__ void a_ready(const pg8::Unit& u) const {
        if (!GATHER && late_cnt != nullptr && u.rt >= late_rt0) { unsigned sp_ = 0u;
            while (__hip_atomic_load(late_cnt, __ATOMIC_RELAXED, __HIP_MEMORY_SCOPE_AGENT) < late_n) { __builtin_amdgcn_s_sleep(2); if (++sp_ > (1u << 22)) break; }
            asm volatile("" ::: "memory"); } }
    __device__ __forceinline__ bool next(int i_, pg8::Unit& u) const {
        const int i = i_ + ilo; if (i >= ihi) return false;
        const int ntile = tb[64 + NE]; int rt;
        if (MOE_XCD_BLOCKS && G == 256) {
            const int RB = (ntile + 7) >> 3, q_ = i * 32 + (rev ? 31 - (v & 31) : (v & 31));
            if (q_ >= RB * NN) return false;
            rt = (v >> 5) * RB + q_ / NN; if (rt >= ntile) return false; u.pn = q_ % NN;
        } else { const int L = i * G + v; if (L >= ntile * NN) return false; rt = L / NN; u.pn = L % NN; }
        typedef int i32x4 __attribute__((ext_vector_type(4))); const i32x4 q = *(const LAS i32x4*)(tb + 128 + 4 * rt);
        u.e = q.x; u.pos0 = q.y; u.cnt = q.z; u.base = q.w; u.pm = (u.base + u.pos0) >> 8; u.pb = u.e * NN + u.pn; u.acol = 0; u.rt = rt; return true;
    }
    __device__ __forceinline__ int arow(const pg8::Unit& u, int rloc) const {
        if (GATHER) { const int pos = u.pos0 + rloc; return tok[u.e * ECAP + (pos < u.cnt ? pos : u.cnt - 1)]; }
        return u.pm * 256 + rloc;
    }
};

__device__ __forceinline__ float fast_sigmoid(float v) { return __builtin_amdgcn_rcpf(1.0f + __builtin_amdgcn_exp2f(-1.4426950408889634f * v)); }
__device__ __forceinline__ unsigned pk4_u8(float x0, float x1, float x2, float x3) {
    const unsigned a = __float_as_uint(fmaf(x0, 255.0f, 8388608.0f)), b = __float_as_uint(fmaf(x1, 255.0f, 8388608.0f)), c_ = __float_as_uint(fmaf(x2, 255.0f, 8388608.0f)), d = __float_as_uint(fmaf(x3, 255.0f, 8388608.0f));
    const unsigned lo = __builtin_amdgcn_perm(b, a, 0x0c0c0400u), hi = __builtin_amdgcn_perm(d, c_, 0x0c0c0400u);
    return __builtin_amdgcn_perm(hi, lo, 0x05040100u);
}
#define EPI_FENCE() do { asm volatile("" ::: "memory"); __builtin_amdgcn_sched_barrier(0); } while (0)
struct EpiInProj {
    static constexpr bool PERM = true, F8 = INPROJ_FP8_ALL, PREFETCH = false;
    static constexpr float ASC = F8 ? 1.0f / W8_SCALE : 1.0f;
    unsigned char* ws; const float *qna, *kna, *qnb, *knb;
    __device__ __forceinline__ bool keep_acc(const pg8::Unit&) const { return false; }
    __device__ __forceinline__ void operator()(pg8::f32x4 (&acc)[2][2][4][2], const pg8::Unit& u, int wr, int wc, int fr_in, int fq_in) const {
        int fr = fr_in, fq = fq_in; asm volatile("" : "+v"(fr), "+v"(fq));
        typedef pg8::f32x4 f32x4; typedef pg8::u32x4 u32x4;
        const int pm = u.pm, pn = u.pn, b = pm / 33, within = pm % 33; const bool isctx = within == 32;
        int kind; size_t wsoff; int colb; int pitch; const float* gn = qna; float scale = 1.0f; bool qrows = true;
        constexpr float QSC = ATT_FP8 ? 2.0f * C2 : C2, KSC = ATT_FP8 ? 0.5f : 1.0f;
        if (pn < 2) { kind = 0; wsoff = WS_QA; colb = (pn * 4 + wc) * 64; pitch = 512; gn = qna; scale = QSC; }
        else if (pn == 2) { qrows = false; pitch = 128; if (wc < 2) { kind = 0; wsoff = WS_KA; colb = wc * 64; gn = kna; scale = KSC; } else { kind = 1; wsoff = WS_VA; colb = (wc - 2) * 64; } }
        else if (pn < 5) { kind = 0; wsoff = WS_QB; colb = ((pn - 3) * 4 + wc) * 64; pitch = 512; gn = qnb; scale = QSC; }
        else if (pn < 7) { kind = 0; qrows = false; wsoff = WS_KB; colb = ((pn - 5) * 4 + wc) * 64; pitch = 512; gn = knb; scale = KSC; }
        else if (pn < 9) { kind = 1; qrows = false; wsoff = WS_VB; colb = ((pn - 7) * 4 + wc) * 64; pitch = 512; }
        else if (pn < 13) { kind = 2; wsoff = WS_G; colb = ((pn - 9) * 4 + wc) * 64; pitch = 2048; }
        else { kind = 2; wsoff = WS_G; colb = 1024 + ((pn - 13) * 4 + wc) * 64; pitch = 2048; }
        char* const dbase = (char*)(ws + wsoff);
        const int rowbase = (qrows ? (pm - b) : pm) * 256 + wr * 64 + fr;
        const unsigned o0 = (unsigned)(rowbase * pitch + colb + 8 * fq) * 2u, pb2 = (unsigned)pitch * 2u;
        if (kind == 0) {
            f32x4 gv[2][2];
#pragma unroll
            for (int bj = 0; bj < 2; ++bj)
#pragma unroll
                for (int n = 0; n < 2; ++n) gv[bj][n] = *(const f32x4*)(gn + 32 * bj + 8 * fq + 4 * n) * scale;
            float irev[4];
#pragma unroll
            for (int q = 0; q < 4; ++q) irev[q] = exp2f(-(float)(4 * fq + q) * (13.287712379549449f / 16.0f)) * 0.15915494309189535f;
#pragma unroll
            for (int ai = 0; ai < 2; ++ai) {
                float cr[4], sr[4];
                { const float pos = (float)(within * 4 + 2 * ai + wr);
#pragma unroll
                  for (int q = 0; q < 4; ++q) { float rev = pos * irev[q]; rev = rev - floorf(rev); cr[q] = __builtin_amdgcn_cosf(rev); sr[q] = __builtin_amdgcn_sinf(rev); } }
#pragma unroll
                for (int m = 0; m < 4; ++m) {
                    float ss = 0.f;
#pragma unroll
                    for (int bj = 0; bj < 2; ++bj)
#pragma unroll
                        for (int n = 0; n < 2; ++n) { const f32x4 x = acc[ai][bj][m][n]; ss += (x[0] * x[0] + x[1] * x[1]) + (x[2] * x[2] + x[3] * x[3]); }
                    ss += __shfl_xor(ss, 16); ss += __shfl_xor(ss, 32);
                    const float rstd = 1.0f / sqrtf(ss * (1.0f / 64.0f) + 1e-6f / (ASC * ASC));
                    float cc[4], sc[4];
                    { const float pos = (float)(16 * m + fr);
#pragma unroll
                      for (int q = 0; q < 4; ++q) { float rev = pos * irev[q]; rev = rev - floorf(rev); cc[q] = __builtin_amdgcn_cosf(rev); sc[q] = __builtin_amdgcn_sinf(rev); } }
                    const unsigned orow = o0 + (unsigned)(ai * 128 + m * 16) * pb2;
#pragma unroll
                    for (int bj = 0; bj < 2; ++bj) {
                        f32x4 x0 = acc[ai][bj][m][0] * rstd * gv[bj][0], x1 = acc[ai][bj][m][1] * rstd * gv[bj][1];
                        if (!isctx) {
                            const float c0 = bj ? cc[0] : cr[0], s0 = bj ? sc[0] : sr[0], c1 = bj ? cc[1] : cr[1], s1 = bj ? sc[1] : sr[1];
                            const float c2 = bj ? cc[2] : cr[2], s2 = bj ? sc[2] : sr[2], c3 = bj ? cc[3] : cr[3], s3 = bj ? sc[3] : sr[3];
                            x0 = (f32x4){x0[0] * c0 - x0[1] * s0, x0[0] * s0 + x0[1] * c0, x0[2] * c1 - x0[3] * s1, x0[2] * s1 + x0[3] * c1};
                            x1 = (f32x4){x1[0] * c2 - x1[1] * s2, x1[0] * s2 + x1[1] * c2, x1[2] * c3 - x1[3] * s3, x1[2] * s3 + x1[3] * c3};
                        }
                        if (ATT_FP8) { typedef unsigned u32x2 __attribute__((ext_vector_type(2))); u32x2 w; w.x = pk4_fp8(x0[0], x0[1], x0[2], x0[3]); w.y = pk4_fp8(x1[0], x1[1], x1[2], x1[3]);
                            *(u32x2*)(dbase + (orow >> 1) + 32 * bj) = w; }
                        else { u32x4 w; w.x = pg8::cvt_pk_bf16(x0[0], x0[1]); w.y = pg8::cvt_pk_bf16(x0[2], x0[3]); w.z = pg8::cvt_pk_bf16(x1[0], x1[1]); w.w = pg8::cvt_pk_bf16(x1[2], x1[3]);
                        *(u32x4*)(dbase + orow + 64 * bj) = w; }
                    }
                    EPI_FENCE();
                }
            }
        } else if (ATT_FP8 && kind == 1) {
            const int dvw = (pn == 2) ? 64 : 128;
            const int head = (pn == 2) ? (wc - 2) : (colb >> 7), dv0 = (pn == 2) ? 0 : (colb & 127);
            unsigned char* const vt = (unsigned char*)dbase + (size_t)((b * (pn == 2 ? 2 : 4) + head) * (SK / 64)) * (size_t)(dvw * 64);
#pragma unroll
            for (int ai = 0; ai < 2; ++ai)
#pragma unroll
                for (int m = 0; m < 4; ++m) {
                    const int t = within * 4 + 2 * ai + wr, k5 = (m & 1) * 16 + fr, slot = 16 * (m >> 1) + (k5 & 3) + 4 * (k5 >> 3), hh = (k5 >> 2) & 1;
                    unsigned char* const rowp = vt + (size_t)t * (size_t)(dvw * 64) + hh * 32 + slot;
#pragma unroll
                    for (int bj = 0; bj < 2; ++bj) {
                        const f32x4 x0 = acc[ai][bj][m][0] * ASC, x1 = acc[ai][bj][m][1] * ASC;
                        const unsigned w0 = pk4_fp8(x0[0], x0[1], x0[2], x0[3]), w1 = pk4_fp8(x1[0], x1[1], x1[2], x1[3]);
                        unsigned char* const q = rowp + (dv0 + 32 * bj + 8 * fq) * 64;
                        q[0] = (unsigned char)w0; q[64] = (unsigned char)(w0 >> 8); q[128] = (unsigned char)(w0 >> 16); q[192] = (unsigned char)(w0 >> 24);
                        q[256] = (unsigned char)w1; q[320] = (unsigned char)(w1 >> 8); q[384] = (unsigned char)(w1 >> 16); q[448] = (unsigned char)(w1 >> 24);
                    }
                    EPI_FENCE();
                }
        } else {
#pragma unroll
            for (int ai = 0; ai < 2; ++ai)
#pragma unroll
                for (int m = 0; m < 4; ++m) {
                    const unsigned orow = o0 + (unsigned)(ai * 128 + m * 16) * pb2;
#pragma unroll
                    for (int bj = 0; bj < 2; ++bj) {
                        f32x4 x0 = acc[ai][bj][m][0] * ASC, x1 = acc[ai][bj][m][1] * ASC;
                        if (kind == 2) { x0 = (f32x4){fast_sigmoid(x0[0]), fast_sigmoid(x0[1]), fast_sigmoid(x0[2]), fast_sigmoid(x0[3])}; x1 = (f32x4){fast_sigmoid(x1[0]), fast_sigmoid(x1[1]), fast_sigmoid(x1[2]), fast_sigmoid(x1[3])}; }
                        if (G_U8 && kind == 2) { typedef unsigned u32x2 __attribute__((ext_vector_type(2))); u32x2 w; w.x = pk4_u8(x0[0], x0[1], x0[2], x0[3]); w.y = pk4_u8(x1[0], x1[1], x1[2], x1[3]);
                            *(u32x2*)(dbase + (orow >> 1) + 32 * bj) = w; }
                        else { u32x4 w; w.x = pg8::cvt_pk_bf16(x0[0], x0[1]); w.y = pg8::cvt_pk_bf16(x0[2], x0[3]); w.z = pg8::cvt_pk_bf16(x1[0], x1[1]); w.w = pg8::cvt_pk_bf16(x1[2], x1[3]);
                        *(u32x4*)(dbase + orow + 64 * bj) = w; }
                    }
                    EPI_FENCE();
                }
        }
    }
};
struct EpiInProjG {
    static constexpr bool PERM = true, F8 = true, PREFETCH = false;
    unsigned char* ws;
    __device__ __forceinline__ bool keep_acc(const pg8::Unit&) const { return false; }
    __device__ __forceinline__ void operator()(pg8::f32x4 (&acc)[2][2][4][2], const pg8::Unit& u, int wr, int wc, int fr_in, int fq_in) const {
        int fr = fr_in, fq = fq_in; asm volatile("" : "+v"(fr), "+v"(fq));
        typedef pg8::f32x4 f32x4; typedef pg8::u32x4 u32x4;
        const int pm = u.pm, pn = u.pn, b = pm / 33;
        const int colb = ((pn - 9) * 4 + wc) * 64;
        char* const dbase = (char*)(ws + WS_G);
        const int rowbase = (pm - b) * 256 + wr * 64 + fr;
        const unsigned o0 = (unsigned)(rowbase * 2048 + colb + 8 * fq) * 2u, pb2 = 2048u * 2u;
        constexpr float ASC = 1.0f / W8_SCALE;
#pragma unroll
        for (int ai = 0; ai < 2; ++ai)
#pragma unroll
            for (int m = 0; m < 4; ++m) {
                const unsigned orow = o0 + (unsigned)(ai * 128 + m * 16) * pb2;
#pragma unroll
                for (int bj = 0; bj < 2; ++bj) {
                    f32x4 x0 = acc[ai][bj][m][0] * ASC, x1 = acc[ai][bj][m][1] * ASC;
                    x0 = (f32x4){fast_sigmoid(x0[0]), fast_sigmoid(x0[1]), fast_sigmoid(x0[2]), fast_sigmoid(x0[3])}; x1 = (f32x4){fast_sigmoid(x1[0]), fast_sigmoid(x1[1]), fast_sigmoid(x1[2]), fast_sigmoid(x1[3])};
                    u32x4 w; w.x = pg8::cvt_pk_bf16(x0[0], x0[1]); w.y = pg8::cvt_pk_bf16(x0[2], x0[3]); w.z = pg8::cvt_pk_bf16(x1[0], x1[1]); w.w = pg8::cvt_pk_bf16(x1[2], x1[3]);
                    *(u32x4*)(dbase + orow + 64 * bj) = w;
                }
                EPI_FENCE();
            }
    }
};
struct EpiMerge {
    static constexpr bool PERM = true, F8 = MERGE_FP8, PREFETCH = false;
    const bf16* G; bf16* MG;
    __device__ __forceinline__ bool keep_acc(const pg8::Unit& u) const { return u.e == 0; }
    __device__ __forceinline__ void operator()(pg8::f32x4 (&acc)[2][2][4][2], const pg8::Unit& u, int wr, int wc, int fr_in, int fq_in) const {
        int fr = fr_in, fq = fq_in; asm volatile("" : "+v"(fr), "+v"(fq));
        typedef pg8::f32x4 f32x4; typedef pg8::u32x4 u32x4;
        const int part = u.e; const unsigned row0 = (unsigned)(u.pm * 256 + wr * 64 + fr), col0 = (unsigned)(u.pn * 256 + wc * 32 + 8 * fq);
        const char* const gb = (const char*)G; char* const mb = (char*)MG;
        constexpr float P0SC = F8 ? 1.0f / YA8_SCALE : 1.0f;
        constexpr float P1SC = (F8 ? MG8_SCALE / W8_SCALE : 1.0f) * (G_U8 ? 1.0f / 255.0f : 1.0f);
        constexpr float GFLOOR = G_U8 ? 1e-6f : 1e-30f;
#define UNPK(WW, LO, HI) const f32x4 LO = G_U8 ? (f32x4){(float)(WW.x & 0xffu), (float)((WW.x >> 8) & 0xffu), (float)((WW.x >> 16) & 0xffu), (float)(WW.x >> 24)} \
                                              : (f32x4){__uint_as_float(WW.x << 16), __uint_as_float(WW.x & 0xffff0000u), __uint_as_float(WW.y << 16), __uint_as_float(WW.y & 0xffff0000u)}; \
                        const f32x4 HI = G_U8 ? (f32x4){(float)(WW.y & 0xffu), (float)((WW.y >> 8) & 0xffu), (float)((WW.y >> 16) & 0xffu), (float)(WW.y >> 24)} \
                                              : (f32x4){__uint_as_float(WW.z << 16), __uint_as_float(WW.z & 0xffff0000u), __uint_as_float(WW.w << 16), __uint_as_float(WW.w & 0xffff0000u)}
#pragma unroll
        for (int ai = 0; ai < 2; ++ai) {
            u32x4 wbv[8], wav[8];
#pragma unroll
            for (int q = 0; q < 8; ++q) { const unsigned row = row0 + (unsigned)(ai * 128 + (q >> 1) * 16), col = col0 + (unsigned)((q & 1) * 128); const unsigned gel = (row * 2048u + col) * (G_U8 ? 1u : 2u);
                if (G_U8) { typedef unsigned u32x2 __attribute__((ext_vector_type(2))); const u32x2 tb_ = *(const u32x2*)(gb + gel + 1024u), ta_ = *(const u32x2*)(gb + gel);
                    wbv[q] = (u32x4){tb_.x, tb_.y, 0u, 0u}; wav[q] = (u32x4){ta_.x, ta_.y, 0u, 0u}; }
                else { wbv[q] = *(const u32x4*)(gb + gel + 2048u); wav[q] = *(const u32x4*)(gb + gel); } }
#pragma unroll
            for (int q = 0; q < 8; ++q) { const int m = q >> 1, bj = q & 1;
                const unsigned row = row0 + (unsigned)(ai * 128 + m * 16), col = col0 + (unsigned)(bj * 128);
                const u32x4 wb = wbv[q];
                UNPK(wb, b0, b1);
                f32x4 c0, c1;
#pragma unroll
                for (int j = 0; j < 4; ++j) { c0[j] = fmaxf(b0[j], GFLOOR); c1[j] = fmaxf(b1[j], GFLOOR); }
                if (part == 0) {
                    const u32x4 wa = wav[q];
                    UNPK(wa, a0, a1);
#pragma unroll
                    for (int j = 0; j < 4; ++j) { acc[ai][bj][m][0][j] *= a0[j] * P0SC * __builtin_amdgcn_rcpf(c0[j]); acc[ai][bj][m][1][j] *= a1[j] * P0SC * __builtin_amdgcn_rcpf(c1[j]); }
                } else {
                    const f32x4 x0 = acc[ai][bj][m][0] * c0 * P1SC, x1 = acc[ai][bj][m][1] * c1 * P1SC;
                    if constexpr (F8) { typedef unsigned u32x2 __attribute__((ext_vector_type(2))); u32x2 w; w.x = pk4_fp8(x0[0], x0[1], x0[2], x0[3]); w.y = pk4_fp8(x1[0], x1[1], x1[2], x1[3]); *(u32x2*)(mb + (row * 1024u + col)) = w; }
                    else { u32x4 w; w.x = pg8::cvt_pk_bf16(x0[0], x0[1]); w.y = pg8::cvt_pk_bf16(x0[2], x0[3]); w.z = pg8::cvt_pk_bf16(x1[0], x1[1]); w.w = pg8::cvt_pk_bf16(x1[2], x1[3]);
                    *(u32x4*)(mb + (row * 1024u + col) * 2u) = w; } }
            }
            EPI_FENCE();
        }
#undef UNPK
    }
};
struct EpiOut {
    static constexpr bool PERM = false, F8 = MERGE_FP8, PREFETCH = false;
    const float* x; const float* MOD; float* out;
    __device__ __forceinline__ bool keep_acc(const pg8::Unit&) const { return false; }
    __device__ __forceinline__ void operator()(pg8::f32x4 (&acc)[2][2][4][2], const pg8::Unit& u, int wr, int wc, int fr_in, int fq_in) const {
        int fr = fr_in, fq = fq_in; asm volatile("" : "+v"(fr), "+v"(fq));
        typedef pg8::f32x4 f32x4;
        const unsigned row0 = (unsigned)(u.pm * 256 + wr * 64 + fr), col0 = (unsigned)(u.pn * 256 + wc * 32 + 4 * fq); const int b = u.pm >> 5;
        const float* ga = MOD + b * NMOD + 2 * D; const char* const xb = (const char*)x; char* const ob = (char*)out;
        const unsigned e0 = (row0 * 1024u + col0) * 4u;
#pragma unroll
        for (int bj = 0; bj < 2; ++bj)
#pragma unroll
            for (int n = 0; n < 2; ++n) { const f32x4 gv = *(const f32x4*)(ga + col0 + bj * 128 + n * 16) * (F8 ? 1.0f / (MG8_SCALE * W8_SCALE) : 1.0f);
                f32x4 xv[8];
#pragma unroll
                for (int q = 0; q < 8; ++q) xv[q] = *(const f32x4*)(xb + e0 + (unsigned)((((q >> 2) * 128 + (q & 3) * 16) * 1024 + bj * 128 + n * 16) * 4));
#pragma unroll
                for (int q = 0; q < 8; ++q) { const f32x4 r_ = xv[q] + gv * acc[q >> 2][bj][q & 3][n];
                    const unsigned eo = e0 + (unsigned)((((q >> 2) * 128 + (q & 3) * 16) * 1024 + bj * 128 + n * 16) * 4);
                    if (X1_BF16) { uint2 w_; w_.x = pk2(r_.x, r_.y); w_.y = pk2(r_.z, r_.w); *(uint2*)(ob + (eo >> 1)) = w_; }
                    else *(f32x4*)(ob + eo) = r_; }
                EPI_FENCE(); }
    }
};
struct EpiMoe1 {
    static constexpr bool PERM = true, F8 = MOE_FP8, PREFETCH = EPI_PREFETCH;
    const float *bg, *bu; bf16* ACT; const LAS unsigned char* pfl;
    __device__ __forceinline__ void prefetch(const pg8::Unit& u, LAS unsigned char* pf, int wid, int lane) const {
        if (wid == 0) { const float* src = (lane < 32 ? bg : bu) + u.e * D + u.pn * 128 + 4 * (lane & 31);
            __builtin_amdgcn_global_load_lds((const unsigned*)src, (LAS unsigned*)pf, 16, 0, 0); } }
    __device__ __forceinline__ bool keep_acc(const pg8::Unit&) const { return false; }
    __device__ __forceinline__ void operator()(pg8::f32x4 (&acc)[2][2][4][2], const pg8::Unit& u, int wr, int wc, int fr_in, int fq_in) const {
        int fr = fr_in, fq = fq_in; asm volatile("" : "+v"(fr), "+v"(fq));
        typedef pg8::f32x4 f32x4; typedef pg8::u32x4 u32x4; typedef float f32x2 __attribute__((ext_vector_type(2)));
        const int col0 = u.pn * 128 + wc * 32 + 8 * fq; const unsigned row0 = (unsigned)(u.pm * 256 + wr * 64 + fr);
        f32x4 bg0, bg1, bu0, bu1;
        if constexpr (PREFETCH) { const LAS float* pf = (const LAS float*)pfl + wc * 32 + 8 * fq; bg0 = *(const LAS f32x4*)pf; bg1 = *(const LAS f32x4*)(pf + 4); bu0 = *(const LAS f32x4*)(pf + 128); bu1 = *(const LAS f32x4*)(pf + 132); }
        else { bg0 = *(const f32x4*)(bg + u.e * D + col0); bg1 = *(const f32x4*)(bg + u.e * D + col0 + 4); bu0 = *(const f32x4*)(bu + u.e * D + col0); bu1 = *(const f32x4*)(bu + u.e * D + col0 + 4); }
        char* const ab = (char*)ACT; const unsigned e0 = (row0 * 1024u + (unsigned)col0) * (F8 ? 1u : 2u);
        constexpr float ASC = F8 ? 1.0f / W8_SCALE : 1.0f;
#pragma unroll
        for (int ai = 0; ai < 2; ++ai)
#pragma unroll
            for (int m = 0; m < 4; ++m) {
                unsigned w[4] = {0u, 0u, 0u, 0u}; f32x2 oo[2][2];
#pragma unroll
                for (int n = 0; n < 2; ++n) { const f32x4 gt = acc[ai][0][m][n] * ASC + (n ? bg1 : bg0), up = acc[ai][1][m][n] * ASC + (n ? bu1 : bu0);
#pragma unroll
                    for (int hj = 0; hj < 2; ++hj) {
                        f32x2 g2 = {fminf(gt[2 * hj], 7.0f), fminf(gt[2 * hj + 1], 7.0f)};
                        const f32x2 u2 = {__builtin_amdgcn_fmed3f(up[2 * hj], -7.0f, 7.0f), __builtin_amdgcn_fmed3f(up[2 * hj + 1], -7.0f, 7.0f)};
                        const f32x2 tt = g2 * (-1.702f * 1.4426950408889634f);
                        f32x2 den = {__builtin_amdgcn_exp2f(tt.x), __builtin_amdgcn_exp2f(tt.y)}; den = den + 1.0f;
                        const f32x2 sg = {__builtin_amdgcn_rcpf(den.x), __builtin_amdgcn_rcpf(den.y)};
                        const f32x2 gs = g2 * sg, o2 = u2 * gs + gs;
                        if constexpr (F8) oo[n][hj] = o2 * ACT8_SCALE;
                        else w[2 * n + hj] = pg8::cvt_pk_bf16(o2.x, o2.y); } }
                if constexpr (F8) {
#pragma unroll
                    for (int n = 0; n < 2; ++n) { int r = __builtin_amdgcn_cvt_pk_fp8_f32(oo[n][0].x, oo[n][0].y, 0, false); r = __builtin_amdgcn_cvt_pk_fp8_f32(oo[n][1].x, oo[n][1].y, r, true); w[n] = (unsigned)r; } }
                if constexpr (F8) { typedef unsigned u32x2 __attribute__((ext_vector_type(2))); u32x2 wv; wv.x = w[0]; wv.y = w[1]; *(u32x2*)(ab + e0 + (unsigned)((ai * 128 + m * 16) * 1024)) = wv; }
                else { u32x4 wv; wv.x = w[0]; wv.y = w[1]; wv.z = w[2]; wv.w = w[3];
                *(u32x4*)(ab + e0 + (unsigned)((ai * 128 + m * 16) * 2048)) = wv; }
                EPI_FENCE();
            }
    }
};
struct EpiMoe2 {
    static constexpr bool PERM = true, F8 = MOE_FP8, PREFETCH = EPI_PREFETCH;
    const float* bd; const float* SW; const int* SDST; bf16* Y; const LAS unsigned char* pfl;
    __device__ __forceinline__ void prefetch(const pg8::Unit& u, LAS unsigned char* pf, int wid, int lane) const {
        if (wid < 3) { const void* src = wid == 0 ? (const void*)(bd + u.e * D + u.pn * 256 + 4 * lane) : wid == 1 ? (const void*)(SW + u.e * ECAP + u.pos0 + 4 * lane) : (const void*)(SDST + u.e * ECAP + u.pos0 + 4 * lane);
            __builtin_amdgcn_global_load_lds((const unsigned*)src, (LAS unsigned*)(pf + wid * 1024), 16, 0, 0); } }
    __device__ __forceinline__ bool keep_acc(const pg8::Unit&) const { return false; }
    __device__ __forceinline__ void operator()(pg8::f32x4 (&acc)[2][2][4][2], const pg8::Unit& u, int wr, int wc, int fr_in, int fq_in) const {
        int fr = fr_in, fq = fq_in; asm volatile("" : "+v"(fr), "+v"(fq));
        typedef pg8::f32x4 f32x4; typedef pg8::u32x4 u32x4;
        const int col0 = u.pn * 256 + wc * 32 + 8 * fq;
        f32x4 bv[2][2];
#pragma unroll
        for (int bj = 0; bj < 2; ++bj)
#pragma unroll
            for (int n = 0; n < 2; ++n) { if constexpr (PREFETCH) bv[bj][n] = *(const LAS f32x4*)((const LAS float*)pfl + wc * 32 + 8 * fq + bj * 128 + 4 * n); else bv[bj][n] = *(const f32x4*)(bd + u.e * D + col0 + bj * 128 + 4 * n); }
        char* const yb = (char*)Y;
        constexpr float ASC = F8 ? 1.0f / (W8_SCALE * ACT8_SCALE) : 1.0f;
        float wv[8]; int dv[8];
#pragma unroll
        for (int q = 0; q < 8; ++q) { const int rl = (q >> 2) * 128 + wr * 64 + (q & 3) * 16 + fr, pos = u.pos0 + rl; const bool ok = pos < u.cnt; const int pc = ok ? pos : u.cnt - 1; int d;
            if constexpr (PREFETCH) { wv[q] = *((const LAS float*)pfl + 256 + rl); d = *((const LAS int*)pfl + 512 + rl); }
            else { wv[q] = SW[u.e * ECAP + pc]; d = SDST[u.e * ECAP + pc]; }
            dv[q] = ok ? d : (int)((WS_TRASH - WS_Y) / ((Y_FP8 ? 1 : 2) * D)); }
#pragma unroll
        for (int ai = 0; ai < 2; ++ai)
#pragma unroll
            for (int m = 0; m < 4; ++m) {
                const float w = wv[ai * 4 + m] * (Y_FP8 ? Y8_SCALE : 1.0f); const unsigned dst = ((unsigned)dv[ai * 4 + m] * 1024u + (unsigned)col0) * (Y_FP8 ? 1u : 2u);
#pragma unroll
                for (int bj = 0; bj < 2; ++bj) { const f32x4 x0 = (acc[ai][bj][m][0] * ASC + bv[bj][0]) * w, x1 = (acc[ai][bj][m][1] * ASC + bv[bj][1]) * w;
                    if constexpr (Y_FP8 != 0) { typedef unsigned u32x2 __attribute__((ext_vector_type(2))); u32x2 o; o.x = pk4_fp8(x0[0], x0[1], x0[2], x0[3]); o.y = pk4_fp8(x1[0], x1[1], x1[2], x1[3]); *(u32x2*)(yb + dst + bj * 128) = o; }
                    else { u32x4 o; o.x = pg8::cvt_pk_bf16(x0[0], x0[1]); o.y = pg8::cvt_pk_bf16(x0[2], x0[3]); o.z = pg8::cvt_pk_bf16(x1[0], x1[1]); o.w = pg8::cvt_pk_bf16(x1[2], x1[3]);
                    *(u32x4*)(yb + dst + bj * 256) = o; } }
            }
    }
};
#include <hip/hip_bf16.h>
#ifndef ATT_DMAPOS
#define ATT_DMAPOS 0
#endif
#ifndef ATT_PRIO
#define ATT_PRIO 1
#endif
namespace attn_body {
using bf16=__hip_bfloat16;
using bf16x8=__attribute__((ext_vector_type(8)))short;
using s16x4=__attribute__((ext_vector_type(4)))short;
using f32x16=__attribute__((ext_vector_type(16)))float;
using u32x4=__attribute__((ext_vector_type(4)))unsigned;
constexpr int D=64;
constexpr int NW=8,QBLK=32,QB=QBLK*NW,KVBLK=64;
#ifndef ONES8_PIN_B
#define ONES8_PIN_B 1
#endif
__device__ __forceinline__ int crow(int r,int hi){return (r&3)+8*(r>>2)+4*hi;}
#define SBAR() __builtin_amdgcn_sched_barrier(0)
constexpr int NSLOT=3, SLOTB=8192;
constexpr int LDS_K=0, LDS_V=NSLOT*SLOTB, LDS_WS=2*NSLOT*SLOTB, LDS_OST=LDS_WS+NW*64*4, LDS_BYTES=LDS_OST+NW*4096;
__device__ __forceinline__ void glds16(const void*gsrc,unsigned lds_dst){unsigned keep;
  asm volatile("s_mov_b32 %0, m0\n\ts_mov_b32 m0, %2\n\ts_nop 0\n\tglobal_load_lds_dwordx4 %1, off\n\ts_mov_b32 m0, %0":"=&s"(keep):"v"(gsrc),"s"(lds_dst):"memory");}
__device__ __forceinline__ float max3f(float a,float b,float c){float r;asm("v_max3_f32 %0, %1, %2, %3":"=v"(r):"v"(a),"v"(b),"v"(c));return r;}
__device__ __forceinline__ float max2f(float a,float b){float r;asm("v_max_f32_e32 %0, %1, %2":"=v"(r):"v"(a),"v"(b));return r;}
__device__ __forceinline__ float fadd_s(float a,float b){float r;asm("v_add_f32_e32 %0, %1, %2":"=v"(r):"v"(a),"v"(b));return r;}
__device__ __forceinline__ float fsub_s(float a,float b){float r;asm("v_sub_f32_e32 %0, %1, %2":"=v"(r):"v"(a),"v"(b));return r;}
typedef float f32x2_t __attribute__((ext_vector_type(2))); typedef __bf16 bf16x2_t __attribute__((ext_vector_type(2)));
__device__ __forceinline__ unsigned cvtpk_s(float lo,float hi){f32x2_t v={lo,hi};bf16x2_t b=__builtin_convertvector(v,bf16x2_t);return __builtin_bit_cast(unsigned,b);}
#define WAIT_BAR(N) asm volatile("s_waitcnt vmcnt(" #N ") lgkmcnt(0)\n\ts_barrier":::"memory")

__device__ __forceinline__ void qkt(f32x16&p0,f32x16&p1,const char*Kslot,const bf16x8*qr,const f32x16&negm,int r32,int hi){
  const char*kb=Kslot+hi*1024+r32*16;
  #pragma unroll
  for(int d0=0;d0<4;++d0){
    const bf16x8 b0=*reinterpret_cast<const bf16x8*>(kb+d0*2048);
    const bf16x8 b1=*reinterpret_cast<const bf16x8*>(kb+d0*2048+512);
    if(d0==0){p0=__builtin_amdgcn_mfma_f32_32x32x16_bf16(b0,qr[0],negm,0,0,0);p1=__builtin_amdgcn_mfma_f32_32x32x16_bf16(b1,qr[0],negm,0,0,0);}
    else{p0=__builtin_amdgcn_mfma_f32_32x32x16_bf16(b0,qr[d0],p0,0,0,0);p1=__builtin_amdgcn_mfma_f32_32x32x16_bf16(b1,qr[d0],p1,0,0,0);}}
}
typedef __attribute__((address_space(3))) const char* lds_cptr;
typedef short v4i16_t __attribute__((ext_vector_type(4)));
__device__ __forceinline__ void kload8(bf16x8*kf,lds_cptr kp){
  kf[0]=*(const __attribute__((address_space(3))) bf16x8*)(kp);      kf[1]=*(const __attribute__((address_space(3))) bf16x8*)(kp+512);
  kf[2]=*(const __attribute__((address_space(3))) bf16x8*)(kp+2048); kf[3]=*(const __attribute__((address_space(3))) bf16x8*)(kp+2560);
  kf[4]=*(const __attribute__((address_space(3))) bf16x8*)(kp+4096); kf[5]=*(const __attribute__((address_space(3))) bf16x8*)(kp+4608);
  kf[6]=*(const __attribute__((address_space(3))) bf16x8*)(kp+6144); kf[7]=*(const __attribute__((address_space(3))) bf16x8*)(kp+6656);
}
__device__ __forceinline__ void kload2(bf16x8*kf,lds_cptr kp,int j){ kf[2*j]=*(const __attribute__((address_space(3))) bf16x8*)(kp+j*2048); kf[2*j+1]=*(const __attribute__((address_space(3))) bf16x8*)(kp+j*2048+512); }
__device__ __forceinline__ s16x4 vtr(lds_cptr p){ return __builtin_bit_cast(s16x4,__builtin_amdgcn_ds_read_tr16_b64_v4i16((__attribute__((address_space(3))) v4i16_t*)p)); }
template<int DV> struct Lds2 { static constexpr int VSLOT=DV*128, K=0, V=NSLOT*SLOTB, WS=V+NSLOT*VSLOT, OST=WS+NW*64*4, BYTES=OST+NW*4096; };
template<int DV,bool ONES,int NT,int QP,int KP,int VP,int OP,int O8=0> __device__ __forceinline__ void attn_unit2(const bf16*Qu,const bf16*__restrict__ Kb,const bf16*__restrict__ Vb,bf16*Ou,char*shm){
  typedef Lds2<DV> L; constexpr int ND=DV/32, NV=DV/64, VSLOT=L::VSLOT;
  const int tid=threadIdx.x,lane=tid&63,r32=lane&31,hi=lane>>5; const int wid=__builtin_amdgcn_readfirstlane(tid>>6);
  const bf16*Qw=Qu+(long)(wid*QBLK)*QP;
  const unsigned lds0=(unsigned)(uintptr_t)shm;
  float*wsf=(float*)(shm+L::WS)+wid*64;
  const bf16*ksrc=Kb+(long)lane*KP+wid*8;
  const bf16*vsrc=Vb+(long)(16*(wid&3)+(lane>>2))*VP+(wid>>2)*32+(lane&3)*8;
  const unsigned kdst=lds0+L::K+wid*1024, vdst=lds0+L::V+wid*1024;
  #define DMA_K(t,slot) glds16(ksrc+(long)(t)*KVBLK*KP,(unsigned)__builtin_amdgcn_readfirstlane(kdst+(slot)*SLOTB))
  #define DMA_V(t,slot) do{ _Pragma("unroll") for(int q_=0;q_<NV;++q_) glds16(vsrc+(long)(t)*KVBLK*VP+q_*64,(unsigned)__builtin_amdgcn_readfirstlane(vdst+(slot)*VSLOT+q_*8192)); }while(0)
  #define WAITB_KV() do{ if constexpr(NV==1) asm volatile("s_waitcnt vmcnt(2) lgkmcnt(0)\n\ts_barrier":::"memory"); else asm volatile("s_waitcnt vmcnt(3) lgkmcnt(0)\n\ts_barrier":::"memory"); }while(0)
  #define WAITB_V()  do{ if constexpr(NV==1) asm volatile("s_waitcnt vmcnt(1) lgkmcnt(0)\n\ts_barrier":::"memory"); else asm volatile("s_waitcnt vmcnt(2) lgkmcnt(0)\n\ts_barrier":::"memory"); }while(0)
  #define WAITB_0()  asm volatile("s_waitcnt vmcnt(0) lgkmcnt(0)\n\ts_barrier":::"memory")
  const char*Kbase=shm+L::K; bf16x8 kf[8];
  const lds_cptr shm3=(lds_cptr)shm; const lds_cptr kp0=shm3+L::K+hi*1024+r32*16; const lds_cptr vp0=shm3+L::V+((lane>>4)&1)*32+(lane&3)*8+(4*hi+((lane&15)>>2))*64;
  DMA_K(0,0);DMA_V(0,0);DMA_K(1,1);
  bf16x8 qr[4];
  #pragma unroll
  for(int d0=0;d0<4;++d0)qr[d0]=*reinterpret_cast<const bf16x8*>(&Qw[(long)r32*QP+d0*16+hi*8]);
  float l_reg=0.f; f32x16 o[ND]; f32x16 os=f32x16{};
  #pragma unroll
  for(int d_=0;d_<ND;++d_)o[d_]=f32x16{};
  const f32x16 zero16=f32x16{};
  const bf16x8 ones={(short)0x3F80,(short)0x3F80,(short)0x3F80,(short)0x3F80,(short)0x3F80,(short)0x3F80,(short)0x3F80,(short)0x3F80};
  f32x16 pA0,pA1,pB0,pB1;
  int sp=0,sc=0,sn=1;
  #define ROT() do{sp=sc;sc=sn;sn=(sn==NSLOT-1)?0:sn+1;}while(0)
  DMA_K(2,2);
  asm volatile("s_waitcnt vmcnt(3) lgkmcnt(0)\n\ts_barrier":::"memory");
  qkt(pA0,pA1,Kbase,qr,zero16,r32,hi);asm volatile("s_nop 15\n\ts_nop 7":"+v"(pA0),"+v"(pA1));
  _Pragma("unroll") for(int r=0;r<16;++r){pA0[r]=__builtin_amdgcn_exp2f(pA0[r]);pA1[r]=__builtin_amdgcn_exp2f(pA1[r]);}
  WAITB_0();
  DMA_K(3,0);DMA_V(1,1);
  ROT();
  kload8(kf,kp0+sc*SLOTB);
  WAITB_KV();
  s16x4 vlo[4*ND],vhi[4*ND]; u32x4 pw0,pw1,pw2,pw3;
  #define PKW(P,B) cvtpk_s(P[B],P[B+1])
  #define PAF(k) __builtin_bit_cast(bf16x8,pw##k)
  #define VFR(i) (bf16x8){vlo[i][0],vlo[i][1],vlo[i][2],vlo[i][3],vhi[i][0],vhi[i][1],vhi[i][2],vhi[i][3]}
  #define PIN(x) asm volatile("":"+v"(x))
  #define MF(a,b,c) __builtin_amdgcn_mfma_f32_32x32x16_bf16(a,b,c,0,0,0)
  #define EX(v) __builtin_amdgcn_exp2f(v)
  #define EXQ(C0,C1,e) do{ if((e)<16) C0[(e)&15]=EX(C0[(e)&15]); else C1[(e)&15]=EX(C1[(e)&15]); }while(0)
  #define VRD(i) do{ vlo[i]=vtr(vp_+(((i)>>2)*4096+((i)&3)*1024)); vhi[i]=vtr(vp_+(((i)>>2)*4096+((i)&3)*1024+512)); }while(0)
  #define KRD(G,j) do{ if(G){ kload2(kf,kp0+sn*SLOTB,j); SBAR(); } }while(0)
  #define GAPA(DST,MFX,A0,A1,A2,A3,W0,W1,PW) do{ DST=MFX; PIN(DST); if constexpr(!ONES){ sacc+=A0; sacc+=A1; sacc+=A2; sacc+=A3; PIN(sacc); } W0; W1; PIN(PW); SBAR(); }while(0)
  #define GAPB(DST,MFX,C0,C1,e0,NE) do{ DST=MFX; PIN(DST); _Pragma("unroll") for(int e_=0;e_<(NE);++e_) EXQ(C0,C1,(e0)+e_); PIN(C0); PIN(C1); SBAR(); }while(0)
  #define STEP(C0,C1,P0,P1,t,GK,GV,GL) do{ SBAR(); \
    const lds_cptr vp_=vp0+sp*VSLOT; \
    VRD(0); SBAR(); float sacc=0.f; if constexpr(!ONES){ sacc=(P0[0]+P0[1]); } \
    GAPA(C0,MF(kf[0],qr[0],zero16), P0[2],P0[3],P0[4],P0[5],     pw0[0]=PKW(P0,0), pw0[1]=PKW(P0,2), pw0); \
    VRD(4); SBAR(); GAPA(C1,MF(kf[1],qr[0],zero16), P0[6],P0[7],P0[8],P0[9],     pw0[2]=PKW(P0,4), pw0[3]=PKW(P0,6), pw0); \
    VRD(1); SBAR(); GAPA(C0,MF(kf[2],qr[1],C0),   P0[10],P0[11],P0[12],P0[13], pw1[0]=PKW(P0,8), pw1[1]=PKW(P0,10), pw1); \
    VRD(5); SBAR(); GAPA(C1,MF(kf[3],qr[1],C1),   P0[14],P0[15],P1[0],P1[1],   pw1[2]=PKW(P0,12),pw1[3]=PKW(P0,14), pw1); \
    VRD(2); SBAR(); GAPA(C0,MF(kf[4],qr[2],C0),   P1[2],P1[3],P1[4],P1[5],     pw2[0]=PKW(P1,0), pw2[1]=PKW(P1,2), pw2); \
    VRD(6); SBAR(); GAPA(C1,MF(kf[5],qr[2],C1),   P1[6],P1[7],P1[8],P1[9],     pw2[2]=PKW(P1,4), pw2[3]=PKW(P1,6), pw2); \
    VRD(3); SBAR(); GAPA(C0,MF(kf[6],qr[3],C0),   P1[10],P1[11],P1[12],P1[13], pw3[0]=PKW(P1,8), pw3[1]=PKW(P1,10), pw3); \
    VRD(7); SBAR(); GAPA(C1,MF(kf[7],qr[3],C1),   P1[14],P1[15],0.f,0.f,       pw3[2]=PKW(P1,12),pw3[3]=PKW(P1,14), pw3); \
    if constexpr(!ONES){ l_reg+=sacc; } \
    if constexpr(ATT_DMAPOS==0){ if(GK){DMA_K((t)+3,sc);} if(GV){DMA_V((t)+1,sn);} } \
    SBAR(); \
    if constexpr(DV==64 && !ONES){ \
      GAPB(o[0],MF(PAF(0),VFR(0),o[0]), C0,C1,0,4); \
      GAPB(o[1],MF(PAF(0),VFR(4),o[1]), C0,C1,4,4); \
      KRD(GL,0); GAPB(o[0],MF(PAF(1),VFR(1),o[0]), C0,C1,8,4); \
      KRD(GL,1); GAPB(o[1],MF(PAF(1),VFR(5),o[1]), C0,C1,12,4); \
      KRD(GL,2); GAPB(o[0],MF(PAF(2),VFR(2),o[0]), C0,C1,16,4); \
      KRD(GL,3); GAPB(o[1],MF(PAF(2),VFR(6),o[1]), C0,C1,20,4); \
      GAPB(o[0],MF(PAF(3),VFR(3),o[0]), C0,C1,24,4); \
      GAPB(o[1],MF(PAF(3),VFR(7),o[1]), C0,C1,28,4); \
    } else if constexpr(DV==64){ \
      GAPB(o[0],MF(PAF(0),VFR(0),o[0]), C0,C1,0,3); \
      GAPB(o[1],MF(PAF(0),VFR(4),o[1]), C0,C1,3,3); \
      KRD(GL,0); GAPB(o[0],MF(PAF(1),VFR(1),o[0]), C0,C1,6,3); \
      KRD(GL,1); GAPB(o[1],MF(PAF(1),VFR(5),o[1]), C0,C1,9,3); \
      KRD(GL,2); GAPB(o[0],MF(PAF(2),VFR(2),o[0]), C0,C1,12,3); \
      KRD(GL,3); GAPB(o[1],MF(PAF(2),VFR(6),o[1]), C0,C1,15,3); \
      GAPB(o[0],MF(PAF(3),VFR(3),o[0]), C0,C1,18,3); \
      GAPB(o[1],MF(PAF(3),VFR(7),o[1]), C0,C1,21,3); \
      GAPB(os,MF(PAF(0),ones,os), C0,C1,24,2); \
      GAPB(os,MF(PAF(1),ones,os), C0,C1,26,2); \
      GAPB(os,MF(PAF(2),ones,os), C0,C1,28,2); \
      GAPB(os,MF(PAF(3),ones,os), C0,C1,30,2); \
    } else { \
      GAPB(o[0],MF(PAF(0),VFR(0),o[0]), C0,C1,0,2);  VRD(8);  SBAR(); \
      GAPB(o[1],MF(PAF(0),VFR(4),o[1]), C0,C1,2,2);  VRD(12); SBAR(); \
      KRD(GL,0); GAPB(o[0],MF(PAF(1),VFR(1),o[0]), C0,C1,4,2);  VRD(9);  SBAR(); \
      KRD(GL,1); GAPB(o[1],MF(PAF(1),VFR(5),o[1]), C0,C1,6,2);  VRD(13); SBAR(); \
      KRD(GL,2); GAPB(o[0],MF(PAF(2),VFR(2),o[0]), C0,C1,8,2);  VRD(10); SBAR(); \
      KRD(GL,3); GAPB(o[1],MF(PAF(2),VFR(6),o[1]), C0,C1,10,2); VRD(14); SBAR(); \
      GAPB(o[0],MF(PAF(3),VFR(3),o[0]), C0,C1,12,2); VRD(11); SBAR(); \
      GAPB(o[1],MF(PAF(3),VFR(7),o[1]), C0,C1,14,2); VRD(15); SBAR(); \
      if constexpr(!ONES){ \
      GAPB(o[ND-2],MF(PAF(0),VFR(8 %(4*ND)),o[ND-2]),  C0,C1,16,2); \
      GAPB(o[ND-1],MF(PAF(0),VFR(12%(4*ND)),o[ND-1]), C0,C1,18,2); \
      GAPB(o[ND-2],MF(PAF(1),VFR(9 %(4*ND)),o[ND-2]),  C0,C1,20,2); \
      GAPB(o[ND-1],MF(PAF(1),VFR(13%(4*ND)),o[ND-1]), C0,C1,22,2); \
      GAPB(o[ND-2],MF(PAF(2),VFR(10%(4*ND)),o[ND-2]), C0,C1,24,2); \
      GAPB(o[ND-1],MF(PAF(2),VFR(14%(4*ND)),o[ND-1]), C0,C1,26,2); \
      GAPB(o[ND-2],MF(PAF(3),VFR(11%(4*ND)),o[ND-2]), C0,C1,28,2); \
      GAPB(o[ND-1],MF(PAF(3),VFR(15%(4*ND)),o[ND-1]), C0,C1,30,2); \
      } else { \
      GAPB(o[ND-2],MF(PAF(0),VFR(8 %(4*ND)),o[ND-2]),  C0,C1,16,1); \
      GAPB(o[ND-1],MF(PAF(0),VFR(12%(4*ND)),o[ND-1]), C0,C1,17,1); \
      GAPB(o[ND-2],MF(PAF(1),VFR(9 %(4*ND)),o[ND-2]),  C0,C1,18,1); \
      GAPB(o[ND-1],MF(PAF(1),VFR(13%(4*ND)),o[ND-1]), C0,C1,19,1); \
      GAPB(o[ND-2],MF(PAF(2),VFR(10%(4*ND)),o[ND-2]), C0,C1,20,1); \
      GAPB(o[ND-1],MF(PAF(2),VFR(14%(4*ND)),o[ND-1]), C0,C1,21,1); \
      GAPB(o[ND-2],MF(PAF(3),VFR(11%(4*ND)),o[ND-2]), C0,C1,22,1); \
      GAPB(o[ND-1],MF(PAF(3),VFR(15%(4*ND)),o[ND-1]), C0,C1,23,1); \
      GAPB(os,MF(PAF(0),ones,os), C0,C1,24,2); \
      GAPB(os,MF(PAF(1),ones,os), C0,C1,26,2); \
      GAPB(os,MF(PAF(2),ones,os), C0,C1,28,2); \
      GAPB(os,MF(PAF(3),ones,os), C0,C1,30,2); \
      } \
    } \
    if constexpr(ATT_DMAPOS==1){ SBAR(); if(GK){DMA_K((t)+3,sc);} if(GV){DMA_V((t)+1,sn);} } \
    }while(0)
  if(ATT_PRIO && wid>=4) __builtin_amdgcn_s_setprio(1);
  int t=1;
  for(;t+5<NT;t+=2){
    STEP(pB0,pB1,pA0,pA1,t,true,true,true);     WAITB_KV(); ROT();
    STEP(pA0,pA1,pB0,pB1,t+1,true,true,true);   WAITB_KV(); ROT();
  }
  #define ENDW(tt) do{ if((tt)+3<NT){WAITB_KV();} else if((tt)+2<NT){WAITB_V();} else {WAITB_0();} }while(0)
  for(;t+1<NT;t+=2){
    STEP(pB0,pB1,pA0,pA1,t,(t+3<NT),(t+1<NT),(t+1<NT));       ENDW(t);   ROT();
    STEP(pA0,pA1,pB0,pB1,t+1,(t+4<NT),(t+2<NT),(t+2<NT));     ENDW(t+1); ROT();
  }
  STEP(pB0,pB1,pA0,pA1,NT-1,false,false,false);
  { if constexpr(!ONES){ float sacc=pB0[0]+pB0[1]; _Pragma("unroll") for(int r=2;r<16;++r)sacc+=pB0[r]; _Pragma("unroll") for(int r=0;r<16;++r)sacc+=pB1[r]; l_reg+=sacc; }
    pw0=(u32x4){PKW(pB0,0),PKW(pB0,2),PKW(pB0,4),PKW(pB0,6)};pw1=(u32x4){PKW(pB0,8),PKW(pB0,10),PKW(pB0,12),PKW(pB0,14)};pw2=(u32x4){PKW(pB1,0),PKW(pB1,2),PKW(pB1,4),PKW(pB1,6)};pw3=(u32x4){PKW(pB1,8),PKW(pB1,10),PKW(pB1,12),PKW(pB1,14)};
    SBAR();
    const lds_cptr vp_=vp0+sc*VSLOT;
    #pragma unroll
    for(int d0=0;d0<ND;++d0){
      #pragma unroll
      for(int ks=0;ks<4;++ks){ const int i=(d0&1)*4+ks; vlo[i]=vtr(vp_+(d0*4096+ks*1024)); vhi[i]=vtr(vp_+(d0*4096+ks*1024+512)); }
      o[d0]=MF(PAF(0),VFR((d0&1)*4+0),o[d0]); o[d0]=MF(PAF(1),VFR((d0&1)*4+1),o[d0]); o[d0]=MF(PAF(2),VFR((d0&1)*4+2),o[d0]); o[d0]=MF(PAF(3),VFR((d0&1)*4+3),o[d0]); }
    if constexpr(ONES){ os=MF(PAF(0),ones,os); os=MF(PAF(1),ones,os); os=MF(PAF(2),ones,os); os=MF(PAF(3),ones,os); } }
  #undef PKW
  #undef PAF
  #undef VFR
  #undef PIN
  #undef MF
  #undef EX
  #undef EXQ
  #undef GAPA
  #undef GAPB
  #undef VRD
  #undef KRD
  #undef STEP
  #undef ENDW
  if(ATT_PRIO && wid>=4) __builtin_amdgcn_s_setprio(0);
  float rli[16];
  if constexpr(ONES){
    #pragma unroll
    for(int r=0;r<16;++r)rli[r]=__builtin_amdgcn_rcpf(os[r]);
  } else {
    {auto rr=__builtin_amdgcn_permlane32_swap(__float_as_uint(l_reg),__float_as_uint(l_reg),false,false);l_reg=__uint_as_float(rr[0])+__uint_as_float(rr[1]);}
    if(hi==0)wsf[32+r32]=l_reg;asm volatile("s_waitcnt lgkmcnt(0)":::"memory");
    #pragma unroll
    for(int r=0;r<16;++r)rli[r]=__builtin_amdgcn_rcpf(wsf[32+crow(r,hi)]);
  }
  if constexpr(O8!=0){ unsigned char*Ow8=(unsigned char*)Ou+(long)(wid*QBLK)*OP; unsigned char*stg8=(unsigned char*)(shm+L::OST)+wid*4096;
    #pragma unroll
    for(int hf=0;hf<NV;++hf){
      #pragma unroll
      for(int r=0;r<16;++r){const int orow=crow(r,hi);
        #pragma unroll
        for(int d0=0;d0<2;++d0){ const float v=__builtin_amdgcn_fmed3f(o[2*hf+d0][r]*rli[r]*YA8_SCALE,-448.0f,448.0f); stg8[orow*64+d0*32+r32]=(unsigned char)__builtin_amdgcn_cvt_pk_fp8_f32(v,v,0,false); } }
      asm volatile("s_waitcnt lgkmcnt(0)":::"memory");
      #pragma unroll
      for(int i=0;i<2;++i){const int row=i*16+(lane>>2),ch=lane&3; const u32x4 v=*(const u32x4*)(stg8+row*64+ch*16); *(u32x4*)(Ow8+(long)row*OP+hf*64+ch*16)=v;}
      asm volatile("s_waitcnt lgkmcnt(0)":::"memory");
    } } else {
  bf16*Ow=Ou+(long)(wid*QBLK)*OP;
  { bf16*stg=(bf16*)(shm+L::OST)+wid*2048;
    #pragma unroll
    for(int hf=0;hf<NV;++hf){
      #pragma unroll
      for(int r=0;r<16;++r){const int orow=crow(r,hi);
        #pragma unroll
        for(int d0=0;d0<2;++d0)stg[orow*64+d0*32+r32]=__float2bfloat16(o[2*hf+d0][r]*rli[r]);}
      asm volatile("s_waitcnt lgkmcnt(0)":::"memory");
      #pragma unroll
      for(int i=0;i<4;++i){const int row=i*8+(lane>>3),ch=lane&7; const u32x4 v=*(const u32x4*)(stg+row*64+ch*8); *(u32x4*)(Ow+(long)row*OP+hf*64+ch*8)=v;}
      asm volatile("s_waitcnt lgkmcnt(0)":::"memory");
    } } }
  asm volatile("s_waitcnt lgkmcnt(0)\n\ts_barrier":::"memory");
  #undef DMA_K
  #undef DMA_V
  #undef WAITB_KV
  #undef WAITB_V
  #undef WAITB_0
  #undef ROT
}

template<int DV> struct Lds3 { static constexpr int NS=4, VSLOT=DV*128, K=0, V=NS*SLOTB, WS=V+NS*VSLOT, OST=WS+NW*64*4, BYTES=OST+NW*4096; };
template<int HALF_,int DV,bool ONES,int NT,int QP,int KP,int VP,int OP> __device__ __forceinline__ void attn_unit3h(const bf16*Qu,const bf16*__restrict__ Kb,const bf16*__restrict__ Vb,bf16*Ou,char*shm){
  typedef Lds3<DV> L; constexpr int ND=DV/32, NV=DV/64, VSLOT=L::VSLOT;
  const int tid=threadIdx.x,lane=tid&63,r32=lane&31,hi=lane>>5; const int wid=__builtin_amdgcn_readfirstlane(tid>>6);
  const bf16*Qw=Qu+(long)(wid*QBLK)*QP;
  const unsigned lds0=(unsigned)(uintptr_t)shm;
  float*wsf=(float*)(shm+L::WS)+wid*64;
  const bf16*ksrc=Kb+(long)lane*KP+wid*8;
  const bf16*vsrc=Vb+(long)(16*(wid&3)+(lane>>2))*VP+(wid>>2)*32+(lane&3)*8;
  const unsigned kdst=lds0+L::K+wid*1024, vdst=lds0+L::V+wid*1024;
  #define DMA_K(t,slot) glds16(ksrc+(long)(t)*KVBLK*KP,(unsigned)__builtin_amdgcn_readfirstlane(kdst+(slot)*SLOTB))
  #define DMA_V(t,slot) do{ _Pragma("unroll") for(int q_=0;q_<NV;++q_) glds16(vsrc+(long)(t)*KVBLK*VP+q_*64,(unsigned)__builtin_amdgcn_readfirstlane(vdst+(slot)*VSLOT+q_*8192)); }while(0)
  #define WAITB_KV() do{ if constexpr(NV==1) asm volatile("s_waitcnt vmcnt(2) lgkmcnt(0)\n\ts_barrier":::"memory"); else asm volatile("s_waitcnt vmcnt(3) lgkmcnt(0)\n\ts_barrier":::"memory"); }while(0)
  #define WAITB_V()  do{ if constexpr(NV==1) asm volatile("s_waitcnt vmcnt(1) lgkmcnt(0)\n\ts_barrier":::"memory"); else asm volatile("s_waitcnt vmcnt(2) lgkmcnt(0)\n\ts_barrier":::"memory"); }while(0)
  #define WAITB_0()  asm volatile("s_waitcnt vmcnt(0) lgkmcnt(0)\n\ts_barrier":::"memory")
  const char*Kbase=shm+L::K; bf16x8 kf[8];
  const lds_cptr shm3=(lds_cptr)shm; const lds_cptr kp0=shm3+L::K+hi*1024+r32*16; const lds_cptr vp0=shm3+L::V+((lane>>4)&1)*32+(lane&3)*8+(4*hi+((lane&15)>>2))*64;
  DMA_K(0,0);DMA_V(0,0);DMA_K(1,1);
  bf16x8 qr[4];
  #pragma unroll
  for(int d0=0;d0<4;++d0)qr[d0]=*reinterpret_cast<const bf16x8*>(&Qw[(long)r32*QP+d0*16+hi*8]);
  float l_reg=0.f; f32x16 o[ND]; f32x16 os=f32x16{};
  #pragma unroll
  for(int d_=0;d_<ND;++d_)o[d_]=f32x16{};
  const f32x16 zero16=f32x16{};
  const bf16x8 ones={(short)0x3F80,(short)0x3F80,(short)0x3F80,(short)0x3F80,(short)0x3F80,(short)0x3F80,(short)0x3F80,(short)0x3F80};
  f32x16 pA0,pA1,pB0,pB1;
  DMA_K(2,2);
  asm volatile("s_waitcnt vmcnt(3) lgkmcnt(0)\n\ts_barrier":::"memory");
  qkt(pA0,pA1,Kbase,qr,zero16,r32,hi);asm volatile("s_nop 15\n\ts_nop 7":"+v"(pA0),"+v"(pA1));
  _Pragma("unroll") for(int r=0;r<16;++r){pA0[r]=__builtin_amdgcn_exp2f(pA0[r]);pA1[r]=__builtin_amdgcn_exp2f(pA1[r]);}
  WAITB_0();
  DMA_K(3,3);DMA_V(1,1);
  kload8(kf,kp0+1*SLOTB);
  s16x4 vlo[4*ND],vhi[4*ND]; u32x4 pw0,pw1,pw2,pw3;
  #define PKW(P,B) cvtpk_s(P[B],P[B+1])
  #define PAF(k) __builtin_bit_cast(bf16x8,pw##k)
  #define VFR(i) (bf16x8){vlo[i][0],vlo[i][1],vlo[i][2],vlo[i][3],vhi[i][0],vhi[i][1],vhi[i][2],vhi[i][3]}
  #define PIN(x) asm volatile("":"+v"(x))
  #define MF(a,b,c) __builtin_amdgcn_mfma_f32_32x32x16_bf16(a,b,c,0,0,0)
  #define EX(v) __builtin_amdgcn_exp2f(v)
  #define EXQ(C0,C1,e) do{ if((e)<16) C0[(e)&15]=EX(C0[(e)&15]); else C1[(e)&15]=EX(C1[(e)&15]); }while(0)
  #define VRD(VP_,i) do{ vlo[i]=vtr(VP_+(((i)>>2)*4096+((i)&3)*1024)); vhi[i]=vtr(VP_+(((i)>>2)*4096+((i)&3)*1024+512)); }while(0)
  #define KRD(G,KP_,j) do{ if(G){ kload2(kf,KP_,j); SBAR(); } }while(0)
  #define GAPA(DST,MFX,A0,A1,A2,A3,W0,W1,PW) do{ DST=MFX; PIN(DST); if constexpr(!ONES){ sacc+=A0; sacc+=A1; sacc+=A2; sacc+=A3; PIN(sacc); } W0; W1; PIN(PW); SBAR(); }while(0)
  #define GAPB(DST,MFX,C0,C1,e0,NE) do{ DST=MFX; PIN(DST); _Pragma("unroll") for(int e_=0;e_<(NE);++e_) EXQ(C0,C1,(e0)+e_); PIN(C0); PIN(C1); SBAR(); }while(0)
  #define PH_A(C0,C1,P0,P1,VS) do{ SBAR(); \
    const lds_cptr vp_=vp0+(VS)*VSLOT; \
    VRD(vp_,0); SBAR(); float sacc=0.f; if constexpr(!ONES){ sacc=(P0[0]+P0[1]); } \
    GAPA(C0,MF(kf[0],qr[0],zero16), P0[2],P0[3],P0[4],P0[5],     pw0[0]=PKW(P0,0), pw0[1]=PKW(P0,2), pw0); \
    VRD(vp_,4); SBAR(); GAPA(C1,MF(kf[1],qr[0],zero16), P0[6],P0[7],P0[8],P0[9],     pw0[2]=PKW(P0,4), pw0[3]=PKW(P0,6), pw0); \
    VRD(vp_,1); SBAR(); GAPA(C0,MF(kf[2],qr[1],C0),   P0[10],P0[11],P0[12],P0[13], pw1[0]=PKW(P0,8), pw1[1]=PKW(P0,10), pw1); \
    VRD(vp_,5); SBAR(); GAPA(C1,MF(kf[3],qr[1],C1),   P0[14],P0[15],P1[0],P1[1],   pw1[2]=PKW(P0,12),pw1[3]=PKW(P0,14), pw1); \
    VRD(vp_,2); SBAR(); GAPA(C0,MF(kf[4],qr[2],C0),   P1[2],P1[3],P1[4],P1[5],     pw2[0]=PKW(P1,0), pw2[1]=PKW(P1,2), pw2); \
    VRD(vp_,6); SBAR(); GAPA(C1,MF(kf[5],qr[2],C1),   P1[6],P1[7],P1[8],P1[9],     pw2[2]=PKW(P1,4), pw2[3]=PKW(P1,6), pw2); \
    VRD(vp_,3); SBAR(); GAPA(C0,MF(kf[6],qr[3],C0),   P1[10],P1[11],P1[12],P1[13], pw3[0]=PKW(P1,8), pw3[1]=PKW(P1,10), pw3); \
    VRD(vp_,7); SBAR(); GAPA(C1,MF(kf[7],qr[3],C1),   P1[14],P1[15],0.f,0.f,       pw3[2]=PKW(P1,12),pw3[3]=PKW(P1,14), pw3); \
    if constexpr(!ONES){ l_reg+=sacc; } SBAR(); }while(0)
  #define PH_B(C0,C1,KS,VS2,GL) do{ SBAR(); \
    const lds_cptr kq_=kp0+(KS)*SLOTB; const lds_cptr vq_=vp0+(VS2)*VSLOT; (void)vq_; \
    if constexpr(DV==64 && !ONES){ \
      GAPB(o[0],MF(PAF(0),VFR(0),o[0]), C0,C1,0,4); \
      GAPB(o[1],MF(PAF(0),VFR(4),o[1]), C0,C1,4,4); \
      KRD(GL,kq_,0); GAPB(o[0],MF(PAF(1),VFR(1),o[0]), C0,C1,8,4); \
      KRD(GL,kq_,1); GAPB(o[1],MF(PAF(1),VFR(5),o[1]), C0,C1,12,4); \
      KRD(GL,kq_,2); GAPB(o[0],MF(PAF(2),VFR(2),o[0]), C0,C1,16,4); \
      KRD(GL,kq_,3); GAPB(o[1],MF(PAF(2),VFR(6),o[1]), C0,C1,20,4); \
      GAPB(o[0],MF(PAF(3),VFR(3),o[0]), C0,C1,24,4); \
      GAPB(o[1],MF(PAF(3),VFR(7),o[1]), C0,C1,28,4); \
    } else if constexpr(DV==64){ \
      GAPB(o[0],MF(PAF(0),VFR(0),o[0]), C0,C1,0,3); \
      GAPB(o[1],MF(PAF(0),VFR(4),o[1]), C0,C1,3,3); \
      KRD(GL,kq_,0); GAPB(o[0],MF(PAF(1),VFR(1),o[0]), C0,C1,6,3); \
      KRD(GL,kq_,1); GAPB(o[1],MF(PAF(1),VFR(5),o[1]), C0,C1,9,3); \
      KRD(GL,kq_,2); GAPB(o[0],MF(PAF(2),VFR(2),o[0]), C0,C1,12,3); \
      KRD(GL,kq_,3); GAPB(o[1],MF(PAF(2),VFR(6),o[1]), C0,C1,15,3); \
      GAPB(o[0],MF(PAF(3),VFR(3),o[0]), C0,C1,18,3); \
      GAPB(o[1],MF(PAF(3),VFR(7),o[1]), C0,C1,21,3); \
      GAPB(os,MF(PAF(0),ones,os), C0,C1,24,2); \
      GAPB(os,MF(PAF(1),ones,os), C0,C1,26,2); \
      GAPB(os,MF(PAF(2),ones,os), C0,C1,28,2); \
      GAPB(os,MF(PAF(3),ones,os), C0,C1,30,2); \
    } else { \
      GAPB(o[0],MF(PAF(0),VFR(0),o[0]), C0,C1,0,2);  VRD(vq_,8%(4*ND));  SBAR(); \
      GAPB(o[1],MF(PAF(0),VFR(4),o[1]), C0,C1,2,2);  VRD(vq_,12%(4*ND)); SBAR(); \
      KRD(GL,kq_,0); GAPB(o[0],MF(PAF(1),VFR(1),o[0]), C0,C1,4,2);  VRD(vq_,9%(4*ND));  SBAR(); \
      KRD(GL,kq_,1); GAPB(o[1],MF(PAF(1),VFR(5),o[1]), C0,C1,6,2);  VRD(vq_,13%(4*ND)); SBAR(); \
      KRD(GL,kq_,2); GAPB(o[0],MF(PAF(2),VFR(2),o[0]), C0,C1,8,2);  VRD(vq_,10%(4*ND)); SBAR(); \
      KRD(GL,kq_,3); GAPB(o[1],MF(PAF(2),VFR(6),o[1]), C0,C1,10,2); VRD(vq_,14%(4*ND)); SBAR(); \
      GAPB(o[0],MF(PAF(3),VFR(3),o[0]), C0,C1,12,2); VRD(vq_,11%(4*ND)); SBAR(); \
      GAPB(o[1],MF(PAF(3),VFR(7),o[1]), C0,C1,14,2); VRD(vq_,15%(4*ND)); SBAR(); \
      GAPB(o[ND-2],MF(PAF(0),VFR(8 %(4*ND)),o[ND-2]),  C0,C1,16,2); \
      GAPB(o[ND-1],MF(PAF(0),VFR(12%(4*ND)),o[ND-1]), C0,C1,18,2); \
      GAPB(o[ND-2],MF(PAF(1),VFR(9 %(4*ND)),o[ND-2]),  C0,C1,20,2); \
      GAPB(o[ND-1],MF(PAF(1),VFR(13%(4*ND)),o[ND-1]), C0,C1,22,2); \
      GAPB(o[ND-2],MF(PAF(2),VFR(10%(4*ND)),o[ND-2]), C0,C1,24,2); \
      GAPB(o[ND-1],MF(PAF(2),VFR(14%(4*ND)),o[ND-1]), C0,C1,26,2); \
      GAPB(o[ND-2],MF(PAF(3),VFR(11%(4*ND)),o[ND-2]), C0,C1,28,2); \
      GAPB(o[ND-1],MF(PAF(3),VFR(15%(4*ND)),o[ND-1]), C0,C1,30,2); \
    } }while(0)
  #define DMAS(t,GK,GV) do{ if(GK){DMA_K((t)+3,((t)+3)&3);} if(GV){DMA_V((t)+1,((t)+1)&3);} }while(0)
  #define ENDW(tt) do{ if((tt)+3<NT){WAITB_KV();} else if((tt)+2<NT){WAITB_V();} else {WAITB_0();} }while(0)
  #define S0_ODD(t,GK,GV,GL)  do{ PH_A(pB0,pB1,pA0,pA1,((t)-1)&3); DMAS(t,GK,GV); PH_B(pB0,pB1,((t)+1)&3,((t)-1)&3,GL); }while(0)
  #define S0_EVEN(t,GK,GV,GL) do{ PH_A(pA0,pA1,pB0,pB1,((t)-1)&3); DMAS(t,GK,GV); PH_B(pA0,pA1,((t)+1)&3,((t)-1)&3,GL); }while(0)
  #define S1_EVEN(t,GK,GV)    do{ PH_B(pB0,pB1,(t)&3,((t)-2)&3,true); DMAS(t,GK,GV); PH_A(pA0,pA1,pB0,pB1,((t)-1)&3); }while(0)
  #define S1_ODD(t,GK,GV)     do{ PH_B(pA0,pA1,(t)&3,((t)-2)&3,true); DMAS(t,GK,GV); PH_A(pB0,pB1,pA0,pA1,((t)-1)&3); }while(0)
  if constexpr(HALF_==0){
    int t=1;
    for(;t+5<NT;t+=2){ S0_ODD(t,true,true,true); WAITB_KV(); S0_EVEN(t+1,true,true,true); WAITB_KV(); }
    for(;t+1<NT;t+=2){ S0_ODD(t,(t+3<NT),(t+1<NT),(t+1<NT)); ENDW(t); S0_EVEN(t+1,(t+4<NT),(t+2<NT),(t+2<NT)); ENDW(t+1); }
    S0_ODD(NT-1,false,false,false);
  } else {
    DMAS(1,true,true); PH_A(pB0,pB1,pA0,pA1,0); WAITB_KV();
    int t=2;
    for(;t+4<NT;t+=2){ S1_EVEN(t,true,true); WAITB_KV(); S1_ODD(t+1,true,true); WAITB_KV(); }
    for(;t+2<NT;t+=2){ S1_EVEN(t,(t+3<NT),(t+1<NT)); ENDW(t); S1_ODD(t+1,(t+4<NT),(t+2<NT)); ENDW(t+1); }
    S1_EVEN(NT-2,false,true); ENDW(NT-2);
    S1_ODD(NT-1,false,false);
    PH_B(pB0,pB1,0,(NT-2)&3,false);
  }
  { if constexpr(!ONES){ float sacc=pB0[0]+pB0[1]; _Pragma("unroll") for(int r=2;r<16;++r)sacc+=pB0[r]; _Pragma("unroll") for(int r=0;r<16;++r)sacc+=pB1[r]; l_reg+=sacc; }
    pw0=(u32x4){PKW(pB0,0),PKW(pB0,2),PKW(pB0,4),PKW(pB0,6)};pw1=(u32x4){PKW(pB0,8),PKW(pB0,10),PKW(pB0,12),PKW(pB0,14)};pw2=(u32x4){PKW(pB1,0),PKW(pB1,2),PKW(pB1,4),PKW(pB1,6)};pw3=(u32x4){PKW(pB1,8),PKW(pB1,10),PKW(pB1,12),PKW(pB1,14)};
    SBAR();
    const lds_cptr vp_=vp0+((NT-1)&3)*VSLOT;
    #pragma unroll
    for(int d0=0;d0<ND;++d0){
      #pragma unroll
      for(int ks=0;ks<4;++ks){ const int i=(d0&1)*4+ks; vlo[i]=vtr(vp_+(d0*4096+ks*1024)); vhi[i]=vtr(vp_+(d0*4096+ks*1024+512)); }
      o[d0]=MF(PAF(0),VFR((d0&1)*4+0),o[d0]); o[d0]=MF(PAF(1),VFR((d0&1)*4+1),o[d0]); o[d0]=MF(PAF(2),VFR((d0&1)*4+2),o[d0]); o[d0]=MF(PAF(3),VFR((d0&1)*4+3),o[d0]); }
    if constexpr(ONES){ os=MF(PAF(0),ones,os); os=MF(PAF(1),ones,os); os=MF(PAF(2),ones,os); os=MF(PAF(3),ones,os); } }
  #undef PKW
  #undef PAF
  #undef VFR
  #undef PIN
  #undef MF
  #undef EX
  #undef EXQ
  #undef GAPA
  #undef GAPB
  #undef VRD
  #undef KRD
  #undef PH_A
  #undef PH_B
  #undef DMAS
  #undef ENDW
  #undef S0_ODD
  #undef S0_EVEN
  #undef S1_ODD
  #undef S1_EVEN
  float rli[16];
  if constexpr(ONES){
    #pragma unroll
    for(int r=0;r<16;++r)rli[r]=__builtin_amdgcn_rcpf(os[r]);
  } else {
    {auto rr=__builtin_amdgcn_permlane32_swap(__float_as_uint(l_reg),__float_as_uint(l_reg),false,false);l_reg=__uint_as_float(rr[0])+__uint_as_float(rr[1]);}
    if(hi==0)wsf[32+r32]=l_reg;asm volatile("s_waitcnt lgkmcnt(0)":::"memory");
    #pragma unroll
    for(int r=0;r<16;++r)rli[r]=__builtin_amdgcn_rcpf(wsf[32+crow(r,hi)]);
  }
  bf16*Ow=Ou+(long)(wid*QBLK)*OP;
  { bf16*stg=(bf16*)(shm+L::OST)+wid*2048;
    #pragma unroll
    for(int hf=0;hf<NV;++hf){
      #pragma unroll
      for(int r=0;r<16;++r){const int orow=crow(r,hi);
        #pragma unroll
        for(int d0=0;d0<2;++d0)stg[orow*64+d0*32+r32]=__float2bfloat16(o[2*hf+d0][r]*rli[r]);}
      asm volatile("s_waitcnt lgkmcnt(0)":::"memory");
      #pragma unroll
      for(int i=0;i<4;++i){const int row=i*8+(lane>>3),ch=lane&7; const u32x4 v=*(const u32x4*)(stg+row*64+ch*8); *(u32x4*)(Ow+(long)row*OP+hf*64+ch*8)=v;}
      asm volatile("s_waitcnt lgkmcnt(0)":::"memory");
    } }
  asm volatile("s_waitcnt lgkmcnt(0)\n\ts_barrier":::"memory");
  #undef DMA_K
  #undef DMA_V
  #undef WAITB_KV
  #undef WAITB_V
  #undef WAITB_0
}
template<int DV,bool ONES,int NT,int QP,int KP,int VP,int OP> __device__ __forceinline__ void attn_unit3(const bf16*Qu,const bf16*__restrict__ Kb,const bf16*__restrict__ Vb,bf16*Ou,char*shm){
  if(__builtin_amdgcn_readfirstlane(threadIdx.x>>6)<4) attn_unit3h<0,DV,ONES,NT,QP,KP,VP,OP>(Qu,Kb,Vb,Ou,shm); else attn_unit3h<1,DV,ONES,NT,QP,KP,VP,OP>(Qu,Kb,Vb,Ou,shm);
}

typedef int i32x4_t __attribute__((ext_vector_type(4)));
typedef int i32x8_t __attribute__((ext_vector_type(8)));
typedef __attribute__((address_space(3))) const i32x4_t* lds_i4p;
template<int DV> struct Lds8 { static constexpr int KSLOT=4096, VSLOT=DV*64, K=0, V=NSLOT*KSLOT, WS=V+NSLOT*VSLOT, OST=WS+NW*64*4, BYTES=OST+NW*4096; };
__device__ __forceinline__ void glds16s(const void*sbase,unsigned voff,unsigned lds_dst){unsigned keep;
  asm volatile("s_mov_b32 %0, m0\n\ts_mov_b32 m0, %3\n\ts_nop 0\n\tglobal_load_lds_dwordx4 %1, %2\n\ts_mov_b32 m0, %0":"=&s"(keep):"v"(voff),"s"(sbase),"s"(lds_dst):"memory");}
__device__ __forceinline__ void glds16s2(const void*sb0,unsigned vo0,unsigned ld0,const void*sb1,unsigned vo1,unsigned ld1){unsigned keep;
  asm volatile("s_mov_b32 %0, m0\n\ts_mov_b32 m0, %3\n\ts_nop 0\n\tglobal_load_lds_dwordx4 %1, %2\n\ts_mov_b32 m0, %6\n\ts_nop 0\n\tglobal_load_lds_dwordx4 %4, %5\n\ts_mov_b32 m0, %0"
    :"=&s"(keep):"v"(vo0),"s"(sb0),"s"(ld0),"v"(vo1),"s"(sb1),"s"(ld1):"memory");}
__device__ __forceinline__ unsigned pk4c(float a,float b,float c,float d,unsigned old){ int r=__builtin_amdgcn_cvt_pk_fp8_f32(a,b,(int)old,false); r=__builtin_amdgcn_cvt_pk_fp8_f32(c,d,r,true); return (unsigned)r; }
template<int DV,bool ONES,int NT,int QP,int KP,int OP,int O8,int ABL=0> __device__ __forceinline__ void attn_unit8(const unsigned char*Q8u,const unsigned char*__restrict__ K8b,const unsigned char*__restrict__ VTb,bf16*Ou,char*shm){
  typedef Lds8<DV> L; constexpr int ND=DV/32, NV=DV/64, VSLOT=L::VSLOT, KSLOT=L::KSLOT;
  const int tid=threadIdx.x,lane=tid&63,r32=lane&31,hi=lane>>5; const int wid=__builtin_amdgcn_readfirstlane(tid>>6);
  const unsigned lds0=(unsigned)(uintptr_t)shm;
  const unsigned koff=(unsigned)((32*(wid&1)+r32)*KP+16*(wid>>1));
  const int pv=(DV==64)?32*wid+r32:64*wid+lane;
  const unsigned voff=(unsigned)((pv&(DV-1))*64+16*(pv/DV));
  const unsigned kdst=(unsigned)__builtin_amdgcn_readfirstlane(lds0+L::K+wid*512), vdst=(unsigned)__builtin_amdgcn_readfirstlane(lds0+L::V+wid*(DV==64?512:1024));
  #define RFL(x) ((unsigned)__builtin_amdgcn_readfirstlane((int)(x)))
  #define DMA_K(t,slot) do{ const unsigned kd_=RFL(kdst+(slot)*KSLOT); if(hi==0){ glds16s(K8b+(long)(t)*KVBLK*KP,koff,kd_); } }while(0)
  #define DMA_V(t,slot) do{ const unsigned vd_=RFL(vdst+(slot)*VSLOT); if(DV==128||hi==0){ glds16s(VTb+(long)(t)*VSLOT,voff,vd_); } }while(0)
  #define DMA_KV(tk,ks,tv,vs) do{ if constexpr(DV==64){ const unsigned kd_=RFL(kdst+(ks)*KSLOT), vd_=RFL(vdst+(vs)*VSLOT); if(hi==0){ glds16s2(K8b+(long)(tk)*KVBLK*KP,koff,kd_,VTb+(long)(tv)*VSLOT,voff,vd_); } } else { DMA_K(tk,ks); DMA_V(tv,vs); } }while(0)
  #define WAITB_KV() do{ if constexpr(ABL&4) asm volatile("s_waitcnt lgkmcnt(0)":::"memory"); else asm volatile("s_waitcnt vmcnt(2) lgkmcnt(0)\n\ts_barrier":::"memory"); }while(0)
  #define WAITB_V()  asm volatile("s_waitcnt vmcnt(1) lgkmcnt(0)\n\ts_barrier":::"memory")
  #define WAITB_0()  asm volatile("s_waitcnt vmcnt(0) lgkmcnt(0)\n\ts_barrier":::"memory")
  const lds_cptr shm3=(lds_cptr)shm; const lds_cptr kp0=shm3+L::K+(2*hi)*1024+r32*16; const lds_cptr vp0=shm3+L::V+(2*hi)*(DV*16)+r32*16;
  i32x8_t kf[2], vf[ND], q8, pw8={0,0,0,0,0,0,0,0};
  #define KLD(slot) do{ const lds_cptr kp_=kp0+(slot)*KSLOT; _Pragma("unroll") for(int b_=0;b_<2;++b_){ kf[b_].lo=*(lds_i4p)(kp_+b_*512); kf[b_].hi=*(lds_i4p)(kp_+1024+b_*512); } }while(0)
  #define VLD(slot) do{ const lds_cptr vp_=vp0+(slot)*VSLOT; _Pragma("unroll") for(int d_=0;d_<ND;++d_){ vf[d_].lo=*(lds_i4p)(vp_+d_*512); vf[d_].hi=*(lds_i4p)(vp_+DV*16+d_*512); } }while(0)
  DMA_K(0,0);DMA_V(0,0);DMA_K(1,1);
  { const unsigned char*qp=Q8u+(long)(wid*QBLK+r32)*QP+32*hi; q8.lo=*(const i32x4_t*)qp; q8.hi=*(const i32x4_t*)(qp+16); }
  f32x16 o[ND]; f32x16 os=f32x16{}; float l_reg=0.f; float*wsf=(float*)(shm+L::WS)+wid*64;
  #pragma unroll
  for(int d_=0;d_<ND;++d_)o[d_]=f32x16{};
  i32x8_t ones8={0x38383838,0x38383838,0x38383838,0x38383838,0x38383838,0x38383838,0x38383838,0x38383838};
  if constexpr(DV==64||ONES8_PIN_B){ int one_=0x38383838; asm volatile("":"+s"(one_)); ones8=(i32x8_t){one_,one_,one_,one_,one_,one_,one_,one_}; asm volatile("":"+v"(ones8)); }
  f32x16 c0,c1;
  i32x8_t pwB={0,0,0,0,0,0,0,0};
  int sp=0,sc=0,sn=1;
  #define ROT() do{sp=sc;sc=sn;sn=(sn==NSLOT-1)?0:sn+1;}while(0)
  #define MFZ(D,A_,B_) do{ if constexpr(ABL&2){ asm volatile("":"=v"(D):"v"(A_),"v"(B_)); } else asm volatile("v_mfma_f32_32x32x64_f8f6f4 %0, %1, %2, -4.0":"=&v"(D):"v"(A_),"v"(B_)); }while(0)
  #define MFA(D,A_,B_) do{ if constexpr(ABL&2){ asm volatile("":"+v"(D):"v"(A_),"v"(B_)); } else asm volatile("v_mfma_f32_32x32x64_f8f6f4 %0, %1, %2, %0":"+v"(D):"v"(A_),"v"(B_)); }while(0)
  #define MFAO(D,A_,B_) do{ if constexpr(ABL&2){ asm volatile("":"+v"(D):"v"(A_),"v"(B_)); } else asm volatile("s_nop 1\n\tv_mfma_f32_32x32x64_f8f6f4 %0, %1, %2, %0":"+v"(D):"v"(A_),"v"(B_)); }while(0)
  #define EXR(C,lo_,n_) do{ if constexpr(!(ABL&1)){ _Pragma("unroll") for(int e_=(lo_);e_<(lo_)+(n_);++e_) C[e_]=__builtin_amdgcn_exp2f(C[e_]); } asm volatile("":"+v"(C)); }while(0)
  #define PACK(P,W,base) do{ if constexpr(!(ABL&8)){ _Pragma("unroll") for(int j_=0;j_<4;++j_) W[(base)+j_]=(int)pk4c(P[4*j_],P[4*j_+1],P[4*j_+2],P[4*j_+3],(unsigned)W[(base)+j_]); } asm volatile("":"+v"(W)); \
    if constexpr(!ONES){ float s_=(P[0]+P[1])+(P[2]+P[3]); _Pragma("unroll") for(int j_=1;j_<4;++j_) s_+=(P[4*j_]+P[4*j_+1])+(P[4*j_+2]+P[4*j_+3]); l_reg+=s_; asm volatile("":"+v"(l_reg)); } }while(0)
  DMA_K(2,2);
  asm volatile("s_waitcnt vmcnt(3) lgkmcnt(0)\n\ts_barrier":::"memory");
  KLD(0);
  MFZ(c0,kf[0],q8); MFZ(c1,kf[1],q8);
  asm volatile("s_nop 15\n\ts_nop 15":"+v"(c0),"+v"(c1));
  EXR(c0,0,16); EXR(c1,0,16); PACK(c0,pw8,0); PACK(c1,pw8,4);
  WAITB_0();
  DMA_K(3,0);DMA_V(1,1);
  ROT();
  KLD(sc);
  WAITB_KV();
  #define STEP9(WP,WN,t,GK,GV,GL) do{ SBAR(); \
    VLD(sp); SBAR(); \
    MFZ(c0,kf[0],q8); SBAR(); \
    if((GK)&&(GV)){ DMA_KV((t)+3,sc,(t)+1,sn); } else { if(GK){DMA_K((t)+3,sc);} if(GV){DMA_V((t)+1,sn);} } SBAR(); \
    MFZ(c1,kf[1],q8); SBAR(); \
    if(GL){KLD(sn);} SBAR(); \
    MFA(o[0],WP,vf[0]); SBAR(); \
    if constexpr(ND==2){ \
      EXR(c0,0,16); PACK(c0,WN,0); SBAR(); \
      MFA(o[1],WP,vf[1]); SBAR(); EXR(c1,0,8); SBAR(); \
      if constexpr(ONES){ MFAO(os,WP,ones8); SBAR(); } EXR(c1,8,8); PACK(c1,WN,4); SBAR(); \
    } else { \
      EXR(c0,0,10); SBAR(); \
      MFA(o[1],WP,vf[1]); SBAR(); EXR(c0,10,6); PACK(c0,WN,0); SBAR(); \
      MFA(o[ND-2],WP,vf[ND-2]); SBAR(); EXR(c1,0,8); SBAR(); \
      MFA(o[ND-1],WP,vf[ND-1]); SBAR(); EXR(c1,8,4); SBAR(); \
      if constexpr(ONES){ MFAO(os,WP,ones8); SBAR(); } EXR(c1,12,4); PACK(c1,WN,4); SBAR(); \
    } }while(0)
  if(ATT_PRIO && wid>=4) __builtin_amdgcn_s_setprio(1);
  int t=1;
  for(;t+5<NT;t+=2){
    STEP9(pw8,pwB,t,true,true,true);     WAITB_KV(); ROT();
    STEP9(pwB,pw8,t+1,true,true,true);   WAITB_KV(); ROT();
  }
  #define ENDW(tt) do{ if((tt)+3<NT){WAITB_KV();} else if((tt)+2<NT){WAITB_V();} else {WAITB_0();} }while(0)
  for(;t+1<NT;t+=2){
    STEP9(pw8,pwB,t,(t+3<NT),(t+1<NT),(t+1<NT));       ENDW(t);   ROT();
    STEP9(pwB,pw8,t+1,(t+4<NT),(t+2<NT),(t+2<NT));     ENDW(t+1); ROT();
  }
  STEP9(pw8,pwB,NT-1,false,false,false);
  if(ATT_PRIO && wid>=4) __builtin_amdgcn_s_setprio(0);
  { VLD(sc); SBAR();
    #pragma unroll
    for(int d_=0;d_<ND;++d_) MFA(o[d_],pwB,vf[d_]);
    if constexpr(ONES){ MFAO(os,pwB,ones8); asm volatile("s_nop 15\n\ts_nop 15":"+v"(os)); }
    else { asm volatile("s_nop 15\n\ts_nop 15":"+v"(o[ND-1])); } }
  #undef STEP9
  #undef ENDW
  #undef MFZ
  #undef MFA
  #undef MFAO
  #undef EXR
  #undef PACK
  #undef KLD
  #undef VLD
  float rli[16];
  if constexpr(ONES){
    #pragma unroll
    for(int r=0;r<16;++r)rli[r]=__builtin_amdgcn_rcpf(os[r]);
  } else {
    {auto rr=__builtin_amdgcn_permlane32_swap(__float_as_uint(l_reg),__float_as_uint(l_reg),false,false);l_reg=__uint_as_float(rr[0])+__uint_as_float(rr[1]);}
    if(hi==0)wsf[32+r32]=l_reg;asm volatile("s_waitcnt lgkmcnt(0)":::"memory");
    #pragma unroll
    for(int r=0;r<16;++r)rli[r]=__builtin_amdgcn_rcpf(wsf[32+crow(r,hi)]);
  }
  if constexpr(O8!=0){ unsigned char*Ow8=(unsigned char*)Ou+(long)(wid*QBLK)*OP; unsigned char*stg8=(unsigned char*)(shm+L::OST)+wid*4096;
    #pragma unroll
    for(int hf=0;hf<NV;++hf){
      #pragma unroll
      for(int r=0;r<16;++r){const int orow=crow(r,hi);
        #pragma unroll
        for(int d0=0;d0<2;++d0){ const float v=__builtin_amdgcn_fmed3f(o[2*hf+d0][r]*rli[r]*YA8_SCALE,-448.0f,448.0f); stg8[orow*64+d0*32+r32]=(unsigned char)__builtin_amdgcn_cvt_pk_fp8_f32(v,v,0,false); } }
      asm volatile("s_waitcnt lgkmcnt(0)":::"memory");
      #pragma unroll
      for(int i=0;i<2;++i){const int row=i*16+(lane>>2),ch=lane&3; const u32x4 v=*(const u32x4*)(stg8+row*64+ch*16); *(u32x4*)(Ow8+(long)row*OP+hf*64+ch*16)=v;}
      asm volatile("s_waitcnt lgkmcnt(0)":::"memory");
    } } else {
  bf16*Ow=Ou+(long)(wid*QBLK)*OP;
  { bf16*stg=(bf16*)(shm+L::OST)+wid*2048;
    #pragma unroll
    for(int hf=0;hf<NV;++hf){
      #pragma unroll
      for(int r=0;r<16;++r){const int orow=crow(r,hi);
        #pragma unroll
        for(int d0=0;d0<2;++d0)stg[orow*64+d0*32+r32]=__float2bfloat16(o[2*hf+d0][r]*rli[r]);}
      asm volatile("s_waitcnt lgkmcnt(0)":::"memory");
      #pragma unroll
      for(int i=0;i<4;++i){const int row=i*8+(lane>>3),ch=lane&7; const u32x4 v=*(const u32x4*)(stg+row*64+ch*8); *(u32x4*)(Ow+(long)row*OP+hf*64+ch*8)=v;}
      asm volatile("s_waitcnt lgkmcnt(0)":::"memory");
    } } }
  asm volatile("s_waitcnt lgkmcnt(0)\n\ts_barrier":::"memory");
  #undef DMA_K
  #undef DMA_KV
  #undef RFL
  #undef DMA_V
  #undef WAITB_KV
  #undef WAITB_V
  #undef WAITB_0
  #undef ROT
}

struct Lds8w { static constexpr int KSLOT=8192, VSLOT=8192, K=0, V=NSLOT*KSLOT, WS=V+NSLOT*VSLOT, OST=WS+NW*64*4, BYTES=OST+NW*4096; };
template<int NT,int QP,int KP,int OP,int O8> __device__ __forceinline__ void attn_unit8w(const unsigned char*Q8u,const unsigned char*__restrict__ K8b,const unsigned char*__restrict__ VTb,bf16*Ou,char*shm){
  typedef Lds8w L; constexpr int ND=2, NV=1, VSLOT=L::VSLOT, KSLOT=L::KSLOT, NS=NT/2;
  static_assert((NT&3)==0 && NS>8,"attn_unit8w");
  const int tid=threadIdx.x,lane=tid&63,r32=lane&31,hi=lane>>5; const int wid=__builtin_amdgcn_readfirstlane(tid>>6);
  const unsigned lds0=(unsigned)(uintptr_t)shm;
  const unsigned koff=(unsigned)((64*(wid&1)+lane)*KP+16*(wid>>1));
  const unsigned voff=(unsigned)((wid>>2)*4096+lane*64+16*(wid&3));
  const unsigned kdst=(unsigned)__builtin_amdgcn_readfirstlane(lds0+L::K+wid*1024), vdst=(unsigned)__builtin_amdgcn_readfirstlane(lds0+L::V+wid*1024);
  #define RFL(x) ((unsigned)__builtin_amdgcn_readfirstlane((int)(x)))
  #define DMA_K(t,slot) do{ glds16s(K8b+(long)(t)*128*KP,koff,RFL(kdst+(slot)*KSLOT)); }while(0)
  #define DMA_V(t,slot) do{ glds16s(VTb+(long)(t)*VSLOT,voff,RFL(vdst+(slot)*VSLOT)); }while(0)
  #define DMA_KV(tk,ks,tv,vs) do{ glds16s2(K8b+(long)(tk)*128*KP,koff,RFL(kdst+(ks)*KSLOT),VTb+(long)(tv)*VSLOT,voff,RFL(vdst+(vs)*VSLOT)); }while(0)
  #define WAITB_KV() asm volatile("s_waitcnt vmcnt(2) lgkmcnt(0)\n\ts_barrier":::"memory")
  #define WAITB_V()  asm volatile("s_waitcnt vmcnt(1) lgkmcnt(0)\n\ts_barrier":::"memory")
  #define WAITB_0()  asm volatile("s_waitcnt vmcnt(0) lgkmcnt(0)\n\ts_barrier":::"memory")
  const lds_cptr shm3=(lds_cptr)shm; const lds_cptr kp0=shm3+L::K+(2*hi)*2048+r32*16; const lds_cptr vp0=shm3+L::V+(2*hi)*1024+r32*16;
  i32x8_t kf[4], vf[2][2], q8, wA[2]={{0,0,0,0,0,0,0,0},{0,0,0,0,0,0,0,0}}, wB[2]={{0,0,0,0,0,0,0,0},{0,0,0,0,0,0,0,0}};
  #define KLD(slot) do{ const lds_cptr kp_=kp0+(slot)*KSLOT; _Pragma("unroll") for(int b_=0;b_<4;++b_){ kf[b_].lo=*(lds_i4p)(kp_+b_*512); kf[b_].hi=*(lds_i4p)(kp_+2048+b_*512); } }while(0)
  #define VLD(slot) do{ const lds_cptr vp_=vp0+(slot)*VSLOT; _Pragma("unroll") for(int h_=0;h_<2;++h_) _Pragma("unroll") for(int d_=0;d_<2;++d_){ vf[h_][d_].lo=*(lds_i4p)(vp_+h_*4096+d_*512); vf[h_][d_].hi=*(lds_i4p)(vp_+h_*4096+1024+d_*512); } }while(0)
  DMA_K(0,0);DMA_V(0,0);DMA_K(1,1);
  { const unsigned char*qp=Q8u+(long)(wid*QBLK+r32)*QP+32*hi; q8.lo=*(const i32x4_t*)qp; q8.hi=*(const i32x4_t*)(qp+16); }
  f32x16 o[ND]; f32x16 os=f32x16{};
  #pragma unroll
  for(int d_=0;d_<ND;++d_)o[d_]=f32x16{};
  i32x8_t ones8; { int one_=0x38383838; asm volatile("":"+s"(one_)); ones8=(i32x8_t){one_,one_,one_,one_,one_,one_,one_,one_}; asm volatile("":"+v"(ones8)); }
  f32x16 c0,c1,c2,c3;
  int sp=0,sc=0,sn=1;
  #define ROT() do{sp=sc;sc=sn;sn=(sn==NSLOT-1)?0:sn+1;}while(0)
  #define MFZ(D,A_,B_) asm volatile("v_mfma_f32_32x32x64_f8f6f4 %0, %1, %2, -4.0":"=&v"(D):"v"(A_),"v"(B_))
  #define MFA(D,A_,B_) asm volatile("v_mfma_f32_32x32x64_f8f6f4 %0, %1, %2, %0":"+v"(D):"v"(A_),"v"(B_))
  #define EXR(C,lo_,n_) do{ _Pragma("unroll") for(int e_=(lo_);e_<(lo_)+(n_);++e_) C[e_]=__builtin_amdgcn_exp2f(C[e_]); asm volatile("":"+v"(C)); }while(0)
  #define PACK(P,W,base) do{ _Pragma("unroll") for(int j_=0;j_<4;++j_) W[(base)+j_]=(int)pk4c(P[4*j_],P[4*j_+1],P[4*j_+2],P[4*j_+3],(unsigned)W[(base)+j_]); asm volatile("":"+v"(W)); }while(0)
  DMA_K(2,2);
  asm volatile("s_waitcnt vmcnt(3) lgkmcnt(0)\n\ts_barrier":::"memory");
  KLD(0);
  MFZ(c0,kf[0],q8); MFZ(c1,kf[1],q8); MFZ(c2,kf[2],q8); MFZ(c3,kf[3],q8);
  asm volatile("s_nop 15\n\ts_nop 15":"+v"(c0),"+v"(c1),"+v"(c2),"+v"(c3));
  EXR(c0,0,16); PACK(c0,wA[0],0); EXR(c1,0,16); PACK(c1,wA[0],4); EXR(c2,0,16); PACK(c2,wA[1],0); EXR(c3,0,16); PACK(c3,wA[1],4);
  WAITB_0();
  DMA_K(3,0);DMA_V(1,1);
  ROT();
  KLD(sc);
  WAITB_KV();
  #define STEP9W(WP,WN,t,GK,GV,GL) do{ SBAR(); \
    VLD(sp); SBAR(); \
    MFZ(c0,kf[0],q8); SBAR(); \
    if((GK)&&(GV)){ DMA_KV((t)+3,sc,(t)+1,sn); } else { if(GK){DMA_K((t)+3,sc);} if(GV){DMA_V((t)+1,sn);} } SBAR(); \
    MFZ(c1,kf[1],q8); MFZ(c2,kf[2],q8); MFZ(c3,kf[3],q8); SBAR(); \
    if(GL){KLD(sn);} SBAR(); \
    MFA(o[0],WP[0],vf[0][0]); SBAR(); EXR(c0,0,16); PACK(c0,WN[0],0); SBAR(); \
    MFA(o[1],WP[0],vf[0][1]); SBAR(); EXR(c1,0,8); SBAR(); \
    asm volatile("s_nop 1":::); MFA(os,WP[0],ones8); SBAR(); EXR(c1,8,8); PACK(c1,WN[0],4); SBAR(); \
    MFA(o[0],WP[1],vf[1][0]); SBAR(); EXR(c2,0,16); PACK(c2,WN[1],0); SBAR(); \
    MFA(o[1],WP[1],vf[1][1]); SBAR(); EXR(c3,0,8); SBAR(); \
    asm volatile("s_nop 1":::); MFA(os,WP[1],ones8); SBAR(); EXR(c3,8,8); PACK(c3,WN[1],4); SBAR(); \
    }while(0)
  if(ATT_PRIO && wid>=4) __builtin_amdgcn_s_setprio(1);
  int t=1;
  for(;t+5<NS;t+=2){
    STEP9W(wA,wB,t,true,true,true);     WAITB_KV(); ROT();
    STEP9W(wB,wA,t+1,true,true,true);   WAITB_KV(); ROT();
  }
  #define ENDW(tt) do{ if((tt)+3<NS){WAITB_KV();} else if((tt)+2<NS){WAITB_V();} else {WAITB_0();} }while(0)
  for(;t+1<NS;t+=2){
    STEP9W(wA,wB,t,(t+3<NS),(t+1<NS),(t+1<NS));       ENDW(t);   ROT();
    STEP9W(wB,wA,t+1,(t+4<NS),(t+2<NS),(t+2<NS));     ENDW(t+1); ROT();
  }
  STEP9W(wA,wB,NS-1,false,false,false);
  if(ATT_PRIO && wid>=4) __builtin_amdgcn_s_setprio(0);
  { VLD(sc); SBAR();
    MFA(o[0],wB[0],vf[0][0]); MFA(o[1],wB[0],vf[0][1]); MFA(o[0],wB[1],vf[1][0]); MFA(o[1],wB[1],vf[1][1]);
    asm volatile("s_nop 1":::); MFA(os,wB[0],ones8); MFA(os,wB[1],ones8); asm volatile("s_nop 15\n\ts_nop 15":"+v"(os)); }
  #undef STEP9W
  #undef ENDW
  #undef MFZ
  #undef MFA
  #undef EXR
  #undef PACK
  #undef KLD
  #undef VLD
  #undef RFL
  float rli[16];
  #pragma unroll
  for(int r=0;r<16;++r)rli[r]=__builtin_amdgcn_rcpf(os[r]);
  if constexpr(O8!=0){ unsigned char*Ow8=(unsigned char*)Ou+(long)(wid*QBLK)*OP; unsigned char*stg8=(unsigned char*)(shm+L::OST)+wid*4096;
      int hi_e=hi; asm volatile("":"+v"(hi_e));
      #pragma unroll
      for(int r=0;r<16;++r){const int orow=crow(r,hi_e);
        #pragma unroll
        for(int d0=0;d0<2;++d0){ const float v=__builtin_amdgcn_fmed3f(o[d0][r]*rli[r]*YA8_SCALE,-448.0f,448.0f); stg8[orow*64+d0*32+r32]=(unsigned char)__builtin_amdgcn_cvt_pk_fp8_f32(v,v,0,false); } }
      asm volatile("s_waitcnt lgkmcnt(0)":::"memory");
      #pragma unroll
      for(int i=0;i<2;++i){const int row=i*16+(lane>>2),ch=lane&3; const u32x4 v=*(const u32x4*)(stg8+row*64+ch*16); *(u32x4*)(Ow8+(long)row*OP+ch*16)=v;}
      asm volatile("s_waitcnt lgkmcnt(0)":::"memory");
  } else {
  bf16*Ow=Ou+(long)(wid*QBLK)*OP;
  { bf16*stg=(bf16*)(shm+L::OST)+wid*2048;
      #pragma unroll
      for(int r=0;r<16;++r){const int orow=crow(r,hi);
        #pragma unroll
        for(int d0=0;d0<2;++d0)stg[orow*64+d0*32+r32]=__float2bfloat16(o[d0][r]*rli[r]);}
      asm volatile("s_waitcnt lgkmcnt(0)":::"memory");
      #pragma unroll
      for(int i=0;i<4;++i){const int row=i*8+(lane>>3),ch=lane&7; const u32x4 v=*(const u32x4*)(stg+row*64+ch*8); *(u32x4*)(Ow+(long)row*OP+ch*8)=v;}
      asm volatile("s_waitcnt lgkmcnt(0)":::"memory");
  } }
  asm volatile("s_waitcnt lgkmcnt(0)\n\ts_barrier":::"memory");
  #undef DMA_K
  #undef DMA_V
  #undef DMA_KV
  #undef WAITB_KV
  #undef WAITB_V
  #undef WAITB_0
  #undef ROT
}
constexpr int ATTN_LDS_BYTES=LDS_BYTES;
#undef SBAR
#undef WAIT_BAR
}
constexpr int NWAVES = 8;
constexpr int RING_OFF = 0, RING_BYTES = 135168;
constexpr int LDSCTL_OFF = RING_BYTES, MISC_OFF = LDSCTL_OFF + 320;
constexpr int TB_OFF = LDSCTL_OFF + 512;
constexpr int LDS_BYTES = 151552;
constexpr int CW_BAR = 4096;
constexpr int N_PHASES = 11;
static_assert(attn_body::Lds8<128>::BYTES <= RING_BYTES && attn_body::Lds8<64>::BYTES <= RING_BYTES, "attention LDS");
static_assert(RING_OFF == 0 && LDSCTL_OFF + 6144 == pg8::PF_OFF && TB_OFF + 4 * (128 + 4 * 320) <= LDSCTL_OFF + 6144 && pg8::PF_OFF + 3072 <= LDS_BYTES, "LDS map");
#ifndef ABL_PROBE
#define ABL_PROBE 0
#endif
#ifndef ATT8_ONES_B
#define ATT8_ONES_B true
#endif
#ifndef ATT8_WIDE_A
#define ATT8_WIDE_A 1
#endif
#if ATT8_WIDE_A
#define ATT8_UNIT_A attn_unit8w<SK / 64, 512, 128, 1024, MERGE_FP8>
#else
#define ATT8_UNIT_A attn_unit8<64, true, SK / 64, 512, 128, 1024, MERGE_FP8>
#endif
#ifndef ATT_XCD_ROWS
#define ATT_XCD_ROWS 1
#endif
#ifndef W8_TALL
#define W8_TALL 1
#endif
#ifndef X_TOUCH
#define X_TOUCH 1
#endif
#ifndef COMBINE_PRELOAD
#define COMBINE_PRELOAD 1
#endif
#ifndef NORM1_PRELOAD
#define NORM1_PRELOAD 1
#endif
#ifndef EARLY_CONV
#define EARLY_CONV 1
#endif
#ifndef MOE_SPLIT_BAR
#define MOE_SPLIT_BAR 1
#endif
#ifndef TOPO_SYNC
#define TOPO_SYNC 1
#endif
constexpr int CW_TOPO = 3072;
#ifndef CENSUS_PAR
#define CENSUS_PAR 1
#endif
#ifndef FUSE_DIFFOUT
#define FUSE_DIFFOUT 1
#endif
#ifndef WSTAGGER
#define WSTAGGER 1
#endif
#ifndef ATT_UNIT_A
#define ATT_UNIT_A attn_unit2
#endif
#ifndef ATT_UNIT_B
#define ATT_UNIT_B attn_unit2
#endif
#ifndef ATT_ONES_A
#define ATT_ONES_A true
#endif
#ifndef ATT_ONES_B
#define ATT_ONES_B false
#endif

typedef GAS unsigned gu32;
#define XB_TMO      128
#define XB_XCNT(j)  (256  + 64 * (j))
#define XB_XSUB(j)  (1280 + 64 * (j))
#define XB_XGEN(j)  (2304 + 64 * (j))
#define XB_TOP      3328
#define XB_TOPGEN   3392
#define XCD_BAR_WORDS 3456
#define XB_SPIN_CAP (1u << 18)

__device__ __forceinline__ unsigned xb_ld(unsigned* p)              { return __hip_atomic_load(p, __ATOMIC_RELAXED, __HIP_MEMORY_SCOPE_AGENT); }
__device__ __forceinline__ unsigned xb_add(unsigned* p, unsigned v) { return __hip_atomic_fetch_add(p, v, __ATOMIC_RELAXED, __HIP_MEMORY_SCOPE_AGENT); }
__device__ __forceinline__ unsigned xb_xcc_id() { return (unsigned)__builtin_amdgcn_s_getreg((3 << 11) | 20) & 0xFu; }
#define XB_SPIN(cond, bar) do { unsigned _sp = 0; while (cond) { __builtin_amdgcn_s_sleep(1); \
    if ((++_sp & 255u) == 0u) { if (xb_ld(&(bar)[XB_TMO])) break; if (_sp > XB_SPIN_CAP) { atomicAdd(&(bar)[XB_TMO], 1u); break; } } } } while (0)

struct XcdBarrier {
    unsigned* bar; unsigned x;
    volatile LAS unsigned* st;
};

__device__ __forceinline__ XcdBarrier xcd_barrier_post(unsigned* bar, volatile LAS unsigned* st) {
    XcdBarrier b; b.bar = bar; b.x = xb_xcc_id(); b.st = st;
    if (threadIdx.x == 0) (void)xb_add(&bar[XB_XCNT(b.x)], 1u);
    return b;
}
__device__ __forceinline__ void xcd_barrier_complete(unsigned* bar, unsigned x, unsigned& nloc, unsigned& nx) {
    const unsigned G = gridDim.x * gridDim.y * gridDim.z;
    unsigned sum, cnt, mine, sp = 0u;
    for (;;) {
        sum = 0u; cnt = 0u; mine = 0u;
#pragma unroll
        for (unsigned j = 0; j < 16; ++j) { const unsigned c = xb_ld(&bar[XB_XCNT(j)]); sum += c; cnt += (c > 0u) ? 1u : 0u; mine = (j == x) ? c : mine; }
        if (sum == G) break;
        __builtin_amdgcn_s_sleep(1);
        if ((++sp & 255u) == 0u) { if (xb_ld(&bar[XB_TMO])) break; if (sp > XB_SPIN_CAP) { atomicAdd(&bar[XB_TMO], 1u); break; } }
    }
    nloc = mine > 0u ? mine : 1u; nx = cnt > 0u ? cnt : 1u;
}

__device__ __forceinline__ void xcd_barrier(const XcdBarrier& b) {
    asm volatile("s_waitcnt vmcnt(0)" ::: "memory");
    __syncthreads();
    if (threadIdx.x == 0) {
        unsigned* bar = b.bar;
        __builtin_amdgcn_s_waitcnt(0);
        unsigned nloc = b.st[0], nx = b.st[1];
        if (nloc == 0u) { xcd_barrier_complete(bar, b.x, nloc, nx); b.st[0] = nloc; b.st[1] = nx; }
        const unsigned old = xb_add(&bar[XB_XSUB(b.x)], 1u);
        const unsigned gen = old / nloc;
        if (old + 1u == (gen + 1u) * nloc) {
            __builtin_amdgcn_fence(__ATOMIC_RELEASE, "agent");
            asm volatile("s_waitcnt vmcnt(0)" ::: "memory");
            const unsigned og = xb_add(&bar[XB_TOP], 1u);
            const unsigned tg = og / nx;
            if (og + 1u == (tg + 1u) * nx) xb_add(&bar[XB_TOPGEN], 1u);
            else XB_SPIN(xb_ld(&bar[XB_TOPGEN]) == tg, bar);
            __builtin_amdgcn_fence(__ATOMIC_ACQUIRE, "agent");
            xb_add(&bar[XB_XGEN(b.x)], 1u);
            asm volatile("s_waitcnt vmcnt(0)" ::: "memory");
        } else {
            XB_SPIN(xb_ld(&bar[XB_XGEN(b.x)]) == gen, bar);
            __builtin_amdgcn_fence(__ATOMIC_ACQUIRE, "agent");
            asm volatile("s_waitcnt vmcnt(0)" ::: "memory");
        }
    }
    __syncthreads();
}

__device__ __forceinline__ void xcd_barrier_arrive(const XcdBarrier& b, volatile LAS unsigned* tk) {
    asm volatile("s_waitcnt vmcnt(0)" ::: "memory");
    __syncthreads();
    if (threadIdx.x == 0) {
        unsigned* bar = b.bar;
        __builtin_amdgcn_s_waitcnt(0);
        unsigned nloc = b.st[0], nx = b.st[1];
        if (nloc == 0u) { xcd_barrier_complete(bar, b.x, nloc, nx); b.st[0] = nloc; b.st[1] = nx; }
        const unsigned old = xb_add(&bar[XB_XSUB(b.x)], 1u);
        const unsigned gen = old / nloc;
        if (old + 1u == (gen + 1u) * nloc) {
            __builtin_amdgcn_fence(__ATOMIC_RELEASE, "agent");
            asm volatile("s_waitcnt vmcnt(0)" ::: "memory");
            const unsigned og = xb_add(&bar[XB_TOP], 1u);
            const unsigned tg = og / nx;
            if (og + 1u == (tg + 1u) * nx) xb_add(&bar[XB_TOPGEN], 1u);
            else XB_SPIN(xb_ld(&bar[XB_TOPGEN]) == tg, bar);
            __builtin_amdgcn_fence(__ATOMIC_ACQUIRE, "agent");
            xb_add(&bar[XB_XGEN(b.x)], 1u);
            asm volatile("s_waitcnt vmcnt(0)" ::: "memory");
            tk[0] = 1u; tk[1] = gen;
        } else { tk[0] = 0u; tk[1] = gen; }
    }
    __syncthreads();
}
__device__ __forceinline__ void xcd_barrier_wait(const XcdBarrier& b, volatile LAS unsigned* tk) {
    asm volatile("s_waitcnt vmcnt(0)" ::: "memory");
    __syncthreads();
    if (threadIdx.x == 0) {
        if (tk[0] == 0u) { const unsigned gen = tk[1]; XB_SPIN(xb_ld(&b.bar[XB_XGEN(b.x)]) == gen, b.bar); }
        __builtin_amdgcn_fence(__ATOMIC_ACQUIRE, "agent");
        asm volatile("s_waitcnt vmcnt(0)" ::: "memory");
    }
    __syncthreads();
}


struct TItem { const float* src; bf16* dst; int K, N, k0, n0, kind; };
__device__ __forceinline__ int titem_drow(int kind, int c) {
    return kind == 0 ? c : kind == 1 ? (c & ~255) + 128 * ((c >> 5) & 1) + 32 * ((c >> 6) & 3) + (c & 31) : kind == 2 ? 256 * (c >> 7) + (c & 127) : 256 * (c >> 7) + 128 + (c & 127);
}
__device__ __forceinline__ void titem_load(const TItem& t, int lane, f32x4 (&va)[8], f32x4 (&vb)[8]) {
    const float* src = t.src + (size_t)(t.k0 + 2 * (lane >> 4)) * t.N + t.n0 + 4 * (lane & 15);
#pragma unroll
    for (int i = 0; i < 8; ++i) { va[i] = __builtin_nontemporal_load((const f32x4*)(src + (size_t)(8 * i) * t.N)); vb[i] = __builtin_nontemporal_load((const f32x4*)(src + (size_t)(8 * i + 1) * t.N)); }
}
__device__ __forceinline__ void titem_finish(const TItem& t, int lane, LAS unsigned* scr, const f32x4 (&va)[8], const f32x4 (&vb)[8]) {
    const int kp = lane >> 4, n4 = lane & 15;
#pragma unroll
    for (int i = 0; i < 8; ++i) { pg8::u32x4 w; w.x = pg8::cvt_pk_bf16(va[i].x, vb[i].x); w.y = pg8::cvt_pk_bf16(va[i].y, vb[i].y); w.z = pg8::cvt_pk_bf16(va[i].z, vb[i].z); w.w = pg8::cvt_pk_bf16(va[i].w, vb[i].w);
        *(LAS pg8::u32x4*)(scr + (4 * i + kp) * 68 + 4 * n4) = w; }
    asm volatile("s_waitcnt lgkmcnt(0)" ::: "memory");
    const int c = lane & 7;
#pragma unroll
    for (int j = 0; j < 8; ++j) { const int n = (lane >> 3) + 8 * j; const LAS unsigned* s = scr + (4 * c) * 68 + n;
        pg8::u32x4 o; o.x = s[0]; o.y = s[68]; o.z = s[136]; o.w = s[204];
        __builtin_nontemporal_store(o, (pg8::u32x4*)(t.dst + (size_t)titem_drow(t.kind, t.n0 + n) * t.K + t.k0 + 8 * c)); }
    asm volatile("s_waitcnt lgkmcnt(0)" ::: "memory");
}
__device__ __forceinline__ void titem8_load(const TItem& t, int lane, f32x4 (&v)[16]) {
    const float* src = t.src + (size_t)(t.k0 + 4 * (lane >> 4)) * t.N + t.n0 + 4 * (lane & 15);
#pragma unroll
    for (int i = 0; i < 4; ++i)
#pragma unroll
        for (int j = 0; j < 4; ++j) v[4 * i + j] = __builtin_nontemporal_load((const f32x4*)(src + (size_t)(16 * i + j) * t.N));
}
__device__ __forceinline__ void titem8_finish(const TItem& t, int lane, LAS unsigned* scr, const f32x4 (&v)[16]) {
    const int kq = lane >> 4, n4 = lane & 15;
#pragma unroll
    for (int i = 0; i < 4; ++i) { pg8::u32x4 w;
        w.x = pk4_fp8(v[4 * i][0] * W8_SCALE, v[4 * i + 1][0] * W8_SCALE, v[4 * i + 2][0] * W8_SCALE, v[4 * i + 3][0] * W8_SCALE);
        w.y = pk4_fp8(v[4 * i][1] * W8_SCALE, v[4 * i + 1][1] * W8_SCALE, v[4 * i + 2][1] * W8_SCALE, v[4 * i + 3][1] * W8_SCALE);
        w.z = pk4_fp8(v[4 * i][2] * W8_SCALE, v[4 * i + 1][2] * W8_SCALE, v[4 * i + 2][2] * W8_SCALE, v[4 * i + 3][2] * W8_SCALE);
        w.w = pk4_fp8(v[4 * i][3] * W8_SCALE, v[4 * i + 1][3] * W8_SCALE, v[4 * i + 2][3] * W8_SCALE, v[4 * i + 3][3] * W8_SCALE);
        *(LAS pg8::u32x4*)(scr + (4 * i + kq) * 68 + 4 * n4) = w; }
    asm volatile("s_waitcnt lgkmcnt(0)" ::: "memory");
    const int c = lane & 3;
#pragma unroll
    for (int j = 0; j < 4; ++j) { const int n = (lane >> 2) + 16 * j; const LAS unsigned* s = scr + (4 * c) * 68 + n;
        pg8::u32x4 o; o.x = s[0]; o.y = s[68]; o.z = s[136]; o.w = s[204];
        __builtin_nontemporal_store(o, (pg8::u32x4*)((unsigned char*)t.dst + (size_t)titem_drow(t.kind, t.n0 + n) * t.K + t.k0 + 16 * c)); }
    asm volatile("s_waitcnt lgkmcnt(0)" ::: "memory");
}
__device__ __forceinline__ void titem8t_load(const TItem& t, int lane, f32x4 (&v)[16]) {
    const float* src = t.src + (size_t)(t.k0 + 4 * (lane >> 3)) * t.N + t.n0 + 4 * (lane & 7);
#pragma unroll
    for (int i = 0; i < 4; ++i)
#pragma unroll
        for (int j = 0; j < 4; ++j) v[4 * i + j] = __builtin_nontemporal_load((const f32x4*)(src + (size_t)(32 * i + j) * t.N));
}
__device__ __forceinline__ void titem8t_finish(const TItem& t, int lane, LAS unsigned* scr, const f32x4 (&v)[16]) {
    const int kq = lane >> 3, n4 = lane & 7;
#pragma unroll
    for (int i = 0; i < 4; ++i) { pg8::u32x4 w;
        w.x = pk4_fp8(v[4 * i][0] * W8_SCALE, v[4 * i + 1][0] * W8_SCALE, v[4 * i + 2][0] * W8_SCALE, v[4 * i + 3][0] * W8_SCALE);
        w.y = pk4_fp8(v[4 * i][1] * W8_SCALE, v[4 * i + 1][1] * W8_SCALE, v[4 * i + 2][1] * W8_SCALE, v[4 * i + 3][1] * W8_SCALE);
        w.z = pk4_fp8(v[4 * i][2] * W8_SCALE, v[4 * i + 1][2] * W8_SCALE, v[4 * i + 2][2] * W8_SCALE, v[4 * i + 3][2] * W8_SCALE);
        w.w = pk4_fp8(v[4 * i][3] * W8_SCALE, v[4 * i + 1][3] * W8_SCALE, v[4 * i + 2][3] * W8_SCALE, v[4 * i + 3][3] * W8_SCALE);
        *(LAS pg8::u32x4*)(scr + (8 * i + kq) * 36 + 4 * n4) = w; }
    asm volatile("s_waitcnt lgkmcnt(0)" ::: "memory");
    const int c = lane & 7;
#pragma unroll
    for (int j = 0; j < 4; ++j) { const int n = (lane >> 3) + 8 * j; const LAS unsigned* s = scr + (4 * c) * 36 + n;
        pg8::u32x4 o; o.x = s[0]; o.y = s[36]; o.z = s[72]; o.w = s[108];
        __builtin_nontemporal_store(o, (pg8::u32x4*)((unsigned char*)t.dst + (size_t)titem_drow(t.kind, t.n0 + n) * t.K + t.k0 + 16 * c)); }
    asm volatile("s_waitcnt lgkmcnt(0)" ::: "memory");
}
constexpr int I_INA = 16 * (INPROJ_FP8_ALL ? 0 : INPROJ_GATE_FP8 ? 36 : 68), I_ING = 16 * (INPROJ_FP8_ALL ? 68 : INPROJ_GATE_FP8 ? 32 : 0), I_OA = 8 * 16, I_OUT = 16 * 16, I_EX = 16 * 16;
constexpr int I_B16 = I_INA + (MERGE_FP8 ? 0 : 2 * I_OA + I_OUT), I_SMALL = I_INA + 2 * I_OA + I_OUT + I_ING, NIT = I_SMALL + NE * 3 * I_EX;
constexpr size_t WS_WOB8 = WS_WOA + (size_t)1024 * 512;
constexpr size_t WS_WIN8 = WS_WIN + (size_t)2304 * 2048;
__device__ __forceinline__ TItem weight_titem(const P& p, int it) {
    TItem t; int r = it; int item;
    if (r < I_INA) { t.src = p.w_in; t.dst = (bf16*)(p.ws + WS_WIN); t.K = D; t.N = INC; t.kind = 1; const int nb = I_INA / 16; t.k0 = 64 * (r / nb); t.n0 = 64 * (r % nb); return t; }
    else if ((r -= I_INA) < I_OA) { t.src = p.w_oa; t.dst = (bf16*)(p.ws + WS_WOA); t.K = 512; t.N = D; t.kind = 0; item = r; }
    else if ((r -= I_OA) < I_OA) { t.src = p.w_ob; t.dst = (bf16*)(p.ws + (MERGE_FP8 ? WS_WOB8 : WS_WOB)); t.K = 512; t.N = D; t.kind = 0; item = r; }
    else if ((r -= I_OA) < I_OUT) { t.src = p.w_out; t.dst = (bf16*)(p.ws + WS_WOUT); t.K = D; t.N = D; t.kind = 0; item = r; }
    else if ((r -= I_OUT) < I_ING) { t.src = p.w_in; t.K = D; t.N = INC; t.kind = 1;
        if (INPROJ_FP8_ALL) { t.dst = (bf16*)(p.ws + WS_WIN); t.k0 = 64 * (r / 68); t.n0 = 64 * (r % 68); }
        else { t.dst = (bf16*)(p.ws + WS_WIN8 - (size_t)2304 * D); t.k0 = 64 * (r / 32); t.n0 = 2304 + 64 * (r % 32); }
        return t; }
    else { r -= I_ING; const int e = r / (3 * I_EX), q = (r / I_EX) % 3; item = r % I_EX; t.K = D; t.N = D;
        constexpr size_t EBW = MOE_FP8 ? 1 : 2;
        if (q == 0) { t.src = p.w_gate + (size_t)e * D * D; t.dst = (bf16*)(p.ws + WS_WGU + (size_t)e * 2048 * D * EBW); t.kind = 2; }
        else if (q == 1) { t.src = p.w_up + (size_t)e * D * D; t.dst = (bf16*)(p.ws + WS_WGU + (size_t)e * 2048 * D * EBW); t.kind = 3; }
        else { t.src = p.w_down + (size_t)e * D * D; t.dst = (bf16*)(p.ws + WS_WD + (size_t)e * D * D * EBW); t.kind = 0; } }
    if (W8_TALL && MOE_FP8 && it >= I_SMALL) { t.k0 = 128 * (item / 32); t.n0 = 32 * (item % 32); return t; }
    const int nblk = t.N / 64; t.k0 = 64 * (item / nblk); t.n0 = 64 * (item % nblk); return t;
}
template <bool F8, bool TALL = false>
__device__ __forceinline__ void weight_items(const P& p, int first, int step, int hi, LAS unsigned* scr, int lane) {
    for (int it = first; it < hi; it += 2 * step) {
        const bool two = it + step < hi;
        const TItem t0 = weight_titem(p, it), t1 = weight_titem(p, two ? it + step : it);
        if constexpr (F8) {
            f32x4 v0[16], v1[16];
            if constexpr (TALL) { titem8t_load(t0, lane, v0); if (two) titem8t_load(t1, lane, v1);
                titem8t_finish(t0, lane, scr, v0); if (two) titem8t_finish(t1, lane, scr, v1); }
            else { titem8_load(t0, lane, v0); if (two) titem8_load(t1, lane, v1);
            titem8_finish(t0, lane, scr, v0); if (two) titem8_finish(t1, lane, scr, v1); }
        } else {
            f32x4 a0[8], b0[8], a1[8], b1[8];
            titem_load(t0, lane, a0, b0); if (two) titem_load(t1, lane, a1, b1);
            titem_finish(t0, lane, scr, a0, b0); if (two) titem_finish(t1, lane, scr, a1, b1);
        }
    }
}
__device__ __forceinline__ void ph_weights(const P& p, int vb, int nvb, LAS unsigned char* lds, int lo, int hi) {
    const int lane = threadIdx.x & 63, wave = threadIdx.x >> 6;
    const int mid = hi < I_B16 ? hi : I_B16;
    if (lo < mid) weight_items<false>(p, lo + vb * NWAVES + wave, nvb * NWAVES, mid, (LAS unsigned*)(lds + wave * 8704), lane);
    if (hi > I_B16 && I_ING > 0) { const int l2 = lo > I_B16 ? lo : I_B16, h2 = hi < I_SMALL ? hi : I_SMALL; weight_items<true>(p, l2 + vb * NWAVES + wave, nvb * NWAVES, h2, (LAS unsigned*)(lds + wave * 8704), lane); }
    if (hi > I_SMALL) { const int l2 = lo > I_SMALL ? lo : I_SMALL; weight_items<MOE_FP8 != 0, (W8_TALL && MOE_FP8)>(p, l2 + vb * NWAVES + wave, nvb * NWAVES, hi, (LAS unsigned*)(lds + wave * 8704), lane); }
}
__device__ __forceinline__ void ph_weights_share(const P& p, int vb, int nvb, LAS unsigned char* lds) {
    int lane = threadIdx.x & 63; const int wave = threadIdx.x >> 6;
    asm volatile("" : "+v"(lane));
    const int per = (NIT - I_SMALL + nvb - 1) / nvb, lo = I_SMALL + vb * per, hi = (lo + per < NIT) ? lo + per : NIT;
    weight_items<MOE_FP8 != 0, (W8_TALL && MOE_FP8)>(p, lo + wave, NWAVES, hi, (LAS unsigned*)(lds + wave * 8704), lane);
}
__device__ __forceinline__ void ph_weights_range(const P& p, int lo, int hi, LAS unsigned char* lds) {
    int lane = threadIdx.x & 63; const int wave = threadIdx.x >> 6;
    asm volatile("" : "+v"(lane));
    weight_items<MOE_FP8 != 0, (W8_TALL && MOE_FP8)>(p, lo + wave, NWAVES, hi, (LAS unsigned*)(lds + wave * 8704), lane);
}

__device__ __forceinline__ void expert_tables(const P& p, LAS int* tb) {
    if (threadIdx.x < 64) { const int lane = threadIdx.x; const gu32* CNT = (const gu32*)((const unsigned*)(p.ws + WS_CTL) + CW_CNT);
        const int c = (int)__hip_atomic_load(CNT + 64 * (lane & 31), __ATOMIC_RELAXED, __HIP_MEMORY_SCOPE_AGENT);
        int pb = (c + 255) & ~255, pt = (c + 255) >> 8;
#pragma unroll
        for (int o = 1; o < 32; o <<= 1) { const int ub = __shfl_up(pb, o), ut = __shfl_up(pt, o); if ((lane & 31) >= o) { pb += ub; pt += ut; } }
        if (lane < 32) { tb[lane] = c; tb[32 + lane] = pb - ((c + 255) & ~255); tb[64 + lane] = pt - ((c + 255) >> 8); if (lane == 31) tb[64 + NE] = pt; } }
    __syncthreads();
    { const int rt = threadIdx.x; const int ntile = tb[64 + NE];
      if (rt < ntile && rt < 320) { int e = 0;
#pragma unroll 1
          while (tb[64 + e + 1] <= rt) ++e;
          tb[128 + 4 * rt] = e; tb[128 + 4 * rt + 1] = (rt - tb[64 + e]) * 256; tb[128 + 4 * rt + 2] = tb[e]; tb[128 + 4 * rt + 3] = tb[32 + e]; } }
    __syncthreads();
}

struct Args { P p; int ph_lo, ph_hi, li, pad; };
__global__ void __launch_bounds__(NWAVES * 64, 2) mk_fwd(Args a) {
    extern __shared__ __attribute__((aligned(16))) unsigned char lds_raw[];
    LAS unsigned char* lds = (LAS unsigned char*)lds_raw;
    volatile LAS unsigned* MISC = (volatile LAS unsigned*)(lds + MISC_OFF);
    const P& p = a.p;
    const int tid = threadIdx.x, G = gridDim.x, bx = blockIdx.x;
    for (int u = tid; u < (LDS_BYTES - LDSCTL_OFF) / 4; u += NWAVES * 64) ((LAS unsigned*)(lds + LDSCTL_OFF))[u] = 0u;
    __syncthreads();
    unsigned* barw = (unsigned*)(p.ws + WS_CTL) + CW_BAR + a.li * XCD_BAR_WORDS;
    XcdBarrier bar = xcd_barrier_post(barw, MISC + 8);
    unsigned* topo = (unsigned*)(p.ws + WS_CTL) + CW_TOPO + a.li * 768;
    bool topo_ok = false; int vcu = (G % 8 == 0) ? (bx % 8) * (G / 8) + bx / 8 : bx;
    if (TOPO_SYNC && a.li == 0) {
        if (tid == 0) MISC[10] = xb_add(&topo[16 * bar.x], 1u);
        if (tid < 64) { unsigned sp_ = 0u;
            for (;;) { const unsigned c_ = tid < 16 ? xb_ld(&topo[16 * tid]) : 0u; unsigned sum_ = c_;
#pragma unroll
                for (int o_ = 1; o_ < 16; o_ <<= 1) sum_ += __shfl_xor(sum_, o_);
                if (__builtin_amdgcn_readfirstlane(sum_) == (unsigned)G) {
                    const unsigned long long nz = __ballot(c_ > 0u), bad = __ballot(c_ != 0u && c_ != 32u);
                    const bool ok_ = G == 256 && __builtin_popcountll(nz) == 8 && bad == 0ull;
                    if (tid == 0) MISC[11] = ok_ ? 1u + (unsigned)__builtin_popcountll(nz & ((1ull << bar.x) - 1ull)) : 0u;
                    break; }
                __builtin_amdgcn_s_sleep(1); if (++sp_ > (1u << 22)) break; } }
        __syncthreads();
        const unsigned tr_ = MISC[11]; topo_ok = tr_ != 0u;
        if (topo_ok) vcu = (int)((tr_ - 1u) * 32u + MISC[10]);
    }
    unsigned* const lbw = topo + 256 + 16 * bar.x;
#define LOCAL_BAR() do { asm volatile("s_waitcnt vmcnt(0)" ::: "memory"); __syncthreads(); \
        if (tid == 0) { const unsigned old_ = xb_add(&lbw[0], 1u), gen_ = old_ / 32u; \
            if (old_ + 1u == (gen_ + 1u) * 32u) (void)xb_add(&lbw[256], 1u); else XB_SPIN(xb_ld(&lbw[256]) == gen_, barw); } \
        asm volatile("" ::: "memory"); __syncthreads(); } while (0)
    const int lo = a.ph_lo, hi = a.ph_hi;
#ifndef PH_COMPILED
#define PH_COMPILED 0x7ff
#endif
#define IN(k) ((((PH_COMPILED) >> (k)) & 1) && lo <= (k) && (k) < hi)
#define CENSUS() do { if (CENSUS_PAR && tid < 64 && MISC[8] == 0u) { unsigned sp_ = 0u; \
        for (;;) { const unsigned c_ = tid < 16 ? xb_ld(&barw[XB_XCNT(tid)]) : 0u; unsigned sum_ = c_, cnt_ = c_ > 0u ? 1u : 0u; \
            _Pragma("unroll") for (int o_ = 1; o_ < 16; o_ <<= 1) { sum_ += __shfl_xor(sum_, o_); cnt_ += __shfl_xor(cnt_, o_); } \
            const unsigned mine_ = __shfl(c_, (int)bar.x); \
            if (__builtin_amdgcn_readfirstlane(sum_) == (unsigned)G) { if (tid == 0) { MISC[8] = __builtin_amdgcn_readfirstlane(mine_); MISC[9] = __builtin_amdgcn_readfirstlane(cnt_); } break; } \
            __builtin_amdgcn_s_sleep(1); if (++sp_ > 20000u) break; } } } while (0)
#define SEAM(k) do { if (IN(k) && IN((k) + 1)) { CENSUS(); xcd_barrier(bar); } } while (0)
#define SEAM_L(k) do { if (IN(k) && IN((k) + 1)) { if (topo_ok) LOCAL_BAR(); else { CENSUS(); xcd_barrier(bar); } } } while (0)
#ifndef DUP_MASK
#define DUP_MASK 0
#endif
#if ((DUP_MASK) >> 0) & 1
#define REP0 _Pragma("unroll 1") for (int rep_ = 0; rep_ < 2; ++rep_)
#else
#define REP0
#endif
#if ((DUP_MASK) >> 1) & 1
#define REP1 _Pragma("unroll 1") for (int rep_ = 0; rep_ < 2; ++rep_)
#else
#define REP1
#endif
#if ((DUP_MASK) >> 2) & 1
#define REP2 _Pragma("unroll 1") for (int rep_ = 0; rep_ < 2; ++rep_)
#else
#define REP2
#endif
#if ((DUP_MASK) >> 3) & 1
#define REP3 _Pragma("unroll 1") for (int rep_ = 0; rep_ < 2; ++rep_)
#else
#define REP3
#endif
#if ((DUP_MASK) >> 4) & 1
#define REP4 _Pragma("unroll 1") for (int rep_ = 0; rep_ < 2; ++rep_)
#else
#define REP4
#endif
#if ((DUP_MASK) >> 5) & 1
#define REP5 _Pragma("unroll 1") for (int rep_ = 0; rep_ < 2; ++rep_)
#else
#define REP5
#endif
#if ((DUP_MASK) >> 6) & 1
#define REP6 _Pragma("unroll 1") for (int rep_ = 0; rep_ < 2; ++rep_)
#else
#define REP6
#endif
#if ((DUP_MASK) >> 7) & 1
#define REP7 _Pragma("unroll 1") for (int rep_ = 0; rep_ < 2; ++rep_)
#else
#define REP7
#endif
#if ((DUP_MASK) >> 8) & 1
#define REP8 _Pragma("unroll 1") for (int rep_ = 0; rep_ < 2; ++rep_)
#else
#define REP8
#endif
#if ((DUP_MASK) >> 9) & 1
#define REP9 _Pragma("unroll 1") for (int rep_ = 0; rep_ < 2; ++rep_)
#else
#define REP9
#endif
    LAS int* tb = (LAS int*)(lds + TB_OFF);

    if (IN(0)) { ph_mod(p, bx, G, (float*)lds_raw); __syncthreads(); ph_weights(p, bx, G, lds, 0, WSTAGGER ? I_SMALL : NIT);
#if ((DUP_MASK) >> 0) & 1
        __syncthreads(); ph_weights(p, bx, G, lds, 0, WSTAGGER ? I_SMALL : NIT);
#endif
#if ((DUP_MASK) >> 13) & 1
        __syncthreads(); ph_mod(p, bx, G, (float*)lds_raw);
#endif
    }
    const bool n1_pre = NORM1_PRELOAD && INPROJ_XCD_BLOCKS && topo_ok && G == 256 && IN(0) && IN(1);
    if (n1_pre) { f32x4 vq_[8][4];
        CENSUS(); xcd_barrier_arrive(bar, MISC + 12); ph_norm1_load(p, vcu, vq_); xcd_barrier_wait(bar, MISC + 12);
        ph_norm1_finish(p, vcu, vq_); ph_router_prep(p, bx, G); }
    else SEAM(0);
    if (IN(1) && !n1_pre) { ph_norm1(p, INPROJ_XCD_BLOCKS ? vcu : bx, G); ph_router_prep(p, bx, G);
#if ((DUP_MASK) >> 1) & 1
        ph_norm1(p, INPROJ_XCD_BLOCKS ? vcu : bx, G);
#endif
    }
    if (INPROJ_XCD_BLOCKS && INPROJ_FP8_ALL) SEAM_L(1); else SEAM(1);
    if (IN(2)) {
        pg8::Gemm g{(const bf16*)(p.ws + WS_HX), (const bf16*)(p.ws + WS_WIN), D, D};
        EpiInProj E{p.ws, p.q_norm_a, p.k_norm_a, p.q_norm_b, p.k_norm_b};
#if INPROJ_FP8_ALL
        { pg8::Gemm g8{(const bf16*)(p.ws + WS_HX8), (const bf16*)(p.ws + WS_WIN), D, D}; SchedInProj S; S.G = G; S.v = vcu;
          pg8::gemm_phase<EpiInProj, SchedInProj, true>(lds + RING_OFF, g8, S, E);
#if ((DUP_MASK) >> 2) & 1
          pg8::gemm_phase<EpiInProj, SchedInProj, true>(lds + RING_OFF, g8, S, E);
#endif
          }
#elif INPROJ_GATE_FP8
        { SchedInProjA S; S.G = G; S.v = vcu; pg8::gemm_phase<EpiInProj, SchedInProjA, true>(lds + RING_OFF, g, S, E); }
        { pg8::Gemm g8{(const bf16*)(p.ws + WS_HX8), (const bf16*)(p.ws + WS_WIN8), D, D}; SchedInProjG S; S.G = G; S.v = vcu; EpiInProjG E8{p.ws};
          pg8::gemm_phase<EpiInProjG, SchedInProjG, true>(lds + RING_OFF, g8, S, E8); }
#else
        SchedInProj S; S.G = G; S.v = vcu;
        pg8::gemm_phase<EpiInProj, SchedInProj, true>(lds + RING_OFF, g, S, E);
#endif
#if (((DUP_MASK) >> 2) & 1) && !INPROJ_GATE_FP8
        pg8::gemm_phase<EpiInProj, SchedInProj, true>(lds + RING_OFF, g, S, E);
#endif
    }
    const bool early_conv = EARLY_CONV && WSTAGGER && MOE_FP8 && topo_ok && G == 256 && IN(2) && IN(3) && (NIT - I_SMALL) == 256 * 96;
    constexpr int EC_IDLE = 40, EC_BUSY = 8;
    const int ec_thr = ((vcu >> 5) & 3) == 3 ? 13 : 8, ec_j = vcu & 31, ec_s = (3072 - EC_BUSY * ec_thr - EC_IDLE * (32 - ec_thr)) / 32;
    const int ec_lo = I_SMALL + (vcu >> 5) * 3072 + ec_j * ec_s + EC_BUSY * (ec_j < ec_thr ? ec_j : ec_thr) + EC_IDLE * (ec_j > ec_thr ? ec_j - ec_thr : 0), ec_early = ec_j >= ec_thr ? EC_IDLE : EC_BUSY;
    if (early_conv) { CENSUS(); xcd_barrier_arrive(bar, MISC + 12); ph_weights_range(p, ec_lo, ec_lo + ec_early, lds); xcd_barrier_wait(bar, MISC + 12); }
    else SEAM(2);
    REP3 if (IN(3) && G == 256) {
        using attn_body::attn_unit2; using attn_body::attn_unit3; typedef attn_body::bf16 abf;
        const int x = vcu >> 5, j = vcu & 31;
        char* shm = (char*)lds_raw + RING_OFF;
        const int wslot = WSTAGGER ? (j % 5) : -1;
#define WSLOT(s) do { if (wslot == (s)) { if (early_conv) ph_weights_range(p, ec_lo + ec_early, ec_lo + ec_early + ec_s, lds); else ph_weights_share(p, vcu, G, lds); __syncthreads(); } } while (0)
#if ATT_FP8
        { const int b = x >> 2;
#pragma unroll 1
          for (int i = 0; i < 2 * (1 + (((DUP_MASK) >> 11) & 1)); ++i) {
            const int kvh = ATT_XCD_ROWS ? (i & 1) : (x >> 1) & 1, u = j + 32 * (i & 1), h = ATT_XCD_ROWS ? kvh * 4 + (j >> 3) : kvh * 4 + (x & 1) * 2 + (u >> 5), qb = ATT_XCD_ROWS ? (x & 3) * 8 + (j & 7) : u & 31;
            const size_t qrow = (size_t)b * SEQ + qb * 256;
            if (i < 2) { WSLOT(i);
            attn_body::ATT8_UNIT_A(p.ws + WS_QA + qrow * 512 + h * 64, p.ws + WS_KA + (size_t)b * SK * 128 + kvh * 64,
                p.ws + WS_VA + (size_t)((b * 2 + kvh) * (SK / 64)) * 4096, MERGE_FP8 ? (abf*)(p.ws + WS_AY + qrow * 1024 + h * 64) : (abf*)(p.ws + WS_AY) + qrow * 1024 + h * 64, shm); }
#if ((DUP_MASK) >> 11) & 1
            else attn_body::attn_unit8<64, true, SK / 64, 512, 128, 1024, 0, ABL_PROBE>(p.ws + WS_QA + qrow * 512 + h * 64, p.ws + WS_KA + (size_t)b * SK * 128 + kvh * 64,
                p.ws + WS_VA + (size_t)((b * 2 + kvh) * (SK / 64)) * 4096, (abf*)(p.ws + WS_HX8 + (size_t)(vcu >> 4) * 256 * 2048 + (size_t)(vcu & 15) * 128), shm);
#endif
            } }
        { const int b = x >> 2, h = ATT_XCD_ROWS ? (j >> 3) : (x & 3);
#pragma unroll 1
          for (int i = 0; i < 2 * (1 + (((DUP_MASK) >> 12) & 1)); ++i) { const int u = j + 32 * (i & 1), m = ATT_XCD_ROWS ? (i & 1) : u >> 5, qb = ATT_XCD_ROWS ? (x & 3) * 8 + (j & 7) : u & 31; const size_t qrow = (size_t)b * SEQ + qb * 256;
            if (i < 2) WSLOT(2 + i);
            attn_body::attn_unit8<128, ATT8_ONES_B, SK / 64, 512, 512, 512, 0>(p.ws + WS_QB + qrow * 512 + h * 128 + m * 64, p.ws + WS_KB + (size_t)b * SK * 512 + h * 128 + m * 64,
                p.ws + WS_VB + (size_t)((b * 4 + h) * (SK / 64)) * 8192, (abf*)(p.ws + WS_OB) + (size_t)m * T * 512 + qrow * 512 + h * 128, shm); } }
#else
        { const int b = x >> 2, kvh = (x >> 1) & 1;
#pragma unroll 1
          for (int i = 0; i < 2 * (1 + (((DUP_MASK) >> 11) & 1)); ++i) { const int u = j + 32 * (i & 1), h = kvh * 4 + (x & 1) * 2 + (u >> 5), qb = u & 31; const size_t qrow = (size_t)b * SEQ + qb * 256;
            WSLOT(i);
#if MERGE_FP8
            attn_unit2<64, ATT_ONES_A, SK / 64, 512, 128, 128, 1024, 1>((const abf*)(p.ws + WS_QA) + qrow * 512 + h * 64, (const abf*)(p.ws + WS_KA) + (size_t)b * SK * 128 + kvh * 64,
                (const abf*)(p.ws + WS_VA) + (size_t)b * SK * 128 + kvh * 64, (abf*)(p.ws + WS_AY + qrow * 1024 + h * 64), shm); } }
#else
            ATT_UNIT_A<64, ATT_ONES_A, SK / 64, 512, 128, 128, 1024>((const abf*)(p.ws + WS_QA) + qrow * 512 + h * 64, (const abf*)(p.ws + WS_KA) + (size_t)b * SK * 128 + kvh * 64,
                (const abf*)(p.ws + WS_VA) + (size_t)b * SK * 128 + kvh * 64, (abf*)(p.ws + WS_AY) + qrow * 1024 + h * 64, shm); } }
#endif
        { const int b = x >> 2, h = x & 3;
#pragma unroll 1
          for (int i = 0; i < 2 * (1 + (((DUP_MASK) >> 12) & 1)); ++i) { const int u = j + 32 * (i & 1), m = u >> 5, qb = u & 31; const size_t qrow = (size_t)b * SEQ + qb * 256;
            WSLOT(2 + i);
            ATT_UNIT_B<128, ATT_ONES_B, SK / 64, 512, 512, 512, 512>((const abf*)(p.ws + WS_QB) + qrow * 512 + h * 128 + m * 64, (const abf*)(p.ws + WS_KB) + (size_t)b * SK * 512 + h * 128 + m * 64,
                (const abf*)(p.ws + WS_VB) + (size_t)b * SK * 512 + h * 128, (abf*)(p.ws + WS_OB) + (size_t)m * T * 512 + qrow * 512 + h * 128, shm); } }
#endif
        if (FUSE_DIFFOUT) {
            asm volatile("s_waitcnt vmcnt(0)" ::: "memory"); __syncthreads();
            diffout_tile(p, (size_t)(x >> 2) * SEQ + (size_t)(ATT_XCD_ROWS ? (x & 3) * 8 + (j & 7) : j) * 256, ATT_XCD_ROWS ? (j >> 3) : (x & 3)); }
        WSLOT(4);
#undef WSLOT
    }
    if (!FUSE_DIFFOUT) SEAM(3);
    if (IN(4) && !FUSE_DIFFOUT) { ph_diffout(p, bx, G);
#if ((DUP_MASK) >> 4) & 1
        ph_diffout(p, bx, G);
#endif
    }
#if X_TOUCH
    if (ATT_XCD_ROWS && ATT_FP8 && FUSE_DIFFOUT) { if (IN(4) && IN(5)) { if (topo_ok) {
        asm volatile("s_waitcnt vmcnt(0)" ::: "memory");
        if (IN(6) && vcu < 256) { const int pm_ = 8 * (vcu >> 5) + (vcu & 7), pn_ = (vcu & 31) >> 3;
            const unsigned char* xt = (const unsigned char*)(p.x + (size_t)pm_ * 256 * D + pn_ * 256);
#pragma unroll
            for (int k = 0; k < 4; ++k) { const int L = tid + 512 * k;
                __builtin_amdgcn_global_load_lds((const unsigned*)(xt + (size_t)(L >> 3) * 4096 + (L & 7) * 128), (LAS unsigned*)(lds + pg8::PF_OFF + (tid >> 6) * 256), 4, 0, 0); } }
        __builtin_amdgcn_s_barrier();
        if (tid == 0) { const unsigned old_ = xb_add(&lbw[0], 1u), gen_ = old_ / 32u;
            if (old_ + 1u == (gen_ + 1u) * 32u) (void)xb_add(&lbw[256], 1u); else XB_SPIN(xb_ld(&lbw[256]) == gen_, barw); }
        asm volatile("" ::: "memory"); __builtin_amdgcn_s_barrier(); asm volatile("" ::: "memory");
    } else { CENSUS(); xcd_barrier(bar); } } } else SEAM(4);
#else
    if (ATT_XCD_ROWS && ATT_FP8 && FUSE_DIFFOUT) SEAM_L(4); else SEAM(4);
#endif
    if (IN(5)) {
        pg8::Gemm g{(const bf16*)(p.ws + WS_AY), (const bf16*)(p.ws + WS_WOA), 1024, 512}; SchedTile<2> S; S.G = G; S.v = vcu;
        EpiMerge E{(const bf16*)(p.ws + WS_G), (bf16*)(p.ws + WS_MERGED)};
        pg8::gemm_phase<EpiMerge, SchedTile<2>, true>(lds + RING_OFF, g, S, E);
#if ((DUP_MASK) >> 5) & 1
        pg8::gemm_phase<EpiMerge, SchedTile<2>, true>(lds + RING_OFF, g, S, E);
#endif
    }
    SEAM_L(5);
    if (IN(6)) {
        pg8::Gemm g{(const bf16*)(p.ws + WS_MERGED), (const bf16*)(p.ws + WS_WOUT), D, D}; SchedTile<1> S; S.G = G; S.v = vcu;
        EpiOut E{p.x, (const float*)(p.ws + WS_MOD), X1_BF16 ? (float*)(p.ws + WS_X1) : p.out};
        pg8::gemm_phase<EpiOut, SchedTile<1>, true>(lds + RING_OFF, g, S, E);
#if ((DUP_MASK) >> 6) & 1
        pg8::gemm_phase<EpiOut, SchedTile<1>, true>(lds + RING_OFF, g, S, E);
#endif
    }
    SEAM_L(6);
    if (IN(7)) ph_router2(p, vcu, G, lds_raw + RING_OFF, lds_raw + LDSCTL_OFF + 1024);
    SEAM(7);
    const bool split_bar = MOE_SPLIT_BAR && MOE_XCD_BLOCKS && topo_ok && G == 256 && IN(8) && IN(9);
    int sb_r1 = 0, sb_e1 = 0, sb_late0 = 0x7fffffff; unsigned* const sb_cnt = topo + 768 + 16 * bar.x;
    REP8 if (IN(8)) {
        expert_tables(p, tb);
        pg8::Gemm g{(const bf16*)(p.ws + WS_HM), (const bf16*)(p.ws + WS_WGU), D, D}; SchedMoe<8, true> S; S.G = G; S.v = vcu; S.tb = tb; S.tok = (const int*)(p.ws + WS_TOK);
        EpiMoe1 E{p.b_gate, p.b_up, (bf16*)(p.ws + WS_ACT), (const LAS unsigned char*)(lds + pg8::PF_OFF)};
        if (split_bar) {
            const int ntile = tb[64 + NE], RB = (ntile + 7) >> 3, x_ = vcu >> 5; int rbx = ntile - x_ * RB; rbx = rbx < 0 ? 0 : rbx > RB ? RB : rbx;
            sb_r1 = (rbx * 8) >> 5; sb_e1 = (rbx * 8) & 31; sb_late0 = x_ * RB + 4 * sb_r1;
            S.ihi = sb_r1; pg8::gemm_phase<EpiMoe1, SchedMoe<8, true>, true>(lds + RING_OFF, g, S, E);
            LOCAL_BAR();
            if (sb_e1 > 0) { S.ilo = sb_r1; S.ihi = 0x7fffffff; pg8::gemm_phase<EpiMoe1, SchedMoe<8, true>, true>(lds + RING_OFF, g, S, E);
                if ((vcu & 31) < sb_e1) { asm volatile("s_waitcnt vmcnt(0)" ::: "memory"); __syncthreads(); if (tid == 0) (void)xb_add(sb_cnt, 1u); } }
        } else
        pg8::gemm_phase<EpiMoe1, SchedMoe<8, true>, true>(lds + RING_OFF, g, S, E);
    }
    if (!split_bar) { if (MOE_XCD_BLOCKS) SEAM_L(8); else SEAM(8); }
    REP9 if (IN(9)) {
        if (!IN(8)) expert_tables(p, tb);
        pg8::Gemm g{(const bf16*)(p.ws + WS_ACT), (const bf16*)(p.ws + WS_WD), D, D}; SchedMoe<4, false> S; S.G = G; S.v = vcu; S.tb = tb; S.tok = nullptr;
        if (split_bar) { S.rev = true; if (sb_e1 > 0) { S.late_rt0 = sb_late0; S.late_cnt = sb_cnt; S.late_n = (unsigned)sb_e1; } }
        EpiMoe2 E{p.b_down, (const float*)(p.ws + WS_SW), (const int*)(p.ws + WS_SDST), (bf16*)(p.ws + WS_Y), (const LAS unsigned char*)(lds + pg8::PF_OFF)};
        pg8::gemm_phase<EpiMoe2, SchedMoe<4, false>, true>(lds + RING_OFF, g, S, E);
    }
    const bool cmb_pre = COMBINE_PRELOAD && X1_BF16 && Y_FP8 && G == 256 && IN(9) && IN(10);
    if (cmb_pre) { uint4 xw_[16]; CENSUS(); xcd_barrier_arrive(bar, MISC + 12); ph_combine_xload(p, bx, G, xw_); xcd_barrier_wait(bar, MISC + 12); ph_combine_pre(p, bx, G, xw_); }
    else { SEAM(9);
    if (IN(10)) ph_combine(p, bx, G); }
#undef IN
#undef SEAM
}

#ifndef FAST_MASK
#define FAST_MASK 0x7ff
#endif
extern "C" void kernel_launch(void* const* d_in, const int* in_sizes, int n_in, void* d_out, int out_size, void* d_ws, size_t ws_size, hipStream_t stream) {
    static int grid = 0;
    if (grid == 0) {
        if (n_in != 29 || out_size != T * D || ws_size < WS_END) { fprintf(stderr, "kernel_launch: unexpected shapes n_in %d out %d ws %zu\n", n_in, out_size, ws_size); grid = -1; return; }
        int dev = 0, cus = 0, per_cu = 0;
        if (hipGetDevice(&dev) != hipSuccess || hipDeviceGetAttribute(&cus, hipDeviceAttributeMultiprocessorCount, dev) != hipSuccess) { grid = -1; return; }
        if (hipFuncSetAttribute((const void*)mk_fwd, hipFuncAttributeMaxDynamicSharedMemorySize, LDS_BYTES) != hipSuccess) { fprintf(stderr, "kernel_launch: hipFuncSetAttribute failed\n"); grid = -1; return; }
        if (hipOccupancyMaxActiveBlocksPerMultiprocessor(&per_cu, (const void*)mk_fwd, NWAVES * 64, LDS_BYTES) != hipSuccess || per_cu < 1) fprintf(stderr, "kernel_launch: occupancy query reports %d\n", per_cu);
        (void)hipGetLastError();
        grid = cus;
        if (grid != 256) fprintf(stderr, "kernel_launch: %d CUs; the unit deals are built for 256\n", grid);
    }
    if (grid < 0) return;
    (void)hipMemsetAsync((char*)d_ws + WS_CTL, 0, CTL_BYTES, stream);
    Args a{};
    const float** f = (const float**)&a.p;
    for (int i = 0; i < 29; ++i) f[i] = (const float*)d_in[i];
    a.p.out = (float*)d_out; a.p.ws = (unsigned char*)d_ws;
    const P& p = a.p;
    const unsigned mask = (unsigned)(FAST_MASK) | 0x493u;
    int li = 0;
    for (int k = 0; k < N_PHASES;) {
        if (mask & (1u << k)) { int e = k; while (e < N_PHASES && (mask & (1u << e))) ++e;
            a.ph_lo = k; a.ph_hi = e; a.li = li++;
            hipLaunchKernelGGL(mk_fwd, dim3(grid), dim3(NWAVES * 64), LDS_BYTES, stream, a);
            k = e; continue; }
        switch (k) {
            case 2: nk_inproj<<<dim3(TK / 64, INC / 64), 256, 0, stream>>>(p); break;
            case 3: nk_attn<0><<<dim3(32, 16), 256, 0, stream>>>(p); nk_attn<1><<<dim3(32, 16), 256, 0, stream>>>(p); break;
            case 5: nk_merge<<<dim3(T / 64, D / 64), 256, 0, stream>>>(p); break;
            case 6: nk_outproj<<<dim3(T / 64, D / 64), 256, 0, stream>>>(p); break;
            case 8: nk_moe1<<<4096, 256, 0, stream>>>(p); break;
            case 9: nk_moe2<<<4096, 256, 0, stream>>>(p); break;
            default: break;
        }
        ++k;
    }
}
```
